# Optimizing an MI355X kernel written in HIP

```python
import math
import jax, jax.numpy as jnp
from jax import lax
import numpy as np

D_MODEL = 1024
BATCH = 8
SEQ = 4096
DEPTH = 1

HEAD_DIM = 64
N_HEADS_MOBA = 8
N_HEADS_DSA = 8
ROT_DIM = HEAD_DIM // 4
ROPE_THETA = 500000.0
MOBA_BLOCK = 256
MOBA_TOPK = 3
MOBA_Q_CHUNK = 16
IDX_HEADS = 8
IDX_DIM = 64
DSA_TOPK_MAX = 256
DSA_Q_CHUNK = 64
N_GROUPS = 4
EXPERTS_PER_GROUP = 8
N_EXPERTS = N_GROUPS * EXPERTS_PER_GROUP
EXPERT_TOPK = 2
D_EXPERT = 512
MOE_ROWS = 256
PLE_DIM = 256
RMS_EPS = 1e-6

A_W = N_HEADS_MOBA * HEAD_DIM
B_W = N_HEADS_DSA * HEAD_DIM
IQ_W = IDX_HEADS * IDX_DIM
IN_SPLITS = (A_W, A_W, A_W, B_W, B_W, B_W, IQ_W, IDX_DIM, IDX_HEADS, D_MODEL, D_MODEL)
IN_COLS = sum(IN_SPLITS)

kernel_name = "hybrid_moba_dsa_hiermoe_ple"


def rms_norm(x, g):
    xf = x.astype(jnp.float32)
    y = xf * lax.rsqrt(jnp.mean(xf * xf, axis=-1, keepdims=True) + RMS_EPS)
    return (y * g.astype(jnp.float32)).astype(x.dtype)


def rope_tables(seq):
    inv = 1.0 / (ROPE_THETA ** (jnp.arange(0, ROT_DIM, 2, dtype=jnp.float32) / ROT_DIM))
    ang = jnp.arange(seq, dtype=jnp.float32)[:, None] * inv[None, :]
    return jnp.cos(ang), jnp.sin(ang)


def apply_rope(x, cos, sin):
    half = ROT_DIM // 2
    xf = x.astype(jnp.float32)
    x1 = xf[..., :half]
    x2 = xf[..., half:ROT_DIM]
    c = cos[None, :, None, :]
    s = sin[None, :, None, :]
    out = jnp.concatenate([x1 * c - x2 * s, x2 * c + x1 * s, xf[..., ROT_DIM:]], axis=-1)
    return out.astype(x.dtype)


def moba_attention(q, k, v):
    b, s, h, dh = q.shape
    n_blk = -(-s // MOBA_BLOCK)
    pad = n_blk * MOBA_BLOCK - s
    kp = jnp.pad(k, ((0, 0), (0, pad), (0, 0), (0, 0)))
    vp = jnp.pad(v, ((0, 0), (0, pad), (0, 0), (0, 0)))
    k_bh = kp.reshape(b, n_blk, MOBA_BLOCK, h, dh).transpose(0, 3, 1, 2, 4)
    v_bh = vp.reshape(b, n_blk, MOBA_BLOCK, h, dh).transpose(0, 3, 1, 2, 4)
    k_mean = jnp.mean(k_bh.astype(jnp.float32), axis=3)
    n_sel = min(MOBA_TOPK, n_blk - 1)
    scale = HEAD_DIM ** -0.5
    n_chunks = s // MOBA_Q_CHUNK
    qc = q.reshape(b, n_chunks, MOBA_Q_CHUNK, h, dh).transpose(1, 0, 2, 3, 4)
    bi = jnp.arange(b)[:, None, None, None]
    hi = jnp.arange(h)[None, None, :, None]
    kpos_in_blk = jnp.arange(MOBA_BLOCK)

    def chunk_fn(args):
        q_c, c = args
        t0 = c * MOBA_Q_CHUNK
        pos = t0 + jnp.arange(MOBA_Q_CHUNK)
        cur = t0 // MOBA_BLOCK
        k_own = lax.dynamic_index_in_dim(k_bh, cur, axis=2, keepdims=False)
        v_own = lax.dynamic_index_in_dim(v_bh, cur, axis=2, keepdims=False)
        s_own = jnp.einsum('bqhd,bhkd->bqhk', q_c, k_own,
                           preferred_element_type=jnp.float32) * scale
        causal = (cur * MOBA_BLOCK + kpos_in_blk)[None, :] <= pos[:, None]
        s_own = jnp.where(causal[None, :, None, :], s_own, -jnp.inf)
        if n_sel > 0:
            gate = jnp.einsum('bqhd,bhnd->bqhn', q_c.astype(jnp.float32), k_mean)
            past = jnp.arange(n_blk) < cur
            gate = jnp.where(past[None, None, None, :], gate, -jnp.inf)
            _, sel = lax.top_k(gate, n_sel)
            sel_ok = sel < cur
            k_sel = k_bh[bi, hi, sel]
            v_sel = v_bh[bi, hi, sel]
            s_past = jnp.einsum('bqhd,bqhnkd->bqhnk', q_c, k_sel,
                                preferred_element_type=jnp.float32) * scale
            s_past = jnp.where(sel_ok[..., None], s_past, -jnp.inf)
            s_past = s_past.reshape(b, MOBA_Q_CHUNK, h, n_sel * MOBA_BLOCK)
            probs = jax.nn.softmax(jnp.concatenate([s_past, s_own], axis=-1), axis=-1)
            p_past = probs[..., :n_sel * MOBA_BLOCK].reshape(b, MOBA_Q_CHUNK, h, n_sel, MOBA_BLOCK)
            p_own = probs[..., n_sel * MOBA_BLOCK:]
            o = (jnp.einsum('bqhnk,bqhnkd->bqhd', p_past, v_sel.astype(jnp.float32))
                 + jnp.einsum('bqhk,bhkd->bqhd', p_own, v_own.astype(jnp.float32)))
        else:
            p_own = jax.nn.softmax(s_own, axis=-1)
            o = jnp.einsum('bqhk,bhkd->bqhd', p_own, v_own.astype(jnp.float32))
        return o.astype(q.dtype)

    out = lax.map(chunk_fn, (qc, jnp.arange(n_chunks)))
    return out.transpose(1, 0, 2, 3, 4).reshape(b, s, h, dh)


def dsa_attention(q, k, v, iq, ik, iw):
    b, s, h, dh = q.shape
    topk = min(DSA_TOPK_MAX, s // 4)
    scale = HEAD_DIM ** -0.5
    idx_scale = IDX_DIM ** -0.5
    w_scale = IDX_HEADS ** -0.5
    n_chunks = s // DSA_Q_CHUNK

    def to_chunks(a):
        return a.reshape((b, n_chunks, DSA_Q_CHUNK) + a.shape[2:]).swapaxes(0, 1)

    key_pos = jnp.arange(s)
    bi = jnp.arange(b)[:, None, None]

    def chunk_fn(args):
        q_c, iq_c, iw_c, c = args
        pos = c * DSA_Q_CHUNK + jnp.arange(DSA_Q_CHUNK)
        rel = jnp.einsum('bqhd,bsd->bhqs', iq_c, ik,
                         preferred_element_type=jnp.float32) * idx_scale
        score = jnp.einsum('bhqs,bqh->bqs', jax.nn.relu(rel),
                           iw_c.astype(jnp.float32) * w_scale)
        admissible = key_pos[None, :] <= pos[:, None]
        score = jnp.where(admissible[None], score, -jnp.inf)
        _, idx = lax.top_k(score, topk)
        ok = idx <= pos[None, :, None]
        k_sel = k[bi, idx]
        v_sel = v[bi, idx]
        logits = jnp.einsum('bqhd,bqkhd->bqhk', q_c, k_sel,
                            preferred_element_type=jnp.float32) * scale
        logits = jnp.where(ok[:, :, None, :], logits, -jnp.inf)
        probs = jax.nn.softmax(logits, axis=-1)
        o = jnp.einsum('bqhk,bqkhd->bqhd', probs, v_sel.astype(jnp.float32))
        return o.astype(q.dtype)

    out = lax.map(chunk_fn, (to_chunks(q), to_chunks(iq), to_chunks(iw), jnp.arange(n_chunks)))
    return out.swapaxes(0, 1).reshape(b, s, h, dh)


def hier_moe(h, w_grp, b_grp, w_rt, b_rt, w_gate, w_up, w_down):
    b, s, d = h.shape
    t = b * s
    hf = h.reshape(t, d)
    grp_logits = jnp.matmul(hf, w_grp).astype(jnp.float32) + b_grp.astype(jnp.float32)
    grp_prob = jax.nn.softmax(grp_logits, axis=-1)
    g = jnp.argmax(grp_logits, axis=-1)
    p_g = jnp.take_along_axis(grp_prob, g[:, None], axis=-1)[:, 0]
    exp_logits = (jnp.matmul(hf, w_rt).astype(jnp.float32) + b_rt.astype(jnp.float32))
    exp_logits = exp_logits.reshape(t, N_GROUPS, EXPERTS_PER_GROUP)
    in_grp = jnp.take_along_axis(exp_logits, g[:, None, None], axis=1)[:, 0]
    top_val, top_idx = lax.top_k(in_grp, EXPERT_TOPK)
    combine = p_g[:, None] * jax.nn.softmax(top_val, axis=-1)
    expert_id = g[:, None] * EXPERTS_PER_GROUP + top_idx

    a = t * EXPERT_TOPK
    e_flat = expert_id.reshape(a)
    tok_flat = jnp.repeat(jnp.arange(t), EXPERT_TOPK)
    w_flat = combine.reshape(a)
    order = jnp.argsort(e_flat)
    e_s, tok_s, w_s = e_flat[order], tok_flat[order], w_flat[order]
    counts = jnp.bincount(e_flat, length=N_EXPERTS)
    padded = ((counts + MOE_ROWS - 1) // MOE_ROWS) * MOE_ROWS
    start = jnp.cumsum(counts) - counts
    pend = jnp.cumsum(padded)
    pstart = pend - padded
    dest = pstart[e_s] + (jnp.arange(a) - start[e_s])
    n_blocks = -(-a // MOE_ROWS) + N_EXPERTS
    rows = n_blocks * MOE_ROWS
    buf_tok = jnp.full((rows,), t, dtype=jnp.int32).at[dest].set(tok_s.astype(jnp.int32))
    buf_w = jnp.zeros((rows,), jnp.float32).at[dest].set(w_s)
    blk_exp = jnp.minimum(jnp.searchsorted(pend, jnp.arange(n_blocks) * MOE_ROWS, side='right'),
                          N_EXPERTS - 1)
    h_pad = jnp.concatenate([hf, jnp.zeros((1, d), hf.dtype)], axis=0)

    def block_fn(args):
        tok_b, e_b = args
        xb = h_pad[tok_b]
        hid = jax.nn.silu(jnp.matmul(xb, w_gate[e_b])) * jnp.matmul(xb, w_up[e_b])
        return jnp.matmul(hid, w_down[e_b])

    y = lax.map(block_fn, (buf_tok.reshape(n_blocks, MOE_ROWS), blk_exp))
    y = y.reshape(rows, d).astype(jnp.float32) * buf_w[:, None]
    out = jnp.zeros((t + 1, d), jnp.float32).at[buf_tok].add(y)[:t]
    return out.reshape(b, s, d).astype(h.dtype)


def hybrid_layer(x, p_i, cos, sin, g_attn, w_in, w_br_a, w_br_b, w_out, g_ffn,
                 w_grp, b_grp, w_rt, b_rt, w_gate, w_up, w_down, g_ple, w_ple_gate, w_ple_proj):
    b, s, d = x.shape
    h = rms_norm(x, g_attn)
    z = jnp.matmul(h, w_in)
    offs = np.cumsum(IN_SPLITS)[:-1].tolist()
    qa, ka, va, qb, kb, vb, iq, ik, iw, ga, gb = jnp.split(z, offs, axis=-1)
    heads = lambda a, n: a.reshape(b, s, n, HEAD_DIM)
    qa = apply_rope(heads(qa, N_HEADS_MOBA), cos, sin)
    ka = apply_rope(heads(ka, N_HEADS_MOBA), cos, sin)
    va = heads(va, N_HEADS_MOBA)
    qb = apply_rope(heads(qb, N_HEADS_DSA), cos, sin)
    kb = apply_rope(heads(kb, N_HEADS_DSA), cos, sin)
    vb = heads(vb, N_HEADS_DSA)
    iq = apply_rope(iq.reshape(b, s, IDX_HEADS, IDX_DIM), cos, sin)
    ik = apply_rope(ik[:, :, None, :], cos, sin)[:, :, 0, :]
    o_a = moba_attention(qa, ka, va).reshape(b, s, A_W)
    o_b = dsa_attention(qb, kb, vb, iq, ik, iw).reshape(b, s, B_W)
    merged = (jax.nn.sigmoid(ga) * jnp.matmul(o_a, w_br_a)
              + jax.nn.sigmoid(gb) * jnp.matmul(o_b, w_br_b))
    x = x + jnp.matmul(merged, w_out)
    x = x + hier_moe(rms_norm(x, g_ffn), w_grp, b_grp, w_rt, b_rt, w_gate, w_up, w_down)
    gate = jax.nn.sigmoid(jnp.matmul(rms_norm(x, g_ple), w_ple_gate))
    x = x + gate * jnp.matmul(p_i, w_ple_proj)
    return x


def setup_inputs(seed: int = 0) -> dict:
    key = jax.random.key(seed)
    ks = jax.random.split(key, 20)
    f32 = jnp.float32
    nrm = lambda k, shape, fan_in: jax.random.normal(k, shape, f32) * (fan_in ** -0.5)
    gain = lambda k: 1.0 + 0.05 * jax.random.normal(k, (DEPTH, D_MODEL), f32)
    return {
        "x": jax.random.normal(ks[0], (BATCH, SEQ, D_MODEL), f32),
        "p": jax.random.normal(ks[1], (DEPTH, BATCH, SEQ, PLE_DIM), f32),
        "g_attn": gain(ks[2]),
        "w_in": nrm(ks[3], (DEPTH, D_MODEL, IN_COLS), D_MODEL),
        "w_br_a": nrm(ks[4], (DEPTH, A_W, D_MODEL), A_W),
        "w_br_b": nrm(ks[5], (DEPTH, B_W, D_MODEL), B_W),
        "w_out": nrm(ks[6], (DEPTH, D_MODEL, D_MODEL), D_MODEL),
        "g_ffn": gain(ks[7]),
        "w_grp": nrm(ks[8], (DEPTH, D_MODEL, N_GROUPS), D_MODEL),
        "b_grp": 0.01 * jax.random.normal(ks[9], (DEPTH, N_GROUPS), f32),
        "w_rt": nrm(ks[10], (DEPTH, D_MODEL, N_EXPERTS), D_MODEL),
        "b_rt": 0.01 * jax.random.normal(ks[11], (DEPTH, N_EXPERTS), f32),
        "w_gate": nrm(ks[12], (DEPTH, N_EXPERTS, D_MODEL, D_EXPERT), D_MODEL),
        "w_up": nrm(ks[13], (DEPTH, N_EXPERTS, D_MODEL, D_EXPERT), D_MODEL),
        "w_down": nrm(ks[14], (DEPTH, N_EXPERTS, D_EXPERT, D_MODEL), D_EXPERT),
        "g_ple": gain(ks[15]),
        "w_ple_gate": nrm(ks[16], (DEPTH, D_MODEL, D_MODEL), D_MODEL),
        "w_ple_proj": nrm(ks[17], (DEPTH, PLE_DIM, D_MODEL), PLE_DIM),
        "g_final": 1.0 + 0.05 * jax.random.normal(ks[18], (D_MODEL,), f32),
    }


def reference(x, p, g_attn, w_in, w_br_a, w_br_b, w_out, g_ffn, w_grp, b_grp, w_rt, b_rt,
              w_gate, w_up, w_down, g_ple, w_ple_gate, w_ple_proj, g_final):
    cos, sin = rope_tables(x.shape[1])
    for i in range(DEPTH):
        x = hybrid_layer(x, p[i], cos, sin, g_attn[i], w_in[i], w_br_a[i], w_br_b[i], w_out[i],
                         g_ffn[i], w_grp[i], b_grp[i], w_rt[i], b_rt[i], w_gate[i], w_up[i],
                         w_down[i], g_ple[i], w_ple_gate[i], w_ple_proj[i])
    return rms_norm(x, g_final)
```

```cpp
#include <hip/hip_runtime.h>
#include <hip/hip_bf16.h>
#include <cstdio>
#include <cstdint>
#include <cmath>

#ifndef MK_N_LAUNCHES
#define MK_N_LAUNCHES 0
#endif

namespace pg8 {
#define PG8_LAS __attribute__((address_space(3)))
typedef unsigned short bf16_t;
typedef short bf16x8 __attribute__((ext_vector_type(8)));
typedef float f32x4 __attribute__((ext_vector_type(4)));
typedef unsigned u32x4 __attribute__((ext_vector_type(4)));
typedef unsigned u32x2 __attribute__((ext_vector_type(2)));
constexpr int BM = 256, BK = 64, HALF = 128, HTB = HALF * BK * 2  , STAGE_BYTES = 8 * HTB, NXCD = 8, WGM = 8;

__host__ __device__ __forceinline__ int lds_byte(int r, int c) { const int st = (r >> 4) * 2 + (c >> 5), rr = r & 15, cc = c & 31, ob = rr * 64 + cc * 2; return st * 1024 + (ob ^ (((ob >> 9) & 1) << 5)); }
__host__ __device__ __forceinline__ void stage_rc(int b, int& R, int& C) { const int st = b / 1024, sb = b % 1024, swz = sb ^ (((sb >> 9) & 1) << 5); R = (st >> 1) * 16 + swz / 64; C = (st & 1) * 32 + (swz % 64) / 2; }
__host__ __device__ __forceinline__ int perm32(int rho) { const int n = rho >> 4, i = rho & 15; return 8 * (i >> 2) + 4 * n + (i & 3); }

struct Unit { int pm, pn; size_t boff; int e, valid; };
struct Gemm { const bf16_t* A; const bf16_t* Bt; int M, N, K; };

struct StaticOrder {
    int nM, nN, nwg, G, c;
    __host__ __device__ void init(int M, int N, int G_, int c_) { nM = M / BM; nN = N / BM; nwg = nM * nN; G = G_; c = c_; }
    __host__ __device__ bool next(int i, Unit& u) const {
        const long L = (long)i * G + c; if (L >= nwg) return false;
        int wgid = (int)L; { const int q = nwg / NXCD, r = nwg % NXCD, xcd = wgid % NXCD, off = wgid / NXCD; wgid = (xcd < r ? xcd * (q + 1) : r * (q + 1) + (xcd - r) * q) + off; }
        const int nig = WGM * nN, gid = wgid / nig, fm = gid * WGM, gsz = (nM - fm) < WGM ? (nM - fm) : WGM;
        u.pm = fm + ((wgid % nig) % gsz); u.pn = (wgid % nig) / gsz; u.boff = 0; u.e = 0; u.valid = 256; return true;
    }
    __device__ __forceinline__ void a_ready(const Unit&) const {}
    __device__ __forceinline__ void done(const Unit&) const {}
    __device__ __forceinline__ unsigned arow(int, int) const { return 0u; }
};

__device__ __forceinline__ unsigned cvt_pk_bf16(float lo, float hi) { unsigned r; asm volatile("v_cvt_pk_bf16_f32 %0, %1, %2" : "=v"(r) : "v"(lo), "v"(hi)); return r; }
__device__ __forceinline__ u32x4 pack8(const f32x4 a, const f32x4 b) { u32x4 w; w.x = cvt_pk_bf16(a[0], a[1]); w.y = cvt_pk_bf16(a[2], a[3]); w.z = cvt_pk_bf16(b[0], b[1]); w.w = cvt_pk_bf16(b[2], b[3]); return w; }
__device__ __forceinline__ float bf_lo(unsigned w) { return __uint_as_float(w << 16); }
__device__ __forceinline__ float bf_hi(unsigned w) { return __uint_as_float(w & 0xffff0000u); }
__device__ __forceinline__ void unpack8(const u32x4 w, f32x4& a, f32x4& b) { a[0] = bf_lo(w.x); a[1] = bf_hi(w.x); a[2] = bf_lo(w.y); a[3] = bf_hi(w.y); b[0] = bf_lo(w.z); b[1] = bf_hi(w.z); b[2] = bf_lo(w.w); b[3] = bf_hi(w.w); }
__device__ __forceinline__ float sigmoidf_(float v) { return __builtin_amdgcn_rcpf(1.0f + __builtin_amdgcn_exp2f(-1.4426950408889634f * v)); }

template <class Epi, class Sched, bool ALIGN_EPI = false, bool SP2 = false, bool GATHER = false>
__device__ __forceinline__ void gemm_phase(PG8_LAS unsigned char* lds, const Gemm g, const Sched& S, const Epi& E) {
    const int tid = threadIdx.x, wid = __builtin_amdgcn_readfirstlane(tid >> 6), lane = tid & 63, wr = wid >> 2, wc = wid & 3, fr = lane & 15, fq = lane >> 4;
    int Kl_ = g.K; asm volatile("" : "+s"(Kl_));
    const int K = Kl_, nt = K / BK;
    unsigned voffA[2], voffB[2], stC2[2]; int stR[2];
#pragma unroll
    for (int i = 0; i < 2; ++i) { int R, C; stage_rc(tid * 16 + i * 8192, R, C); const int Rb = Epi::PERM ? ((R & ~31) + perm32(R & 31)) : R;
        voffA[i] = (unsigned)(R * K + C) * 2u; voffB[i] = (unsigned)(Rb * K + C) * 2u; stR[i] = R; stC2[i] = (unsigned)C * 2u; }
    const size_t kstep = (size_t)(BK * 2);
    const size_t hstep = (size_t)HALF * K * 2;
    const size_t tstep = 2 * hstep;
    const unsigned ldsw = (unsigned)wid * 1024u;
    const int aoff = lds_byte(wr * 64 + fr, fq * 8), boff = lds_byte(wc * 32 + fr, fq * 8);
#define PG8_SA(b, h) (((b) * 2 + (h)) * HTB)
#define PG8_SB(b, h) ((4 + (b) * 2 + (h)) * HTB)
#define PG8_STAGE(bufoff, gbase, voff) do { _Pragma("unroll") for (int _i = 0; _i < 2; ++_i) \
        __builtin_amdgcn_global_load_lds((const unsigned*)((const char*)(gbase) + (voff)[_i]), (PG8_LAS unsigned*)(lds + (bufoff) + ldsw + _i * 8192), 16, 0, 0); } while (0)
#define PG8_STAGE_A(bufoff, base, h, NX) do { if constexpr (GATHER) { unsigned _v[2]; _v[0] = (NX) ? gAn[h][0] : gAc[h][0]; _v[1] = (NX) ? gAn[h][1] : gAc[h][1]; PG8_STAGE(bufoff, base, _v); } \
        else { PG8_STAGE(bufoff, (base) + (h) * hstep, voffA); } } while (0)
#define PG8_LDA(dst, b, h) do { _Pragma("unroll") for (int m = 0; m < 4; ++m) _Pragma("unroll") for (int k = 0; k < 2; ++k) dst[m][k] = *(const PG8_LAS bf16x8*)(lds + PG8_SA(b, h) + aoff + m * 2048 + k * 1024); } while (0)
#define PG8_LDB(dst, b, h) do { _Pragma("unroll") for (int n = 0; n < 2; ++n) _Pragma("unroll") for (int k = 0; k < 2; ++k) dst[n][k] = *(const PG8_LAS bf16x8*)(lds + PG8_SB(b, h) + boff + n * 2048 + k * 1024); } while (0)
#define PG8_MMA(ai, bj, At, Bt) do { __builtin_amdgcn_s_setprio(1); _Pragma("unroll") for (int m = 0; m < 4; ++m) _Pragma("unroll") for (int n = 0; n < 2; ++n) _Pragma("unroll") for (int k = 0; k < 2; ++k) \
        acc[ai][bj][m][n] = __builtin_amdgcn_mfma_f32_16x16x32_bf16(Bt[n][k], At[m][k], acc[ai][bj][m][n], 0, 0, 0); __builtin_amdgcn_s_setprio(0); } while (0)
#define PG8_WAIT_V(n) asm volatile("s_waitcnt vmcnt(" #n ")" ::: "memory")
#define PG8_WAIT_L(n) asm volatile("s_waitcnt lgkmcnt(" #n ")" ::: "memory")
#define PG8_BAR __builtin_amdgcn_s_barrier()
#define PG8_SCHED __builtin_amdgcn_sched_barrier(0)
    Unit cur, nxt; int ui = 0;
    if (!S.next(0, cur)) return;
    f32x4 acc[2][2][4][2];
#pragma unroll
    for (int a = 0; a < 2; ++a)
#pragma unroll
        for (int b = 0; b < 2; ++b)
#pragma unroll
            for (int m = 0; m < 4; ++m)
#pragma unroll
                for (int n = 0; n < 2; ++n) acc[a][b][m][n] = (f32x4){0.f, 0.f, 0.f, 0.f};
    bf16x8 At[4][2], B0[2][2], B1[2][2];
    const char* cA = GATHER ? (const char*)g.A : (const char*)g.A + (size_t)cur.pm * tstep; const char* cB = (const char*)g.Bt + cur.boff + (size_t)cur.pn * tstep;
    unsigned gAc[2][2], gAn[2][2];
    if constexpr (GATHER) { _Pragma("unroll") for (int h = 0; h < 2; ++h) _Pragma("unroll") for (int i = 0; i < 2; ++i) { gAc[h][i] = S.arow(0, h * HALF + stR[i]) + stC2[i]; gAn[h][i] = gAc[h][i]; } }
    S.a_ready(cur);
    if constexpr (SP2) {
        PG8_STAGE(PG8_SB(0, 0), cB, voffB); PG8_STAGE(PG8_SB(0, 1), cB + hstep, voffB); PG8_STAGE_A(PG8_SA(0, 0), cA, 0, false); PG8_STAGE_A(PG8_SA(0, 1), cA, 1, false);
        if (wr == 1) PG8_BAR;
        PG8_WAIT_V(2); PG8_BAR;
        PG8_STAGE(PG8_SB(1, 0), cB + kstep, voffB); PG8_STAGE_A(PG8_SA(1, 0), cA + kstep, 0, false); PG8_STAGE(PG8_SB(1, 1), cB + hstep + kstep, voffB);
        PG8_WAIT_V(6); PG8_BAR;
    } else {
        PG8_STAGE(PG8_SB(0, 0), cB, voffB); PG8_STAGE_A(PG8_SA(0, 0), cA, 0, false); PG8_STAGE(PG8_SB(0, 1), cB + hstep, voffB); PG8_STAGE_A(PG8_SA(0, 1), cA, 1, false);
        if (wr == 1) PG8_BAR;
        PG8_WAIT_V(4); PG8_BAR;
        PG8_STAGE(PG8_SB(1, 0), cB + kstep, voffB); PG8_STAGE_A(PG8_SA(1, 0), cA + kstep, 0, false); PG8_STAGE(PG8_SB(1, 1), cB + hstep + kstep, voffB);
        PG8_WAIT_V(6); PG8_BAR;
    }
    for (;;) {
        const bool has_next = S.next(ui + 1, nxt);
        const char* nA = GATHER ? cA : (has_next ? (const char*)g.A + (size_t)nxt.pm * tstep : cA); const char* nB = has_next ? (const char*)g.Bt + nxt.boff + (size_t)nxt.pn * tstep : cB;
        if constexpr (GATHER) { if (has_next) { _Pragma("unroll") for (int h = 0; h < 2; ++h) _Pragma("unroll") for (int i = 0; i < 2; ++i) gAn[h][i] = S.arow(ui + 1, h * HALF + stR[i]) + stC2[i]; } }
        for (int t = 0; t < nt; t += 2) {
            const bool last = (t == nt - 2);
            const char* a1 = cA + (size_t)(t + 1) * kstep;
            const char* a2 = last ? nA : cA + (size_t)(t + 2) * kstep; const char* b2 = last ? nB : cB + (size_t)(t + 2) * kstep;
            const char* a3 = a2 + kstep; const char* b3 = b2 + kstep;
            if (last && has_next) S.a_ready(nxt);
            if constexpr (SP2) {
            PG8_LDB(B0, 0, 0); PG8_LDB(B1, 0, 1); PG8_SCHED; PG8_LDA(At, 0, 0); PG8_STAGE_A(PG8_SA(1, 1), a1, 1, false);
            PG8_WAIT_V(8); PG8_WAIT_L(0); PG8_BAR; PG8_MMA(0, 0, At, B0); PG8_MMA(0, 1, At, B1); PG8_BAR; PG8_SCHED;
            PG8_LDA(At, 0, 1); PG8_STAGE(PG8_SB(0, 0), b2, voffB); PG8_STAGE(PG8_SB(0, 1), b2 + hstep, voffB); PG8_STAGE_A(PG8_SA(0, 0), a2, 0, last);
            PG8_WAIT_V(8); PG8_WAIT_L(0); PG8_BAR; PG8_MMA(1, 0, At, B0); PG8_MMA(1, 1, At, B1); PG8_BAR; PG8_SCHED;
            PG8_LDB(B0, 1, 0); PG8_LDB(B1, 1, 1); PG8_SCHED; PG8_LDA(At, 1, 0); PG8_STAGE_A(PG8_SA(0, 1), a2, 1, last);
            PG8_WAIT_V(8); PG8_WAIT_L(0); PG8_BAR; PG8_MMA(0, 0, At, B0); PG8_MMA(0, 1, At, B1); PG8_BAR; PG8_SCHED;
            PG8_LDA(At, 1, 1); PG8_STAGE(PG8_SB(1, 0), b3, voffB); PG8_STAGE(PG8_SB(1, 1), b3 + hstep, voffB); PG8_STAGE_A(PG8_SA(1, 0), a3, 0, last);
            PG8_WAIT_V(8); PG8_WAIT_L(0); PG8_BAR; PG8_MMA(1, 0, At, B0); PG8_MMA(1, 1, At, B1); PG8_BAR; PG8_SCHED;
            } else {
            PG8_LDB(B0, 0, 0); PG8_SCHED; PG8_LDA(At, 0, 0); PG8_STAGE_A(PG8_SA(1, 1), a1, 1, false);
            PG8_WAIT_L(8); PG8_BAR; PG8_WAIT_L(0); PG8_MMA(0, 0, At, B0); PG8_BAR; PG8_SCHED;
            PG8_LDB(B1, 0, 1); PG8_STAGE(PG8_SB(0, 0), b2, voffB);
            PG8_BAR; PG8_WAIT_L(0); PG8_MMA(0, 1, At, B1); PG8_BAR;
            PG8_LDA(At, 0, 1); PG8_STAGE_A(PG8_SA(0, 0), a2, 0, last);
            PG8_BAR; PG8_WAIT_L(0); PG8_MMA(1, 0, At, B0); PG8_BAR; PG8_SCHED;
            PG8_STAGE(PG8_SB(0, 1), b2 + hstep, voffB);
            PG8_WAIT_V(6); PG8_BAR; PG8_MMA(1, 1, At, B1); PG8_BAR;
            PG8_LDB(B0, 1, 0); PG8_SCHED; PG8_LDA(At, 1, 0); PG8_STAGE_A(PG8_SA(0, 1), a2, 1, last);
            PG8_WAIT_L(8); PG8_BAR; PG8_WAIT_L(0); PG8_MMA(0, 0, At, B0); PG8_BAR; PG8_SCHED;
            PG8_LDB(B1, 1, 1); PG8_STAGE(PG8_SB(1, 0), b3, voffB);
            PG8_BAR; PG8_WAIT_L(0); PG8_MMA(0, 1, At, B1); PG8_BAR;
            PG8_LDA(At, 1, 1); PG8_STAGE_A(PG8_SA(1, 0), a3, 0, last);
            PG8_BAR; PG8_WAIT_L(0); PG8_MMA(1, 0, At, B0); PG8_BAR; PG8_SCHED;
            PG8_STAGE(PG8_SB(1, 1), b3 + hstep, voffB);
            PG8_WAIT_V(6); PG8_BAR; PG8_MMA(1, 1, At, B1); PG8_BAR;
            }
        }
        if constexpr (ALIGN_EPI) { if (wr == 0) PG8_BAR; }
        if constexpr (!Epi::AFTER_DRAIN) { E(acc, cur, ui, wr, wc, fr, fq); S.done(cur); }
        if (!has_next) break;
#pragma unroll
        for (int a = 0; a < 2; ++a)
#pragma unroll
            for (int b = 0; b < 2; ++b)
#pragma unroll
                for (int m = 0; m < 4; ++m)
#pragma unroll
                    for (int n = 0; n < 2; ++n) acc[a][b][m][n] = (f32x4){0.f, 0.f, 0.f, 0.f};
        cur = nxt; cA = nA; cB = nB; ++ui;
        if constexpr (GATHER) { _Pragma("unroll") for (int h = 0; h < 2; ++h) _Pragma("unroll") for (int i = 0; i < 2; ++i) gAc[h][i] = gAn[h][i]; }
        if constexpr (ALIGN_EPI) { if (wr == 1) PG8_BAR; }
    }
    PG8_WAIT_V(0);
    if constexpr (!ALIGN_EPI) { if (wr == 0) PG8_BAR; }
    PG8_BAR;
#undef PG8_SA
#undef PG8_SB
#undef PG8_STAGE
#undef PG8_STAGE_A
#undef PG8_LDA
#undef PG8_LDB
#undef PG8_MMA
#undef PG8_WAIT_V
#undef PG8_WAIT_L
#undef PG8_BAR
#undef PG8_SCHED
}


constexpr int BATCH = 8, SEQ = 4096, DMODEL = 1024, TOK = BATCH * SEQ;
constexpr int NHEAD = 8, HD = 64, AW = 512;
constexpr int IN_COLS = 5704, ZN = 5888;
constexpr int NEXP = 32, DEXP = 512, PLE = 256;
constexpr float RMS_EPS = 1e-6f;
constexpr float C2 = 0.125f * 1.4426950408889634f;
constexpr float IW_SCALE = 0.125f * 0.35355339059327373f;

struct EpiZ {
    static constexpr bool PERM = true, AFTER_DRAIN = false;
    bf16_t *QA, *KA, *VA, *QB, *KB, *VB, *IQ, *IK, *GA, *GB; float* IW; float* kmean; const float* ropec; const float* ropes;
    __device__ __forceinline__ void operator()(f32x4 (&acc)[2][2][4][2], const Unit& u, int, int wr, int wc, int fr, int fq) const {
        const int pn = u.pn;
        bf16_t* dst; int ld, colt; bool rope_t = false, isq = false, iskm = false, issig = false;
        if (pn < 14) { const int t = pn >> 1; colt = (pn & 1) * 256; ld = AW;
            dst = t == 0 ? QA : t == 1 ? KA : t == 2 ? VA : t == 3 ? QB : t == 4 ? KB : t == 5 ? VB : IQ;
            rope_t = (t != 2 && t != 5); isq = (t == 0 || t == 3); iskm = (t == 1); }
        else if (pn == 14) { dst = IK; ld = 64; colt = 0; rope_t = true; }
        else { const int t = (pn - 15) >> 2; dst = t == 0 ? GA : GB; ld = DMODEL; colt = ((pn - 15) & 3) * 256; issig = true; }
        const bool rope_w = rope_t && ((wc & 1) == 0);
        const float rs = (fq == 0) ? -1.f : 1.f; const bool rl = fq < 2;
        f32x4 cs[2][2];
#pragma unroll
        for (int bj = 0; bj < 2; ++bj)
#pragma unroll
            for (int n = 0; n < 2; ++n) cs[bj][n] = (f32x4){0.f, 0.f, 0.f, 0.f};
#pragma unroll
        for (int ai = 0; ai < 2; ++ai)
#pragma unroll
            for (int m = 0; m < 4; ++m) {
                const int row = u.pm * BM + ai * HALF + wr * 64 + m * 16 + fr; const int pos = row & (SEQ - 1);
                f32x4 c0 = (f32x4){1.f, 1.f, 1.f, 1.f}, c1 = c0, s0 = (f32x4){0.f, 0.f, 0.f, 0.f}, s1 = s0;
                if (rope_w) { const f32x4 a = *(const f32x4*)(ropec + pos * 8), b = *(const f32x4*)(ropec + pos * 8 + 4), c = *(const f32x4*)(ropes + pos * 8), d = *(const f32x4*)(ropes + pos * 8 + 4);
                    if (rl) { c0 = a; c1 = b; s0 = c * rs; s1 = d * rs; } }
#pragma unroll
                for (int bj = 0; bj < 2; ++bj) {
                    f32x4 v0 = acc[ai][bj][m][0], v1 = acc[ai][bj][m][1];
                    if (pn == 14 && bj == 1) continue;
                    if (rope_w && !(pn == 14 && wc != 0)) {
                        f32x4 o0, o1;
#pragma unroll
                        for (int i = 0; i < 4; ++i) { o0[i] = __shfl_xor(v0[i], 16); o1[i] = __shfl_xor(v1[i], 16); }
                        v0 = v0 * c0 + o0 * s0; v1 = v1 * c1 + o1 * s1;
                    }
                    if (isq) { v0 = v0 * C2; v1 = v1 * C2; }
                    if (iskm) { cs[bj][0] += v0; cs[bj][1] += v1; }
                    if (issig) {
#pragma unroll
                        for (int i = 0; i < 4; ++i) { v0[i] = sigmoidf_(v0[i]); v1[i] = sigmoidf_(v1[i]); } }
                    const int col = bj * HALF + wc * 32 + 8 * fq;
                    if (pn == 14) {
                        if (wc < 2) *(u32x4*)(dst + (size_t)row * 64 + col) = pack8(v0, v1);
                        else if (wc == 2 && fq == 0) { *(f32x4*)(IW + (size_t)row * 8) = v0 * IW_SCALE; *(f32x4*)(IW + (size_t)row * 8 + 4) = v1 * IW_SCALE; }
                    } else *(u32x4*)(dst + (size_t)row * ld + colt + col) = pack8(v0, v1);
                }
            }
        if (iskm) {
            const int b = u.pm >> 4, blk = u.pm & 15;
#pragma unroll
            for (int bj = 0; bj < 2; ++bj)
#pragma unroll
                for (int n = 0; n < 2; ++n)
#pragma unroll
                    for (int i = 0; i < 4; ++i) { float s = cs[bj][n][i]; s += __shfl_xor(s, 1); s += __shfl_xor(s, 2); s += __shfl_xor(s, 4); s += __shfl_xor(s, 8);
                        if (fr == 0) { const int col = (pn & 1) * 256 + bj * HALF + wc * 32 + 8 * fq + 4 * n + i; const int h = col >> 6, d = col & 63;
                            atomicAdd(kmean + ((size_t)((b * NHEAD + h) * 16 + blk) * 64 + d), s * (1.0f / 256.0f)); } }
        }
    }
};
struct EpiStoreBf16 {
    static constexpr bool PERM = true, AFTER_DRAIN = false;
    bf16_t* O; int ld;
    __device__ __forceinline__ void operator()(f32x4 (&acc)[2][2][4][2], const Unit& u, int, int wr, int wc, int fr, int fq) const {
#pragma unroll
        for (int ai = 0; ai < 2; ++ai)
#pragma unroll
            for (int m = 0; m < 4; ++m) { const int row = u.pm * BM + ai * HALF + wr * 64 + m * 16 + fr;
#pragma unroll
                for (int bj = 0; bj < 2; ++bj) { const int col = u.pn * BM + bj * HALF + wc * 32 + 8 * fq;
                    *(u32x4*)(O + (size_t)row * ld + col) = pack8(acc[ai][bj][m][0], acc[ai][bj][m][1]); } }
    }
};
template <int MODE> struct EpiBranch {
    static constexpr bool PERM = true, AFTER_DRAIN = false;
    const bf16_t* G; const bf16_t* Tin; bf16_t* O;
    __device__ __forceinline__ void operator()(f32x4 (&acc)[2][2][4][2], const Unit& u, int, int wr, int wc, int fr, int fq) const {
#pragma unroll
        for (int ai = 0; ai < 2; ++ai)
#pragma unroll
            for (int m = 0; m < 4; ++m) { const int row = u.pm * BM + ai * HALF + wr * 64 + m * 16 + fr;
#pragma unroll
                for (int bj = 0; bj < 2; ++bj) { const size_t off = (size_t)row * DMODEL + u.pn * BM + bj * HALF + wc * 32 + 8 * fq;
                    f32x4 g0, g1; unpack8(*(const u32x4*)(G + off), g0, g1);
                    f32x4 v0 = acc[ai][bj][m][0] * g0, v1 = acc[ai][bj][m][1] * g1;
                    if (MODE == 1) { f32x4 t0, t1; unpack8(*(const u32x4*)(Tin + off), t0, t1); v0 += t0; v1 += t1; }
                    *(u32x4*)(O + off) = pack8(v0, v1); } }
    }
};
struct EpiResidual {
    static constexpr bool PERM = false, AFTER_DRAIN = false;
    const float* base; float* out;
    __device__ __forceinline__ void operator()(f32x4 (&acc)[2][2][4][2], const Unit& u, int, int wr, int wc, int fr, int fq) const {
#pragma unroll
        for (int ai = 0; ai < 2; ++ai)
#pragma unroll
            for (int m = 0; m < 4; ++m) { const int row = u.pm * BM + ai * HALF + wr * 64 + m * 16 + fr;
#pragma unroll
                for (int bj = 0; bj < 2; ++bj)
#pragma unroll
                    for (int n = 0; n < 2; ++n) { const size_t off = (size_t)row * DMODEL + u.pn * BM + bj * HALF + wc * 32 + 16 * n + 4 * fq;
                        *(f32x4*)(out + off) = *(const f32x4*)(base + off) + acc[ai][bj][m][n]; } }
    }
};
struct EpiPle {
    static constexpr bool PERM = false, AFTER_DRAIN = false;
    float* x; const bf16_t* P; float* stats;
    __device__ __forceinline__ void operator()(f32x4 (&acc)[2][2][4][2], const Unit& u, int, int wr, int wc, int fr, int fq) const {
#pragma unroll
        for (int ai = 0; ai < 2; ++ai)
#pragma unroll
            for (int m = 0; m < 4; ++m) { const int row = u.pm * BM + ai * HALF + wr * 64 + m * 16 + fr; float ss = 0.f;
#pragma unroll
                for (int bj = 0; bj < 2; ++bj)
#pragma unroll
                    for (int n = 0; n < 2; ++n) { const size_t off = (size_t)row * DMODEL + u.pn * BM + bj * HALF + wc * 32 + 16 * n + 4 * fq;
                        const u32x2 pw = *(const u32x2*)(P + off); const f32x4 pv = (f32x4){bf_lo(pw.x), bf_hi(pw.x), bf_lo(pw.y), bf_hi(pw.y)};
                        f32x4 g = acc[ai][bj][m][n];
#pragma unroll
                        for (int i = 0; i < 4; ++i) g[i] = sigmoidf_(g[i]);
                        const f32x4 o = *(const f32x4*)(x + off) + g * pv; *(f32x4*)(x + off) = o;
                        ss += (o[0] * o[0] + o[1] * o[1]) + (o[2] * o[2] + o[3] * o[3]); }
                ss += __shfl_xor(ss, 16); ss += __shfl_xor(ss, 32);
                if (fq == 0) stats[(size_t)row * 16 + u.pn * 4 + wc] = ss; }
    }
};
struct EpiSwiglu {
    static constexpr bool PERM = true, AFTER_DRAIN = false;
    bf16_t* HID;
    __device__ __forceinline__ void operator()(f32x4 (&acc)[2][2][4][2], const Unit& u, int, int wr, int wc, int fr, int fq) const {
#pragma unroll
        for (int ai = 0; ai < 2; ++ai)
#pragma unroll
            for (int m = 0; m < 4; ++m) { const int row = u.pm * BM + ai * HALF + wr * 64 + m * 16 + fr;
                f32x4 h0, h1;
#pragma unroll
                for (int i = 0; i < 4; ++i) { const float g0 = acc[ai][0][m][0][i], g1 = acc[ai][0][m][1][i];
                    h0[i] = g0 * sigmoidf_(g0) * acc[ai][1][m][0][i]; h1[i] = g1 * sigmoidf_(g1) * acc[ai][1][m][1][i]; }
                *(u32x4*)(HID + (size_t)row * DEXP + u.pn * HALF + wc * 32 + 8 * fq) = pack8(h0, h1); }
    }
};
struct EpiDown {
    static constexpr bool PERM = true, AFTER_DRAIN = false;
    bf16_t* Y; const PG8_LAS int* tokk; const PG8_LAS float* wt;
    __device__ __forceinline__ void operator()(f32x4 (&acc)[2][2][4][2], const Unit& u, int ui, int wr, int wc, int fr, int fq) const {
#pragma unroll
        for (int ai = 0; ai < 2; ++ai)
#pragma unroll
            for (int m = 0; m < 4; ++m) { const int r = ai * HALF + wr * 64 + m * 16 + fr;
                const int tk = tokk[ui * 256 + r]; const float w = wt[ui * 256 + r];
#pragma unroll
                for (int bj = 0; bj < 2; ++bj)
                    *(u32x4*)(Y + (size_t)tk * DMODEL + u.pn * BM + bj * HALF + wc * 32 + 8 * fq) = pack8(acc[ai][bj][m][0] * w, acc[ai][bj][m][1] * w); }
    }
};
}

namespace att {
using bf16x8 = __attribute__((ext_vector_type(8))) short;
using s16x4 = __attribute__((ext_vector_type(4))) short;
using f32x16 = __attribute__((ext_vector_type(16))) float;
using u32x4 = __attribute__((ext_vector_type(4))) unsigned;
using u32x2 = __attribute__((ext_vector_type(2))) unsigned;
typedef unsigned short bf16r;
constexpr int SEQL = 4096, D = 64, DM = 512;
constexpr int NW = 8, QBLK = 32, QB = QBLK * NW, KVBLK = 64;
constexpr int SLOTB = 8192, NSLOT = 2;
constexpr int LDS_K = 0, LDS_V = NSLOT * SLOTB, LDS_WS = 2 * NSLOT * SLOTB, LDS_OST = LDS_WS + NW * 64 * 4, LDS_KM = LDS_OST + NW * 4096, LDS_BYTES = LDS_KM + 16 * 64 * 4;
constexpr float THR = 8.0f;
__device__ __forceinline__ int crow(int r, int hi) { return (r & 3) + 8 * (r >> 2) + 4 * hi; }
__device__ __forceinline__ void glds16(const void* gsrc, unsigned lds_dst) { unsigned keep;
    asm volatile("s_mov_b32 %0, m0\n\ts_mov_b32 m0, %2\n\ts_nop 0\n\tglobal_load_lds_dwordx4 %1, off\n\ts_mov_b32 m0, %0" : "=&s"(keep) : "v"(gsrc), "s"(lds_dst) : "memory"); }
typedef float f32x2_t __attribute__((ext_vector_type(2))); typedef __bf16 bf16x2_t __attribute__((ext_vector_type(2)));
__device__ __forceinline__ unsigned cvtpk_s(float lo, float hi) { f32x2_t v = {lo, hi}; bf16x2_t b = __builtin_convertvector(v, bf16x2_t); return __builtin_bit_cast(unsigned, b); }
__device__ __forceinline__ void qkt(f32x16& p0, f32x16& p1, const char* Kslot, const bf16x8* qr, const f32x16& cin, int r32, int hi) {
    const char* kb = Kslot + hi * 1024 + r32 * 16;
#pragma unroll
    for (int d0 = 0; d0 < 4; ++d0) {
        const bf16x8 b0 = *reinterpret_cast<const bf16x8*>(kb + d0 * 2048);
        const bf16x8 b1 = *reinterpret_cast<const bf16x8*>(kb + d0 * 2048 + 512);
        if (d0 == 0) { p0 = __builtin_amdgcn_mfma_f32_32x32x16_bf16(b0, qr[0], cin, 0, 0, 0); p1 = __builtin_amdgcn_mfma_f32_32x32x16_bf16(b1, qr[0], cin, 0, 0, 0); }
        else { p0 = __builtin_amdgcn_mfma_f32_32x32x16_bf16(b0, qr[d0], p0, 0, 0, 0); p1 = __builtin_amdgcn_mfma_f32_32x32x16_bf16(b1, qr[d0], p1, 0, 0, 0); } }
}
__device__ __forceinline__ float rowmax(const f32x16& p0, const f32x16& p1) {
    float a = __builtin_fmaxf(p0[0], p1[0]);
#pragma unroll
    for (int r = 1; r < 16; ++r) a = __builtin_fmaxf(a, __builtin_fmaxf(p0[r], p1[r]));
    auto rr = __builtin_amdgcn_permlane32_swap(__float_as_uint(a), __float_as_uint(a), false, false);
    return __builtin_fmaxf(__uint_as_float(rr[0]), __uint_as_float(rr[1]));
}
__device__ __forceinline__ void pv(f32x16* o, int vb, bf16x8 pa0, bf16x8 pa1, bf16x8 pa2, bf16x8 pa3) {
#pragma unroll
    for (int d0 = 0; d0 < 2; ++d0) { s16x4 lo[4], hi[4];
#pragma unroll
        for (int ks = 0; ks < 4; ++ks) {
            asm volatile("ds_read_b64_tr_b16 %0,%1 offset:%c2" : "=&v"(lo[ks]) : "v"(vb), "i"(d0 * 4096 + ks * 1024) : "memory");
            asm volatile("ds_read_b64_tr_b16 %0,%1 offset:%c2" : "=&v"(hi[ks]) : "v"(vb), "i"(d0 * 4096 + ks * 1024 + 512) : "memory"); }
        asm volatile("s_waitcnt lgkmcnt(0)" ::: "memory"); __builtin_amdgcn_sched_barrier(0);
#define ATT_PK(k) (bf16x8){lo[k][0], lo[k][1], lo[k][2], lo[k][3], hi[k][0], hi[k][1], hi[k][2], hi[k][3]}
        o[d0] = __builtin_amdgcn_mfma_f32_32x32x16_bf16(pa0, ATT_PK(0), o[d0], 0, 0, 0);
        o[d0] = __builtin_amdgcn_mfma_f32_32x32x16_bf16(pa1, ATT_PK(1), o[d0], 0, 0, 0);
        o[d0] = __builtin_amdgcn_mfma_f32_32x32x16_bf16(pa2, ATT_PK(2), o[d0], 0, 0, 0);
        o[d0] = __builtin_amdgcn_mfma_f32_32x32x16_bf16(pa3, ATT_PK(3), o[d0], 0, 0, 0);
#undef ATT_PK
    }
}
#define ATT_WAIT_BAR0() asm volatile("s_waitcnt vmcnt(0) lgkmcnt(0)\n\ts_barrier" ::: "memory")

template <int MODE> __device__ __forceinline__ void attn_unit(int b, int h, int qb, const bf16r* Q, const bf16r* __restrict__ K, const bf16r* __restrict__ V, bf16r* O, const void* aux, char* shm) {
    const int tid = threadIdx.x, lane = tid & 63, r32 = lane & 31, hi = lane >> 5; const int wid = __builtin_amdgcn_readfirstlane(tid >> 6);
    const long rowbase = (long)b * SEQL; const int q0 = qb * QB;
    const bf16r* Qw = Q + (rowbase + q0 + wid * QBLK) * DM + h * D;
    const bf16r* Kh = K + rowbase * DM + h * D, *Vh = V + rowbase * DM + h * D;
    const unsigned lds0 = (unsigned)(uintptr_t)shm;
    float* wsf = (float*)(shm + LDS_WS) + wid * 64;
    const bf16r* ksrc = Kh + (long)lane * DM + wid * 8;
    const bf16r* vsrc = Vh + (long)(16 * (wid & 3) + (lane >> 2)) * DM + (wid >> 2) * 32 + (lane & 3) * 8;
    const unsigned kdst = lds0 + LDS_K + wid * 1024, vdst = lds0 + LDS_V + wid * 1024;
#define DMA_K(t, slot) glds16(ksrc + (long)(t) * KVBLK * DM, (unsigned)__builtin_amdgcn_readfirstlane(kdst + (slot)))
#define DMA_V(t, slot) glds16(vsrc + (long)(t) * KVBLK * DM, (unsigned)__builtin_amdgcn_readfirstlane(vdst + (slot)))
    const int vb0 = (int)(lds0 + LDS_V) + ((lane >> 4) & 1) * 32 + (lane & 3) * 8 + (4 * hi + ((lane & 15) >> 2)) * 64;
    const char* Kbase = shm + LDS_K;
    const int NT = (q0 + QB) / KVBLK;
    DMA_K(0, 0); DMA_V(0, 0);
    bf16x8 qr[4];
#pragma unroll
    for (int d0 = 0; d0 < 4; ++d0) qr[d0] = *reinterpret_cast<const bf16x8*>(&Qw[(long)r32 * DM + d0 * 16 + hi * 8]);
    unsigned selmask = 0u;
    if (MODE == 0) {
        float* km = (float*)(shm + LDS_KM); const float* kmg = (const float*)aux + (size_t)(b * 8 + h) * 16 * 64;
        for (int i = tid; i < 16 * 64; i += NW * 64) km[i] = kmg[i];
        asm volatile("s_waitcnt vmcnt(0) lgkmcnt(0)" ::: "memory"); __syncthreads();
        float g[15];
#pragma unroll
        for (int j = 0; j < 15; ++j) { g[j] = -INFINITY;
            if (j < qb) { float s = 0.f;
#pragma unroll
                for (int d0 = 0; d0 < 4; ++d0)
#pragma unroll
                    for (int e = 0; e < 8; ++e) s += __uint_as_float(((unsigned)(unsigned short)qr[d0][e]) << 16) * km[j * 64 + d0 * 16 + hi * 8 + e];
                auto rr = __builtin_amdgcn_permlane32_swap(__float_as_uint(s), __float_as_uint(s), false, false);
                g[j] = __uint_as_float(rr[0]) + __uint_as_float(rr[1]); } }
#pragma unroll
        for (int k = 0; k < 3; ++k) { float best = -INFINITY; int bi = -1;
#pragma unroll
            for (int j = 0; j < 15; ++j) if (j < qb && !((selmask >> j) & 1u) && g[j] > best) { best = g[j]; bi = j; }
            if (bi >= 0) selmask |= 1u << bi; }
    }
    const unsigned* mrow = nullptr;
    if (MODE == 1) mrow = (const unsigned*)aux + (size_t)(rowbase + q0 + wid * QBLK + r32) * 128;
    float mhat = 0.f, l_reg = 0.f; f32x16 o[2]; o[0] = f32x16{}; o[1] = f32x16{};
    const int qrel = wid * QBLK + r32;
    for (int t = 0; t < NT; ++t) {
        ATT_WAIT_BAR0();
        if (t + 1 < NT) { DMA_K(t + 1, ((t + 1) & 1) * SLOTB); DMA_V(t + 1, ((t + 1) & 1) * SLOTB); }
        u32x2 mw = (u32x2){0u, 0u};
        if (MODE == 1) mw = *(const u32x2*)(mrow + 2 * t);
        float c = -mhat;
        if (MODE == 0 && t < NT - 4) { if (!((selmask >> (t >> 2)) & 1u)) c = -1e30f; }
        f32x16 cin;
#pragma unroll
        for (int r = 0; r < 16; ++r) cin[r] = c;
        f32x16 p0, p1;
        qkt(p0, p1, Kbase + (t & 1) * SLOTB, qr, cin, r32, hi);
        if (MODE == 0) { const int jb = t - (NT - 4);
            if (jb >= 0) { const int kb = 64 * jb + 4 * hi;
#pragma unroll
                for (int r = 0; r < 16; ++r) { const int kv = kb + (r & 3) + 8 * (r >> 2); if (kv > qrel) p0[r] = -INFINITY; if (kv + 32 > qrel) p1[r] = -INFINITY; } } }
        else { const unsigned w0 = mw.x >> (4 * hi), w1 = mw.y >> (4 * hi);
#pragma unroll
            for (int r = 0; r < 16; ++r) { const int bit = (r & 3) + 8 * (r >> 2); if (!((w0 >> bit) & 1u)) p0[r] = -INFINITY; if (!((w1 >> bit) & 1u)) p1[r] = -INFINITY; } }
        const float rm = rowmax(p0, p1);
        if (__any(rm > THR)) {
            const float dl = __builtin_fmaxf(rm, 0.f); mhat += dl;
#pragma unroll
            for (int r = 0; r < 16; ++r) { p0[r] -= dl; p1[r] -= dl; }
            const float f = __builtin_amdgcn_exp2f(-dl); l_reg *= f; if (hi == 0) wsf[r32] = f;
            asm volatile("s_waitcnt lgkmcnt(0)" ::: "memory");
#pragma unroll
            for (int d_ = 0; d_ < 2; ++d_)
#pragma unroll
                for (int r = 0; r < 16; ++r) o[d_][r] *= wsf[crow(r, hi)];
        }
        float sacc = 0.f;
#pragma unroll
        for (int r = 0; r < 16; ++r) { p0[r] = __builtin_amdgcn_exp2f(p0[r]); p1[r] = __builtin_amdgcn_exp2f(p1[r]); sacc += p0[r] + p1[r]; }
        l_reg += sacc;
        u32x4 pw0, pw1, pw2, pw3;
        pw0 = (u32x4){cvtpk_s(p0[0], p0[1]), cvtpk_s(p0[2], p0[3]), cvtpk_s(p0[4], p0[5]), cvtpk_s(p0[6], p0[7])};
        pw1 = (u32x4){cvtpk_s(p0[8], p0[9]), cvtpk_s(p0[10], p0[11]), cvtpk_s(p0[12], p0[13]), cvtpk_s(p0[14], p0[15])};
        pw2 = (u32x4){cvtpk_s(p1[0], p1[1]), cvtpk_s(p1[2], p1[3]), cvtpk_s(p1[4], p1[5]), cvtpk_s(p1[6], p1[7])};
        pw3 = (u32x4){cvtpk_s(p1[8], p1[9]), cvtpk_s(p1[10], p1[11]), cvtpk_s(p1[12], p1[13]), cvtpk_s(p1[14], p1[15])};
        __builtin_amdgcn_sched_barrier(0);
        pv(o, vb0 + (t & 1) * SLOTB, __builtin_bit_cast(bf16x8, pw0), __builtin_bit_cast(bf16x8, pw1), __builtin_bit_cast(bf16x8, pw2), __builtin_bit_cast(bf16x8, pw3));
    }
    { auto rr = __builtin_amdgcn_permlane32_swap(__float_as_uint(l_reg), __float_as_uint(l_reg), false, false); l_reg = __uint_as_float(rr[0]) + __uint_as_float(rr[1]); }
    if (hi == 0) wsf[32 + r32] = l_reg; asm volatile("s_waitcnt lgkmcnt(0)" ::: "memory");
    float rli[16];
#pragma unroll
    for (int r = 0; r < 16; ++r) rli[r] = __builtin_amdgcn_rcpf(wsf[32 + crow(r, hi)]);
    bf16r* Ow = O + (rowbase + q0 + wid * QBLK) * DM + h * D;
    { bf16r* stg = (bf16r*)(shm + LDS_OST) + wid * 2048;
#pragma unroll
        for (int r = 0; r < 16; ++r) { const int orow = crow(r, hi);
#pragma unroll
            for (int d0 = 0; d0 < 2; ++d0) stg[orow * 64 + d0 * 32 + r32] = (bf16r)(cvtpk_s(o[d0][r] * rli[r], 0.f) & 0xffffu); }
        asm volatile("s_waitcnt lgkmcnt(0)" ::: "memory");
#pragma unroll
        for (int i = 0; i < 4; ++i) { const int row = i * 8 + (lane >> 3), ch = lane & 7; const u32x4 v = *(const u32x4*)(stg + row * 64 + ch * 8); *(u32x4*)(Ow + (long)row * DM + ch * 8) = v; } }
    asm volatile("s_waitcnt vmcnt(0) lgkmcnt(0)\n\ts_barrier" ::: "memory");
#undef DMA_K
#undef DMA_V
}
}

namespace idx {
using bf16x8 = __attribute__((ext_vector_type(8))) short;
using f32x16 = __attribute__((ext_vector_type(16))) float;
using u32x4 = __attribute__((ext_vector_type(4))) unsigned;
typedef unsigned short bf16r;
constexpr int SEQL = 4096;
constexpr int L_HIST = 0, L_AF = 65536, L_W = L_AF + 16384, L_M = L_W + 512, L_CT = L_M + 8192, LDS_BYTES = L_CT + 256;
#define IDX_LAS __attribute__((address_space(3)))
__device__ __forceinline__ unsigned okey(float s) { const unsigned u = __float_as_uint(s); return (u & 0x80000000u) ? ~u : (u | 0x80000000u); }

template <int LEVEL> __device__ __forceinline__ void radix_level(const unsigned (&sc)[16][8], int ni, char* shm, int tid, int lane, int wid, int hi) {
    IDX_LAS unsigned* hist = (IDX_LAS unsigned*)(shm + L_HIST); IDX_LAS unsigned* ct = (IDX_LAS unsigned*)(shm + L_CT);
    { IDX_LAS u32x4* h4 = (IDX_LAS u32x4*)hist;
#pragma unroll
      for (int i = 0; i < 8; ++i) h4[tid + i * 512] = (u32x4){0u, 0u, 0u, 0u}; }
    unsigned pfx[8];
#pragma unroll
    for (int c = 0; c < 8; ++c) pfx[c] = (LEVEL == 1) ? 0u : ct[4 * (c >> 1) + 2 * hi + (c & 1)];
    asm volatile("s_waitcnt lgkmcnt(0)" ::: "memory"); __syncthreads();
#pragma unroll
    for (int i = 0; i < 16; ++i) if (i < ni) {
#pragma unroll
        for (int c = 0; c < 8; ++c) { const unsigned k = sc[i][c]; const int q = 4 * (c >> 1) + 2 * hi + (c & 1);
            bool match; unsigned bin;
            if (LEVEL == 1) { match = true; bin = k >> 21; } else if (LEVEL == 2) { match = (k >> 21) == pfx[c]; bin = (k >> 10) & 2047u; } else { match = (k >> 10) == pfx[c]; bin = k & 1023u; }
            if (match) (void)__hip_atomic_fetch_add(&hist[q * 1024 + (bin >> 1)], (bin & 1u) ? 65536u : 1u, __ATOMIC_RELAXED, __HIP_MEMORY_SCOPE_WORKGROUP); } }
    asm volatile("s_waitcnt lgkmcnt(0)" ::: "memory"); __syncthreads();
#pragma unroll 1
    for (int qq = 0; qq < 2; ++qq) { const int q = 2 * wid + qq; const unsigned need = (LEVEL == 1) ? 256u : ct[16 + q];
        unsigned w[16];
#pragma unroll
        for (int i = 0; i < 4; ++i) { const u32x4 v = *(const IDX_LAS u32x4*)(hist + q * 1024 + 16 * lane + 4 * i); w[4 * i] = v.x; w[4 * i + 1] = v.y; w[4 * i + 2] = v.z; w[4 * i + 3] = v.w; }
        unsigned tot = 0u;
#pragma unroll
        for (int i = 0; i < 16; ++i) tot += (w[i] & 0xffffu) + (w[i] >> 16);
        unsigned s = tot;
#pragma unroll
        for (int d = 1; d < 64; d <<= 1) { const unsigned t = __shfl_down(s, d); if (lane + d < 64) s += t; }
        const unsigned above = s - tot;
        const unsigned long long bal = __ballot(above < need && need <= above + tot);
        const int L = bal ? (int)__builtin_ctzll(bal) : 0;
        unsigned run = above, bsel = 0u, nsel = 1u; bool found = false;
#pragma unroll
        for (int i = 15; i >= 0; --i) { const unsigned chi = w[i] >> 16, clo = w[i] & 0xffffu;
            if (!found && run + chi >= need) { found = true; bsel = 2 * i + 1; nsel = need - run; } run += chi;
            if (!found && run + clo >= need) { found = true; bsel = 2 * i; nsel = need - run; } run += clo; }
        const unsigned binL = (unsigned)__shfl((int)bsel, L) + 32u * (unsigned)L, needL = (unsigned)__shfl((int)nsel, L);
        if (lane == 0) { const unsigned old = (LEVEL == 1) ? 0u : ct[q];
            ct[q] = (LEVEL == 1) ? binL : (LEVEL == 2) ? ((old << 11) | binL) : ((old << 10) | binL); ct[16 + q] = needL; }
    }
    asm volatile("s_waitcnt lgkmcnt(0)" ::: "memory"); __syncthreads();
}

__device__ __forceinline__ void unit(int b, int q0, const bf16r* IQ, const bf16r* IK, const float* IW, unsigned* MASK, char* shm) {
    const int tid = threadIdx.x, lane = tid & 63, j = lane & 31, hi = lane >> 5; const int wid = __builtin_amdgcn_readfirstlane(tid >> 6);
    const size_t rowbase = (size_t)b * SEQL;
    IDX_LAS unsigned* ct = (IDX_LAS unsigned*)(shm + L_CT);
#pragma unroll
    for (int k = 0; k < 2; ++k) { const int f = wid + 8 * k, rb = f >> 2, s = f & 3; const int i = j;
        const int qi = ((i >> 4) & 1) + 2 * ((i >> 2) & 1), head = (i & 3) + 4 * ((i >> 3) & 1);
        const u32x4 v = *(const u32x4*)(IQ + (rowbase + q0 + 4 * rb + qi) * 512 + head * 64 + 16 * s + 8 * hi);
        *(IDX_LAS u32x4*)(shm + L_AF + f * 1024 + lane * 16) = v; }
    if (tid < 128) ((IDX_LAS float*)(shm + L_W))[tid] = IW[(rowbase + q0 + (tid >> 3)) * 8 + (tid & 7)];
    { IDX_LAS u32x4* m4 = (IDX_LAS u32x4*)(shm + L_M); m4[tid] = (u32x4){0u, 0u, 0u, 0u}; }
    asm volatile("s_waitcnt vmcnt(0) lgkmcnt(0)" ::: "memory"); __syncthreads();
    const int ntile = (q0 + 15) / 32 + 1;
    const int ni = (ntile > wid) ? (ntile - wid + 7) / 8 : 0;
    unsigned sc[16][8];
#pragma unroll
    for (int i = 0; i < 16; ++i)
#pragma unroll
        for (int c = 0; c < 8; ++c) sc[i][c] = 0x007fffffu;
#pragma unroll
    for (int i = 0; i < 16; ++i) if (i < ni) {
        const int kt = 8 * i + wid; const int key = 32 * kt + j;
        bf16x8 bf[4];
#pragma unroll
        for (int s = 0; s < 4; ++s) bf[s] = *(const bf16x8*)(IK + (rowbase + key) * 64 + 16 * s + 8 * hi);
#pragma unroll
        for (int rb = 0; rb < 4; ++rb) { f32x16 d = f32x16{};
#pragma unroll
            for (int s = 0; s < 4; ++s) { const bf16x8 a = *(const IDX_LAS bf16x8*)(shm + L_AF + (rb * 4 + s) * 1024 + lane * 16); d = __builtin_amdgcn_mfma_f32_32x32x16_bf16(a, bf[s], d, 0, 0, 0); }
            const IDX_LAS float* wl = (const IDX_LAS float*)(shm + L_W) + (4 * rb + 2 * hi) * 8;
            float sa = 0.f, sb = 0.f;
#pragma unroll
            for (int h = 0; h < 8; ++h) { sa += wl[h] * __builtin_fmaxf(d[h], 0.f); sb += wl[8 + h] * __builtin_fmaxf(d[8 + h], 0.f); }
            const int posa = q0 + 4 * rb + 2 * hi;
            if (key > posa) sa = -INFINITY; if (key > posa + 1) sb = -INFINITY;
            sc[i][2 * rb] = okey(sa); sc[i][2 * rb + 1] = okey(sb); __builtin_amdgcn_sched_barrier(0); }
    }
    if (q0 >= 256) { radix_level<1>(sc, ni, shm, tid, lane, wid, hi); radix_level<2>(sc, ni, shm, tid, lane, wid, hi); radix_level<3>(sc, ni, shm, tid, lane, wid, hi); }
    else { if (tid < 16) ct[tid] = 0x00800000u; asm volatile("s_waitcnt lgkmcnt(0)" ::: "memory"); __syncthreads(); }
    unsigned tk[8];
#pragma unroll
    for (int c = 0; c < 8; ++c) tk[c] = ct[4 * (c >> 1) + 2 * hi + (c & 1)];
    IDX_LAS unsigned* M = (IDX_LAS unsigned*)(shm + L_M);
#pragma unroll
    for (int i = 0; i < 16; ++i) if (i < ni) { const int kt = 8 * i + wid;
#pragma unroll
        for (int c = 0; c < 8; ++c) { const unsigned long long bal = __ballot(sc[i][c] >= tk[c]); const unsigned word = hi ? (unsigned)(bal >> 32) : (unsigned)bal;
            M[(4 * (c >> 1) + 2 * hi + (c & 1)) * 128 + kt] = word; } }
    asm volatile("s_waitcnt lgkmcnt(0)" ::: "memory"); __syncthreads();
    { const u32x4 v = ((const IDX_LAS u32x4*)M)[tid]; *(u32x4*)(MASK + (rowbase + q0) * 128 + tid * 4) = v; }
    asm volatile("s_waitcnt vmcnt(0) lgkmcnt(0)" ::: "memory"); __syncthreads();
}
}

constexpr int NWAVES = 8;
constexpr int N_LAUNCHES = MK_N_LAUNCHES;
enum Phase { PH_PRO = 0, PH_ZG, PH_IDX, PH_ATT, PH_BR, PH_WO, PH_RT, PH_GU, PH_DN, PH_CMB, PH_PG, PH_FIN, PH_COUNT };
using pg8::BATCH; using pg8::SEQ; using pg8::DMODEL; using pg8::TOK; using pg8::AW; using pg8::ZN; using pg8::IN_COLS; using pg8::NEXP; using pg8::DEXP; using pg8::PLE; using pg8::RMS_EPS;

constexpr size_t MiB = 1u << 20;
constexpr size_t WS_CTL = 0, CTL_ZERO_BYTES = 2 * MiB;
constexpr size_t WS_KMEAN = 1 * MiB;
constexpr size_t WS_ROPEC = 2 * MiB, WS_ROPES = 2 * MiB + 128 * 1024;
constexpr size_t WS_STATS = 2 * MiB + 256 * 1024;
constexpr size_t WS_LTOK = 3 * MiB, WS_LW = 7 * MiB;
constexpr size_t WS_WIN = 11 * MiB;
constexpr size_t WS_BRA = 23 * MiB, WS_BRB = 24 * MiB, WS_WOUT = 25 * MiB, WS_WPG = 27 * MiB, WS_WPP = 29 * MiB;
constexpr size_t WS_PB = 30 * MiB;
constexpr size_t WS_A = 46 * MiB;
constexpr size_t WS_B = 110 * MiB;
constexpr size_t WS_QA = WS_B, WS_KA = WS_B + 32 * MiB, WS_VA = WS_B + 64 * MiB, WS_QB = WS_B + 96 * MiB, WS_KB = WS_B + 128 * MiB, WS_VB = WS_B + 160 * MiB;
constexpr size_t WS_IQ = WS_B + 192 * MiB, WS_IK = WS_B + 224 * MiB, WS_IW = WS_B + 228 * MiB;
constexpr size_t WS_T = WS_KA;
constexpr size_t WS_HID = WS_B, WS_Y = WS_B + 72 * MiB;
constexpr size_t WS_P = WS_B;
constexpr size_t WS_C = 342 * MiB;
constexpr size_t WS_GA = WS_C, WS_GB = WS_C + 64 * MiB;
constexpr size_t WS_WGU = WS_C, WS_WDN = WS_C + 64 * MiB;
constexpr size_t WS_MASK = 470 * MiB;
constexpr size_t WS_ST = 486 * MiB;
constexpr size_t WS_END = 488 * MiB;
constexpr int CW_BAR = 4096;
constexpr int CW_CNT = 16384;
constexpr int RING_OFF = 0, RING_BYTES = 131072;
constexpr int TBL_OFF = RING_BYTES, TBL_BYTES = 28672;
constexpr int LDSCTL_OFF = TBL_OFF + TBL_BYTES, MISC_OFF = LDSCTL_OFF + 320;
constexpr int LDS_BYTES = 163840;
static_assert(MISC_OFF + 128 <= LDS_BYTES, "LDS map");

#define GAS __attribute__((address_space(1)))
#define LAS __attribute__((address_space(3)))
typedef unsigned short bf16;
typedef unsigned v4u __attribute__((ext_vector_type(4)));
typedef float f32x4 __attribute__((ext_vector_type(4)));
typedef short bf16x8 __attribute__((ext_vector_type(8)));
typedef GAS unsigned gu32;
typedef GAS unsigned long long gu64;
#define RLX_AGENT __ATOMIC_RELAXED, __HIP_MEMORY_SCOPE_AGENT
#define LDS_WAIT() asm volatile("s_waitcnt lgkmcnt(0)" ::: "memory")
#define VM_WAIT() asm volatile("s_waitcnt vmcnt(0)" ::: "memory")
__device__ __forceinline__ unsigned long long rt() { return __builtin_amdgcn_s_memrealtime(); }
__device__ __forceinline__ unsigned f2bf(float f) { unsigned u = __builtin_bit_cast(unsigned, f); return (u + 0x7fffu + ((u >> 16) & 1u)) >> 16; }
__device__ __forceinline__ unsigned pk2(float lo, float hi) { return f2bf(lo) | (f2bf(hi) << 16); }

#define XB_TMO      128
#define XB_XCNT(j)  (256  + 64 * (j))
#define XB_XSUB(j)  (1280 + 64 * (j))
#define XB_XGEN(j)  (2304 + 64 * (j))
#define XB_TOP      3328
#define XB_TOPGEN   3392
#define XCD_BAR_WORDS 3456
#define XB_SPIN_CAP (1u << 18)

__device__ __forceinline__ unsigned xb_ld(unsigned* p)              { return __hip_atomic_load(p, __ATOMIC_RELAXED, __HIP_MEMORY_SCOPE_AGENT); }
__device__ __forceinline__ unsigned xb_add(unsigned* p, unsigned v) { return __hip_atomic_fetch_add(p, v, __ATOMIC_RELAXED, __HIP_MEMORY_SCOPE_AGENT); }
__device__ __forceinline__ unsigned xb_xcc_id() { return (unsigned)__builtin_amdgcn_s_getreg((3 << 11) | 20) & 0xFu; }
#define XB_SPIN(cond, bar) do { unsigned _sp = 0; while (cond) { __builtin_amdgcn_s_sleep(1); \
    if ((++_sp & 255u) == 0u) { if (xb_ld(&(bar)[XB_TMO])) break; if (_sp > XB_SPIN_CAP) { atomicAdd(&(bar)[XB_TMO], 1u); break; } } } } while (0)

struct XcdBarrier {
    unsigned* bar; unsigned x;
    volatile LAS unsigned* st;
};

__device__ __forceinline__ XcdBarrier xcd_barrier_post(unsigned* bar, volatile LAS unsigned* st) {
    XcdBarrier b; b.bar = bar; b.x = xb_xcc_id(); b.st = st;
    if (threadIdx.x == 0) (void)xb_add(&bar[XB_XCNT(b.x)], 1u);
    return b;
}
__device__ __forceinline__ void xcd_barrier_complete(unsigned* bar, unsigned x, unsigned& nloc, unsigned& nx) {
    const unsigned G = gridDim.x * gridDim.y * gridDim.z;
    unsigned sum, cnt, mine, sp = 0u;
    for (;;) {
        sum = 0u; cnt = 0u; mine = 0u;
#pragma unroll
        for (unsigned j = 0; j < 16; ++j) { const unsigned c = xb_ld(&bar[XB_XCNT(j)]); sum += c; cnt += (c > 0u) ? 1u : 0u; mine = (j == x) ? c : mine; }
        if (sum == G) break;
        __builtin_amdgcn_s_sleep(1);
        if ((++sp & 255u) == 0u) { if (xb_ld(&bar[XB_TMO])) break; if (sp > XB_SPIN_CAP) { atomicAdd(&bar[XB_TMO], 1u); break; } }
    }
    nloc = mine > 0u ? mine : 1u; nx = cnt > 0u ? cnt : 1u;
}

__device__ __forceinline__ void xcd_barrier(const XcdBarrier& b) {
    asm volatile("s_waitcnt vmcnt(0)" ::: "memory");
    __syncthreads();
    if (threadIdx.x == 0) {
        unsigned* bar = b.bar;
        __builtin_amdgcn_s_waitcnt(0);
        unsigned nloc = b.st[0], nx = b.st[1];
        if (nloc == 0u) { xcd_barrier_complete(bar, b.x, nloc, nx); b.st[0] = nloc; b.st[1] = nx; }
        const unsigned old = xb_add(&bar[XB_XSUB(b.x)], 1u);
        const unsigned gen = old / nloc;
        if (old + 1u == (gen + 1u) * nloc) {
            __builtin_amdgcn_fence(__ATOMIC_RELEASE, "agent");
            asm volatile("s_waitcnt vmcnt(0)" ::: "memory");
            const unsigned og = xb_add(&bar[XB_TOP], 1u);
            const unsigned tg = og / nx;
            if (og + 1u == (tg + 1u) * nx) xb_add(&bar[XB_TOPGEN], 1u);
            else XB_SPIN(xb_ld(&bar[XB_TOPGEN]) == tg, bar);
            __builtin_amdgcn_fence(__ATOMIC_ACQUIRE, "agent");
            xb_add(&bar[XB_XGEN(b.x)], 1u);
            asm volatile("s_waitcnt vmcnt(0)" ::: "memory");
        } else {
            XB_SPIN(xb_ld(&bar[XB_XGEN(b.x)]) == gen, bar);
            __builtin_amdgcn_fence(__ATOMIC_ACQUIRE, "agent");
            asm volatile("s_waitcnt vmcnt(0)" ::: "memory");
        }
    }
    __syncthreads();
}

struct Frame {
    LAS unsigned char* lds;
    volatile LAS unsigned* MISC;
    gu32* ctl;
    int tid, lane, wave;
    int vcu, G;
};
__device__ __forceinline__ float wave_sum(float v) {
#pragma unroll
    for (int o = 1; o < 64; o <<= 1) v += __shfl_xor(v, o);
    return v;
}
template <class RowMap> __device__ __forceinline__ void transpose_item(const float* W, int K, int N, bf16* WT, const RowMap& RM, LAS float* scr, int item, int lane) {
    const int nblk = (N + 31) / 32, kb = item / nblk, nb = item % nblk, k0 = 64 * kb, n0 = 32 * nb;
    const int nsrc = n0 + (lane & 31); const bool okc = nsrc < N;
#pragma unroll 8
    for (int i = 0; i < 32; ++i) { const int kk = 2 * i + (lane >> 5); scr[kk * 33 + (lane & 31)] = okc ? W[(size_t)(k0 + kk) * N + nsrc] : 0.f; }
    LDS_WAIT(); asm volatile("" ::: "memory");
    const int c = lane & 7;
#pragma unroll
    for (int j = 0; j < 4; ++j) { const int n = (lane >> 3) + 8 * j; const LAS float* s = scr + (8 * c) * 33 + n;
        v4u o; o.x = pk2(s[0 * 33], s[1 * 33]); o.y = pk2(s[2 * 33], s[3 * 33]); o.z = pk2(s[4 * 33], s[5 * 33]); o.w = pk2(s[6 * 33], s[7 * 33]);
        const int drow = (n0 + n < N) ? RM(n0 + n) : -1;
        if (drow >= 0) *(GAS v4u*)(WT + (size_t)drow * K + k0 + 8 * c) = o; }
    LDS_WAIT(); asm volatile("" ::: "memory");
}
struct RmIdent { __device__ __forceinline__ int operator()(int n) const { return n; } };
struct RmWin { __device__ __forceinline__ int operator()(int n) const { return n < 3656 ? n : n + 184; } };
struct RmGate { int up; __device__ __forceinline__ int operator()(int n) const { return 256 * (n >> 7) + 128 * up + (n & 127); } };

__device__ __forceinline__ void rms_row_to_bf16(const float* xrow, const float* g, bf16* orow, int lane) {
    const GAS f32x4* xr = (const GAS f32x4*)xrow + lane; const GAS f32x4* gr = (const GAS f32x4*)g + lane;
    f32x4 v[4]; float s = 0.f;
#pragma unroll
    for (int j = 0; j < 4; ++j) { v[j] = xr[64 * j]; s += (v[j].x * v[j].x + v[j].y * v[j].y) + (v[j].z * v[j].z + v[j].w * v[j].w); }
    const float rinv = 1.0f / sqrtf(wave_sum(s) * (1.f / DMODEL) + RMS_EPS);
    GAS unsigned long long* o8 = (GAS unsigned long long*)orow + lane;
#pragma unroll
    for (int j = 0; j < 4; ++j) { const f32x4 gg = gr[64 * j]; o8[64 * j] = (unsigned long long)pk2(v[j].x * rinv * gg.x, v[j].y * rinv * gg.y) | ((unsigned long long)pk2(v[j].z * rinv * gg.z, v[j].w * rinv * gg.w) << 32); }
}

struct MoeTbl {
    static constexpr int RB0 = 0;
    static constexpr int UNITS = 256;
    static constexpr int ROWOFF = 512;
    static constexpr int ROWW = 512 + 8192;
};
struct MoeOrder {
    const LAS int* units; const LAS unsigned* rowoff; int n; size_t estride;
    __device__ __forceinline__ bool next(int i, pg8::Unit& u) const { if (i >= n) return false; u.pm = units[4 * i]; u.pn = units[4 * i + 1]; u.e = units[4 * i + 2]; u.valid = units[4 * i + 3]; u.boff = (size_t)u.e * estride; return true; }
    __device__ __forceinline__ void a_ready(const pg8::Unit&) const {}
    __device__ __forceinline__ void done(const pg8::Unit&) const {}
    __device__ __forceinline__ unsigned arow(int ui, int r) const { return rowoff[ui * 256 + r]; }
};
__device__ __forceinline__ int moe_build(Frame& F, const int* cnt_g, const int* ltok, const float* lw, int mode) {
    LAS int* rb0 = (LAS int*)(F.lds + TBL_OFF + MoeTbl::RB0); LAS int* units = (LAS int*)(F.lds + TBL_OFF + MoeTbl::UNITS);
    LAS unsigned* rowoff = (LAS unsigned*)(F.lds + TBL_OFF + MoeTbl::ROWOFF); LAS float* roww = (LAS float*)(F.lds + TBL_OFF + MoeTbl::ROWW);
    LAS int* cn = (LAS int*)(F.lds + TBL_OFF + MoeTbl::ROWW + 8192);
    if (F.tid < 32) cn[F.tid] = __hip_atomic_load(cnt_g + F.tid, __ATOMIC_RELAXED, __HIP_MEMORY_SCOPE_AGENT);
    LDS_WAIT(); __syncthreads();
    if (F.tid == 0) { int s = 0; for (int e = 0; e < 32; ++e) { rb0[e] = s; s += (cn[e] + 255) >> 8; } rb0[32] = s; }
    LDS_WAIT(); __syncthreads();
    const int NB = rb0[32]; int n = 0;
    for (int i = 0; i < 8; ++i) { const int L = i * F.G + (int)blockIdx.x; if (L >= 4 * NB) break; n = i + 1;
        const int rb = L >> 2, t = L & 3; int e = 0;
        for (int k = 1; k < 32; ++k) if (rb0[k] <= rb) e = k;
        const int jb = rb - rb0[e]; const int valid = min(256, cn[e] - 256 * jb);
        if (F.tid == 0) { units[4 * i] = rb; units[4 * i + 1] = t; units[4 * i + 2] = e; units[4 * i + 3] = valid; }
        if (F.tid < 256) { const int r = F.tid; const int src = e * 32768 + 256 * jb + (r < valid ? r : 0); const int tk = ltok[src];
            if (mode == 0) rowoff[i * 256 + r] = (unsigned)(tk >> 1) * (unsigned)(DMODEL * 2);
            else { rowoff[i * 256 + r] = (r < valid) ? (unsigned)tk : (unsigned)(2 * TOK); roww[i * 256 + r] = (r < valid) ? lw[src] : 0.f; } }
    }
    VM_WAIT(); LDS_WAIT(); __syncthreads();
    return n;
}

struct Args { const float* in[19]; float* out; unsigned char* ws; int ph_lo, ph_hi; };
typedef __attribute__((address_space(4))) const Args CArgs;
__device__ __forceinline__ CArgs* phase_args() { CArgs* p = (CArgs*)__builtin_amdgcn_kernarg_segment_ptr(); asm volatile("" : "+s"(p)); return p; }
__global__ void __launch_bounds__(NWAVES * 64, 2) fwd(Args args) {
    extern __shared__ __attribute__((aligned(16))) unsigned char lds[];
    Frame F0; Frame& F = F0;
    F.lds = (LAS unsigned char*)lds;
    F.MISC = (volatile LAS unsigned*)(F.lds + MISC_OFF);
    F.tid = threadIdx.x; F.lane = F.tid & 63; F.wave = __builtin_amdgcn_readfirstlane(F.tid >> 6);
    F.G = gridDim.x; { const int bx = blockIdx.x; F.vcu = (F.G % 8 == 0) ? (bx % 8) * (F.G / 8) + bx / 8 : bx; }
    F.ctl = (gu32*)(args.ws + WS_CTL);
    for (int u = F.tid; u < (LDS_BYTES - LDSCTL_OFF) / 4; u += NWAVES * 64) ((LAS unsigned*)(F.lds + LDSCTL_OFF))[u] = 0u;
    __syncthreads();
    XcdBarrier bar; bar.bar = (unsigned*)(F.ctl + CW_BAR); bar.x = 0; bar.st = nullptr;
    if (N_LAUNCHES == 1) bar = xcd_barrier_post((unsigned*)(F.ctl + CW_BAR), F.MISC + 8);
#define GRID_BAR() do { if (N_LAUNCHES == 1) { xcd_barrier(bar); } } while (0)
    const int lo = args.ph_lo, hi = args.ph_hi;
#ifndef PHASE_MASK
#define PHASE_MASK 0xFFF
#endif
#define IN(k) ((((PHASE_MASK) >> (k)) & 1) && lo <= (k) && (k) < hi)
#define BOTH(k) (IN(k) && IN((k) + 1))
#define Win_t ((bf16*)(ws + WS_WIN))
#define BrA_t ((bf16*)(ws + WS_BRA))
#define BrB_t ((bf16*)(ws + WS_BRB))
#define Wout_t ((bf16*)(ws + WS_WOUT))
#define Wpg_t ((bf16*)(ws + WS_WPG))
#define Wpp_t ((bf16*)(ws + WS_WPP))
#define PB ((bf16*)(ws + WS_PB))
#define HA ((bf16*)(ws + WS_A))
#define ropec ((float*)(ws + WS_ROPEC))
#define ropes ((float*)(ws + WS_ROPES))
#define kmean ((float*)(ws + WS_KMEAN))
#define cnt_g ((int*)(ws + WS_CTL + 4 * CW_CNT))
#define ltok ((int*)(ws + WS_LTOK))
#define lwt ((float*)(ws + WS_LW))
    if (IN(PH_PRO)) {
        CArgs& args = *phase_args(); unsigned char* const ws = args.ws; float* const out = args.out; const float* const x = args.in[0]; (void)x; (void)out;
        Frame F = F0; { int t_ = threadIdx.x; asm volatile("" : "+v"(t_)); F.tid = t_; F.lane = t_ & 63; F.wave = __builtin_amdgcn_readfirstlane(t_ >> 6); }
        const int gw = F.vcu * NWAVES + F.wave, NGW = F.G * NWAVES; (void)gw; (void)NGW;
        LAS float* scr = (LAS float*)(F.lds + RING_OFF + F.wave * 16384);
        constexpr int I_IN = 16 * 179, I_BR = 8 * 32, I_O = 16 * 32, I_PP = 4 * 32;
        constexpr int NITEMS = I_IN + 2 * I_BR + 2 * I_O + I_PP;
        for (int it = gw; it < NITEMS; it += NGW) { int r = it;
            if (r < I_IN) { transpose_item(args.in[3], DMODEL, IN_COLS, Win_t, RmWin{}, scr, r, F.lane); continue; } r -= I_IN;
            if (r < I_BR) { transpose_item(args.in[4], AW, DMODEL, BrA_t, RmIdent{}, scr, r, F.lane); continue; } r -= I_BR;
            if (r < I_BR) { transpose_item(args.in[5], AW, DMODEL, BrB_t, RmIdent{}, scr, r, F.lane); continue; } r -= I_BR;
            if (r < I_O) { transpose_item(args.in[6], DMODEL, DMODEL, Wout_t, RmIdent{}, scr, r, F.lane); continue; } r -= I_O;
            if (r < I_O) { transpose_item(args.in[16], DMODEL, DMODEL, Wpg_t, RmIdent{}, scr, r, F.lane); continue; } r -= I_O;
            transpose_item(args.in[17], PLE, DMODEL, Wpp_t, RmIdent{}, scr, r, F.lane); }
        { const int gt = F.vcu * NWAVES * 64 + F.tid, NGT = F.G * NWAVES * 64;
            for (int i = gt; i < 184 * 128; i += NGT) ((GAS v4u*)(Win_t + (size_t)3656 * DMODEL))[i] = (v4u){0u, 0u, 0u, 0u};
            for (int i = gt; i < SEQ * 8; i += NGT) { const int pos = i >> 3, k = i & 7; const float inv = 1.0f / powf(500000.0f, (float)k * 0.125f); const float ang = (float)pos * inv; ropec[i] = cosf(ang); ropes[i] = sinf(ang); }
            const GAS f32x4* p4 = (const GAS f32x4*)args.in[1]; GAS unsigned long long* pb8 = (GAS unsigned long long*)PB;
            for (int i = gt; i < TOK * PLE / 4; i += NGT) { const f32x4 v = p4[i]; pb8[i] = (unsigned long long)pk2(v.x, v.y) | ((unsigned long long)pk2(v.z, v.w) << 32); } }
        for (int m = gw; m < TOK; m += NGW) rms_row_to_bf16(x + (size_t)m * DMODEL, args.in[2], HA + (size_t)m * DMODEL, F.lane);
        if (BOTH(PH_PRO)) GRID_BAR();
    }
    if (IN(PH_ZG)) {
        CArgs& args = *phase_args(); unsigned char* const ws = args.ws; float* const out = args.out; const float* const x = args.in[0]; (void)x; (void)out;
        Frame F = F0; { int t_ = threadIdx.x; asm volatile("" : "+v"(t_)); F.tid = t_; F.lane = t_ & 63; F.wave = __builtin_amdgcn_readfirstlane(t_ >> 6); }
        const int gw = F.vcu * NWAVES + F.wave, NGW = F.G * NWAVES; (void)gw; (void)NGW;
        pg8::Gemm g{HA, Win_t, TOK, ZN, DMODEL}; pg8::StaticOrder S; S.init(TOK, ZN, F.G, (int)blockIdx.x);
        pg8::EpiZ E{(bf16*)(ws + WS_QA), (bf16*)(ws + WS_KA), (bf16*)(ws + WS_VA), (bf16*)(ws + WS_QB), (bf16*)(ws + WS_KB), (bf16*)(ws + WS_VB), (bf16*)(ws + WS_IQ), (bf16*)(ws + WS_IK),
                    (bf16*)(ws + WS_GA), (bf16*)(ws + WS_GB), (float*)(ws + WS_IW), kmean, ropec, ropes};
        pg8::gemm_phase<pg8::EpiZ, pg8::StaticOrder, true, true, false>(F.lds + RING_OFF, g, S, E);
        if (BOTH(PH_ZG)) GRID_BAR();
    }
    if (IN(PH_IDX)) {
        CArgs& args = *phase_args(); unsigned char* const ws = args.ws; float* const out = args.out; const float* const x = args.in[0]; (void)x; (void)out;
        Frame F = F0; { int t_ = threadIdx.x; asm volatile("" : "+v"(t_)); F.tid = t_; F.lane = t_ & 63; F.wave = __builtin_amdgcn_readfirstlane(t_ >> 6); }
        const int gw = F.vcu * NWAVES + F.wave, NGW = F.G * NWAVES; (void)gw; (void)NGW;
        const int b = F.vcu >> 5, jj = F.vcu & 31;
        if (F.G == 256) {
#pragma unroll 1
            for (int k = 0; k < 8; ++k) { const int u = 32 * k + ((k & 1) ? 31 - jj : jj);
                idx::unit(b, 16 * u, (const bf16*)(ws + WS_IQ), (const bf16*)(ws + WS_IK), (const float*)(ws + WS_IW), (unsigned*)(ws + WS_MASK), (char*)lds + RING_OFF); }
        }
        if (BOTH(PH_IDX)) GRID_BAR();
    }
    if (IN(PH_ATT)) {
        CArgs& args = *phase_args(); unsigned char* const ws = args.ws; float* const out = args.out; const float* const x = args.in[0]; (void)x; (void)out;
        Frame F = F0; { int t_ = threadIdx.x; asm volatile("" : "+v"(t_)); F.tid = t_; F.lane = t_ & 63; F.wave = __builtin_amdgcn_readfirstlane(t_ >> 6); }
        const int gw = F.vcu * NWAVES + F.wave, NGW = F.G * NWAVES; (void)gw; (void)NGW;
        if (F.G == 256) {
            const int bh = F.vcu >> 2, s = F.vcu & 3; const int b = bh >> 3, h = bh & 7;
#pragma unroll 1
            for (int i = 0; i < 4; ++i) { const int qb = (i == 0) ? s : (i == 1) ? 7 - s : (i == 2) ? 8 + s : 15 - s;
                att::attn_unit<0>(b, h, qb, (const bf16*)(ws + WS_QA), (const bf16*)(ws + WS_KA), (const bf16*)(ws + WS_VA), (bf16*)(ws + WS_QA), kmean, (char*)lds + RING_OFF); }
#pragma unroll 1
            for (int i = 0; i < 4; ++i) { const int qb = (i == 0) ? s : (i == 1) ? 7 - s : (i == 2) ? 8 + s : 15 - s;
                att::attn_unit<1>(b, h, qb, (const bf16*)(ws + WS_QB), (const bf16*)(ws + WS_KB), (const bf16*)(ws + WS_VB), (bf16*)(ws + WS_QB), ws + WS_MASK, (char*)lds + RING_OFF); }
        }
        if (BOTH(PH_ATT)) GRID_BAR();
    }
    if (IN(PH_BR)) {
        CArgs& args = *phase_args(); unsigned char* const ws = args.ws; float* const out = args.out; const float* const x = args.in[0]; (void)x; (void)out;
        Frame F = F0; { int t_ = threadIdx.x; asm volatile("" : "+v"(t_)); F.tid = t_; F.lane = t_ & 63; F.wave = __builtin_amdgcn_readfirstlane(t_ >> 6); }
        const int gw = F.vcu * NWAVES + F.wave, NGW = F.G * NWAVES; (void)gw; (void)NGW;
        { pg8::Gemm g{(const bf16*)(ws + WS_QA), BrA_t, TOK, DMODEL, AW}; pg8::StaticOrder S; S.init(TOK, DMODEL, F.G, (int)blockIdx.x);
          pg8::EpiBranch<0> E{(const bf16*)(ws + WS_GA), nullptr, (bf16*)(ws + WS_T)};
          pg8::gemm_phase<pg8::EpiBranch<0>, pg8::StaticOrder, true, true, false>(F.lds + RING_OFF, g, S, E); }
        VM_WAIT(); __syncthreads();
        { pg8::Gemm g{(const bf16*)(ws + WS_QB), BrB_t, TOK, DMODEL, AW}; pg8::StaticOrder S; S.init(TOK, DMODEL, F.G, (int)blockIdx.x);
          pg8::EpiBranch<1> E{(const bf16*)(ws + WS_GB), (const bf16*)(ws + WS_T), HA};
          pg8::gemm_phase<pg8::EpiBranch<1>, pg8::StaticOrder, true, true, false>(F.lds + RING_OFF, g, S, E); }
        if (BOTH(PH_BR)) GRID_BAR();
    }
    if (IN(PH_WO)) {
        CArgs& args = *phase_args(); unsigned char* const ws = args.ws; float* const out = args.out; const float* const x = args.in[0]; (void)x; (void)out;
        Frame F = F0; { int t_ = threadIdx.x; asm volatile("" : "+v"(t_)); F.tid = t_; F.lane = t_ & 63; F.wave = __builtin_amdgcn_readfirstlane(t_ >> 6); }
        const int gw = F.vcu * NWAVES + F.wave, NGW = F.G * NWAVES; (void)gw; (void)NGW;
        pg8::Gemm g{HA, Wout_t, TOK, DMODEL, DMODEL}; pg8::StaticOrder S; S.init(TOK, DMODEL, F.G, (int)blockIdx.x);
        pg8::EpiResidual E{x, out};
        pg8::gemm_phase<pg8::EpiResidual, pg8::StaticOrder, true, true, false>(F.lds + RING_OFF, g, S, E);
        if (BOTH(PH_WO)) GRID_BAR();
    }
    if (IN(PH_RT)) {
        CArgs& args = *phase_args(); unsigned char* const ws = args.ws; float* const out = args.out; const float* const x = args.in[0]; (void)x; (void)out;
        Frame F = F0; { int t_ = threadIdx.x; asm volatile("" : "+v"(t_)); F.tid = t_; F.lane = t_ & 63; F.wave = __builtin_amdgcn_readfirstlane(t_ >> 6); }
        const int gw = F.vcu * NWAVES + F.wave, NGW = F.G * NWAVES; (void)gw; (void)NGW;
        LAS float* WT = (LAS float*)(F.lds);
        LAS int* lcnt = (LAS int*)(F.lds + 147456);
        LAS int* rinfo = (LAS int*)(F.lds + 147456 + 256);
        for (int i = F.tid; i < 36 * DMODEL; i += NWAVES * 64) { const int c = i >> 10, k = i & 1023; WT[i] = (c < 4) ? args.in[8][k * 4 + c] : args.in[10][k * 32 + (c - 4)]; }
        if (F.tid < 64) lcnt[F.tid] = 0;
        VM_WAIT(); LDS_WAIT(); __syncthreads();
        const int chunk = F.vcu;
        if (F.G == 256) {
#pragma unroll 1
            for (int rr = 0; rr < 16; ++rr) { const int rloc = F.wave * 16 + rr; const int row = chunk * 128 + rloc;
                const GAS f32x4* xr = (const GAS f32x4*)(out + (size_t)row * DMODEL) + F.lane; const GAS f32x4* gr = (const GAS f32x4*)args.in[7] + F.lane;
                f32x4 v[4]; float s = 0.f;
#pragma unroll
                for (int j = 0; j < 4; ++j) { v[j] = xr[64 * j]; s += (v[j].x * v[j].x + v[j].y * v[j].y) + (v[j].z * v[j].z + v[j].w * v[j].w); }
                const float rinv = 1.0f / sqrtf(wave_sum(s) * (1.f / DMODEL) + RMS_EPS);
                GAS unsigned long long* o8 = (GAS unsigned long long*)(HA + (size_t)row * DMODEL) + F.lane;
#pragma unroll
                for (int j = 0; j < 4; ++j) { const f32x4 gg = gr[64 * j]; v[j] = v[j] * rinv * gg; o8[64 * j] = (unsigned long long)pk2(v[j].x, v[j].y) | ((unsigned long long)pk2(v[j].z, v[j].w) << 32); }
                float lg[36];
#pragma unroll
                for (int c = 0; c < 36; ++c) { float a = 0.f;
#pragma unroll
                    for (int j = 0; j < 4; ++j) { const f32x4 w = *(const LAS f32x4*)(WT + c * DMODEL + 256 * j + 4 * F.lane); a += (v[j].x * w.x + v[j].y * w.y) + (v[j].z * w.z + v[j].w * w.w); }
                    lg[c] = wave_sum(a); }
#pragma unroll
                for (int c = 0; c < 4; ++c) lg[c] += args.in[9][c];
#pragma unroll
                for (int c = 0; c < 32; ++c) lg[4 + c] += args.in[11][c];
                int g = 0; float gm = lg[0];
#pragma unroll
                for (int c = 1; c < 4; ++c) if (lg[c] > gm) { gm = lg[c]; g = c; }
                float den = 0.f;
#pragma unroll
                for (int c = 0; c < 4; ++c) den += expf(lg[c] - gm);
                const float pg = 1.0f / den;
                float el[8];
#pragma unroll
                for (int c = 0; c < 8; ++c) { el[c] = lg[4 + c];
#pragma unroll
                    for (int gg = 1; gg < 4; ++gg) if (g == gg) el[c] = lg[4 + 8 * gg + c]; }
                int i1 = 0; float v1 = el[0];
#pragma unroll
                for (int c = 1; c < 8; ++c) if (el[c] > v1) { v1 = el[c]; i1 = c; }
                int i2 = -1; float v2 = -INFINITY;
#pragma unroll
                for (int c = 0; c < 8; ++c) if (c != i1 && el[c] > v2) { v2 = el[c]; i2 = c; }
                const float e2 = expf(v2 - v1); const float w1 = pg / (1.0f + e2), w2 = pg * e2 / (1.0f + e2);
                if (F.lane == 0) { const int e1 = 8 * g + i1, ee2 = 8 * g + i2;
                    const int p1 = __hip_atomic_fetch_add(lcnt + e1, 1, __ATOMIC_RELAXED, __HIP_MEMORY_SCOPE_WORKGROUP); const int p2 = __hip_atomic_fetch_add(lcnt + ee2, 1, __ATOMIC_RELAXED, __HIP_MEMORY_SCOPE_WORKGROUP);
                    LAS int* ri = rinfo + rloc * 8; ri[0] = e1; ri[1] = p1; ri[2] = (int)__float_as_uint(w1); ri[3] = 2 * row; ri[4] = ee2; ri[5] = p2; ri[6] = (int)__float_as_uint(w2); ri[7] = 2 * row + 1; }
            }
            LDS_WAIT(); __syncthreads();
            if (F.tid < 32) { const int c = lcnt[F.tid]; lcnt[32 + F.tid] = c ? (int)__hip_atomic_fetch_add((gu32*)cnt_g + F.tid, (unsigned)c, RLX_AGENT) : 0; }
            VM_WAIT(); LDS_WAIT(); __syncthreads();
            if (F.tid < 256) { const LAS int* ri = rinfo + F.tid * 4; const int e = ri[0], pos = lcnt[32 + e] + ri[1]; ltok[e * 32768 + pos] = ri[3]; lwt[e * 32768 + pos] = __uint_as_float((unsigned)ri[2]); }
        }
        __syncthreads();
        { LAS float* scr = (LAS float*)(F.lds + RING_OFF + F.wave * 16384);
          bf16* const Wgu = (bf16*)(ws + WS_WGU); bf16* const Wdn = (bf16*)(ws + WS_WDN);
          constexpr int IG = 16 * 16, ID = 8 * 32;
          for (int it = gw; it < NEXP * (2 * IG + ID); it += NGW) { const int e = it / (2 * IG + ID); int r = it % (2 * IG + ID);
              if (r < IG) { transpose_item(args.in[12] + (size_t)e * DMODEL * DEXP, DMODEL, DEXP, Wgu + (size_t)e * DMODEL * DMODEL, RmGate{0}, scr, r, F.lane); continue; } r -= IG;
              if (r < IG) { transpose_item(args.in[13] + (size_t)e * DMODEL * DEXP, DMODEL, DEXP, Wgu + (size_t)e * DMODEL * DMODEL, RmGate{1}, scr, r, F.lane); continue; } r -= IG;
              transpose_item(args.in[14] + (size_t)e * DEXP * DMODEL, DEXP, DMODEL, Wdn + (size_t)e * DMODEL * DEXP, RmIdent{}, scr, r, F.lane); } }
        if (BOTH(PH_RT)) GRID_BAR();
    }
    if (IN(PH_GU)) {
        CArgs& args = *phase_args(); unsigned char* const ws = args.ws; float* const out = args.out; const float* const x = args.in[0]; (void)x; (void)out;
        Frame F = F0; { int t_ = threadIdx.x; asm volatile("" : "+v"(t_)); F.tid = t_; F.lane = t_ & 63; F.wave = __builtin_amdgcn_readfirstlane(t_ >> 6); }
        const int gw = F.vcu * NWAVES + F.wave, NGW = F.G * NWAVES; (void)gw; (void)NGW;
        const int n = moe_build(F, cnt_g, ltok, lwt, 0);
        MoeOrder S{(const LAS int*)(F.lds + TBL_OFF + MoeTbl::UNITS), (const LAS unsigned*)(F.lds + TBL_OFF + MoeTbl::ROWOFF), n, (size_t)DMODEL * DMODEL * 2};
        pg8::Gemm g{HA, (const bf16*)(ws + WS_WGU), 0, DMODEL, DMODEL};
        pg8::EpiSwiglu E{(bf16*)(ws + WS_HID)};
        pg8::gemm_phase<pg8::EpiSwiglu, MoeOrder, true, true, true>(F.lds + RING_OFF, g, S, E);
        if (BOTH(PH_GU)) GRID_BAR();
    }
    if (IN(PH_DN)) {
        CArgs& args = *phase_args(); unsigned char* const ws = args.ws; float* const out = args.out; const float* const x = args.in[0]; (void)x; (void)out;
        Frame F = F0; { int t_ = threadIdx.x; asm volatile("" : "+v"(t_)); F.tid = t_; F.lane = t_ & 63; F.wave = __builtin_amdgcn_readfirstlane(t_ >> 6); }
        const int gw = F.vcu * NWAVES + F.wave, NGW = F.G * NWAVES; (void)gw; (void)NGW;
        const int n = moe_build(F, cnt_g, ltok, lwt, 1);
        MoeOrder S{(const LAS int*)(F.lds + TBL_OFF + MoeTbl::UNITS), (const LAS unsigned*)(F.lds + TBL_OFF + MoeTbl::ROWOFF), n, (size_t)DMODEL * DEXP * 2};
        pg8::Gemm g{(const bf16*)(ws + WS_HID), (const bf16*)(ws + WS_WDN), 0, DMODEL, DEXP};
        pg8::EpiDown E{(bf16*)(ws + WS_Y), (const LAS int*)(F.lds + TBL_OFF + MoeTbl::ROWOFF), (const LAS float*)(F.lds + TBL_OFF + MoeTbl::ROWW)};
        pg8::gemm_phase<pg8::EpiDown, MoeOrder, true, true, false>(F.lds + RING_OFF, g, S, E);
        if (BOTH(PH_DN)) GRID_BAR();
    }
    if (IN(PH_CMB)) {
        CArgs& args = *phase_args(); unsigned char* const ws = args.ws; float* const out = args.out; const float* const x = args.in[0]; (void)x; (void)out;
        Frame F = F0; { int t_ = threadIdx.x; asm volatile("" : "+v"(t_)); F.tid = t_; F.lane = t_ & 63; F.wave = __builtin_amdgcn_readfirstlane(t_ >> 6); }
        const int gw = F.vcu * NWAVES + F.wave, NGW = F.G * NWAVES; (void)gw; (void)NGW;
        const bf16* Y = (const bf16*)(ws + WS_Y);
#ifndef NO_CMB_LOOP
        for (int m = gw; m < TOK; m += NGW) {
            GAS f32x4* xr = (GAS f32x4*)(out + (size_t)m * DMODEL) + F.lane; const GAS f32x4* gr = (const GAS f32x4*)args.in[15] + F.lane;
            const GAS unsigned long long* y0 = (const GAS unsigned long long*)(Y + (size_t)(2 * m) * DMODEL) + F.lane; const GAS unsigned long long* y1 = (const GAS unsigned long long*)(Y + (size_t)(2 * m + 1) * DMODEL) + F.lane;
            f32x4 v[4]; float s = 0.f;
#pragma unroll
            for (int j = 0; j < 4; ++j) { v[j] = xr[64 * j]; const unsigned long long a = y0[64 * j], b = y1[64 * j];
                v[j].x += pg8::bf_lo((unsigned)a) + pg8::bf_lo((unsigned)b); v[j].y += pg8::bf_hi((unsigned)a) + pg8::bf_hi((unsigned)b);
                v[j].z += pg8::bf_lo((unsigned)(a >> 32)) + pg8::bf_lo((unsigned)(b >> 32)); v[j].w += pg8::bf_hi((unsigned)(a >> 32)) + pg8::bf_hi((unsigned)(b >> 32));
                xr[64 * j] = v[j]; s += (v[j].x * v[j].x + v[j].y * v[j].y) + (v[j].z * v[j].z + v[j].w * v[j].w); }
            const float rinv = 1.0f / sqrtf(wave_sum(s) * (1.f / DMODEL) + RMS_EPS);
            GAS unsigned long long* o8 = (GAS unsigned long long*)(HA + (size_t)m * DMODEL) + F.lane;
#pragma unroll
            for (int j = 0; j < 4; ++j) { const f32x4 gg = gr[64 * j]; o8[64 * j] = (unsigned long long)pk2(v[j].x * rinv * gg.x, v[j].y * rinv * gg.y) | ((unsigned long long)pk2(v[j].z * rinv * gg.z, v[j].w * rinv * gg.w) << 32); }
        }
#endif
        VM_WAIT(); __syncthreads();
#ifndef NO_PGEMM
        { pg8::Gemm g{PB, Wpp_t, TOK, DMODEL, PLE}; pg8::StaticOrder S; S.init(TOK, DMODEL, F.G, (int)blockIdx.x);
          pg8::EpiStoreBf16 E{(bf16*)(ws + WS_P), DMODEL};
          pg8::gemm_phase<pg8::EpiStoreBf16, pg8::StaticOrder, true, true, false>(F.lds + RING_OFF, g, S, E); }
#endif
        if (BOTH(PH_CMB)) GRID_BAR();
    }
    if (IN(PH_PG)) {
        CArgs& args = *phase_args(); unsigned char* const ws = args.ws; float* const out = args.out; const float* const x = args.in[0]; (void)x; (void)out;
        Frame F = F0; { int t_ = threadIdx.x; asm volatile("" : "+v"(t_)); F.tid = t_; F.lane = t_ & 63; F.wave = __builtin_amdgcn_readfirstlane(t_ >> 6); }
        const int gw = F.vcu * NWAVES + F.wave, NGW = F.G * NWAVES; (void)gw; (void)NGW;
        pg8::Gemm g{HA, Wpg_t, TOK, DMODEL, DMODEL}; pg8::StaticOrder S; S.init(TOK, DMODEL, F.G, (int)blockIdx.x);
        pg8::EpiPle E{out, (const bf16*)(ws + WS_P), (float*)(ws + WS_ST)};
        pg8::gemm_phase<pg8::EpiPle, pg8::StaticOrder, true, true, false>(F.lds + RING_OFF, g, S, E);
        if (BOTH(PH_PG)) GRID_BAR();
    }
    if (IN(PH_FIN)) {
        CArgs& args = *phase_args(); unsigned char* const ws = args.ws; float* const out = args.out; const float* const x = args.in[0]; (void)x; (void)out;
        Frame F = F0; { int t_ = threadIdx.x; asm volatile("" : "+v"(t_)); F.tid = t_; F.lane = t_ & 63; F.wave = __builtin_amdgcn_readfirstlane(t_ >> 6); }
        const int gw = F.vcu * NWAVES + F.wave, NGW = F.G * NWAVES; (void)gw; (void)NGW;
        const float* st = (const float*)(ws + WS_ST);
        for (int m = gw; m < TOK; m += NGW) {
            GAS f32x4* xr = (GAS f32x4*)(out + (size_t)m * DMODEL) + F.lane; const GAS f32x4* gr = (const GAS f32x4*)args.in[18] + F.lane;
            float s = 0.f;
#pragma unroll
            for (int k = 0; k < 16; ++k) s += st[(size_t)m * 16 + k];
            const float rinv = 1.0f / sqrtf(s * (1.f / DMODEL) + RMS_EPS);
#pragma unroll
            for (int j = 0; j < 4; ++j) { const f32x4 v = xr[64 * j]; xr[64 * j] = v * rinv * gr[64 * j]; }
        }
    }
#undef IN
#undef BOTH
#undef GRID_BAR
}

extern "C" void kernel_launch(void* const* d_in, const int* in_sizes, int n_in, void* d_out, int out_size, void* d_ws, size_t ws_size, hipStream_t stream) {
    static int grid = 0;
    if (grid == 0) {
        if (n_in != 19 || in_sizes[0] != TOK * DMODEL || out_size != TOK * DMODEL || ws_size < WS_END) { fprintf(stderr, "kernel_launch: unexpected problem shape (n_in %d, ws %zu); nothing launched\n", n_in, ws_size); grid = -1; return; }
        int dev = 0, cus = 0, per_cu = 0;
        if (hipGetDevice(&dev) != hipSuccess || hipDeviceGetAttribute(&cus, hipDeviceAttributeMultiprocessorCount, dev) != hipSuccess) { grid = -1; return; }
        if (hipFuncSetAttribute((const void*)fwd, hipFuncAttributeMaxDynamicSharedMemorySize, LDS_BYTES) != hipSuccess) { fprintf(stderr, "kernel_launch: hipFuncSetAttribute failed\n"); grid = -1; return; }
        if (hipOccupancyMaxActiveBlocksPerMultiprocessor(&per_cu, (const void*)fwd, NWAVES * 64, LDS_BYTES) != hipSuccess || per_cu < 1) fprintf(stderr, "kernel_launch: occupancy query reports %d\n", per_cu);
        (void)hipGetLastError();
        grid = cus;
        if (grid != 256) fprintf(stderr, "kernel_launch: %d CUs; this build is laid out for 256\n", grid);
    }
    if (grid < 0) return;
    if (hipMemsetAsync((char*)d_ws + WS_CTL, 0, CTL_ZERO_BYTES, stream) != hipSuccess) return;
    Args a{};
    for (int i = 0; i < 19; ++i) a.in[i] = (const float*)d_in[i];
    a.out = (float*)d_out; a.ws = (unsigned char*)d_ws;
    if (N_LAUNCHES == 1) { a.ph_lo = 0; a.ph_hi = PH_COUNT; hipLaunchKernelGGL(fwd, dim3(grid), dim3(NWAVES * 64), LDS_BYTES, stream, a); }
    else { for (int p = 0; p < PH_COUNT; ++p) { a.ph_lo = p; a.ph_hi = p + 1; hipLaunchKernelGGL(fwd, dim3(grid), dim3(NWAVES * 64), LDS_BYTES, stream, a); } }
}
```

```cpp
#include <hip/hip_runtime.h>
#include <hip/hip_bf16.h>
#include <cstdio>
#include <cstdint>
#include <cmath>

#ifndef MK_N_LAUNCHES
#define MK_N_LAUNCHES 1
#endif

namespace pg8 {
#define PG8_LAS __attribute__((address_space(3)))
typedef unsigned short bf16_t;
typedef short bf16x8 __attribute__((ext_vector_type(8)));
typedef float f32x4 __attribute__((ext_vector_type(4)));
typedef unsigned u32x4 __attribute__((ext_vector_type(4)));
typedef unsigned u32x2 __attribute__((ext_vector_type(2)));
typedef int v4i32 __attribute__((ext_vector_type(4)));
typedef int v8i32 __attribute__((ext_vector_type(8)));
constexpr int BM = 256, BK = 64, HALF = 128, HTB = HALF * BK * 2  , STAGE_BYTES = 8 * HTB, NXCD = 8, WGM = 8;

__host__ __device__ __forceinline__ int lds_byte(int r, int c) { const int st = (r >> 4) * 2 + (c >> 5), rr = r & 15, cc = c & 31, ob = rr * 64 + cc * 2; return st * 1024 + (ob ^ (((ob >> 9) & 1) << 5)); }
__host__ __device__ __forceinline__ void stage_rc(int b, int& R, int& C) { const int st = b / 1024, sb = b % 1024, swz = sb ^ (((sb >> 9) & 1) << 5); R = (st >> 1) * 16 + swz / 64; C = (st & 1) * 32 + (swz % 64) / 2; }
__host__ __device__ __forceinline__ int perm32(int rho) { const int n = rho >> 4, i = rho & 15; return 8 * (i >> 2) + 4 * n + (i & 3); }

struct Unit { int pm, pn; size_t boff; int e, valid; };
struct Gemm { const bf16_t* A; const bf16_t* Bt; int M, N, K; };

struct StaticOrder {
    int nM, nN, nwg, G, c;
    __host__ __device__ void init(int M, int N, int G_, int c_) { nM = M / BM; nN = N / BM; nwg = nM * nN; G = G_; c = c_; }
    __host__ __device__ bool next(int i, Unit& u) const { return at((long)i * G + c, u); }
    __host__ __device__ bool at(const long L, Unit& u) const {
        if (L >= nwg) return false;
        int wgid = (int)L; { const int q = nwg / NXCD, r = nwg % NXCD, xcd = wgid % NXCD, off = wgid / NXCD; wgid = (xcd < r ? xcd * (q + 1) : r * (q + 1) + (xcd - r) * q) + off; }
        const int nig = WGM * nN, gid = wgid / nig, fm = gid * WGM, gsz = (nM - fm) < WGM ? (nM - fm) : WGM;
        u.pm = fm + ((wgid % nig) % gsz); u.pn = (wgid % nig) / gsz; u.boff = 0; u.e = 0; u.valid = 256; return true;
    }
    __device__ __forceinline__ void a_ready(const Unit&, int, int) const {}
    __device__ __forceinline__ void done(const Unit&, int, int) const {}
    __device__ __forceinline__ unsigned arow(int, int) const { return 0u; }
};

struct StaticOrderSlice {
    StaticOrder S; int first, stride, limit;
    __host__ __device__ bool next(int i, Unit& u) const { const long L = (long)first + (long)i * stride; return first >= 0 && L < limit && S.at(L, u); }
    __device__ __forceinline__ void a_ready(const Unit&, int, int) const {}
    __device__ __forceinline__ void done(const Unit&, int, int) const {}
    __device__ __forceinline__ unsigned arow(int, int) const { return 0u; }
};
struct StaticOrderTail {
    StaticOrder S; int full, cut;
    __host__ __device__ bool next(int i, Unit& u) const {
        if (i < full) return S.at((long)i * S.G + S.c, u);
        if (S.c < cut) return false;
        return S.at((long)full * S.G + (long)(i - full) * (S.G - cut) + (S.c - cut), u); }
    __device__ __forceinline__ void a_ready(const Unit&, int, int) const {}
    __device__ __forceinline__ void done(const Unit&, int, int) const {}
    __device__ __forceinline__ unsigned arow(int, int) const { return 0u; }
};
struct StaticOrderRound {
    StaticOrder S; int round;
    __host__ __device__ bool next(int i, Unit& u) const { return i == 0 && S.next(round, u); }
    __device__ __forceinline__ void a_ready(const Unit&, int, int) const {}
    __device__ __forceinline__ void done(const Unit&, int, int) const {}
    __device__ __forceinline__ unsigned arow(int, int) const { return 0u; }
};
__device__ __forceinline__ unsigned cvt_pk_bf16(float lo, float hi) { unsigned r; asm volatile("v_cvt_pk_bf16_f32 %0, %1, %2" : "=v"(r) : "v"(lo), "v"(hi)); return r; }
__device__ __forceinline__ u32x4 pack8(const f32x4 a, const f32x4 b) { u32x4 w; w.x = cvt_pk_bf16(a[0], a[1]); w.y = cvt_pk_bf16(a[2], a[3]); w.z = cvt_pk_bf16(b[0], b[1]); w.w = cvt_pk_bf16(b[2], b[3]); return w; }
__device__ __forceinline__ u32x2 pack8_fp8(const f32x4 a, const f32x4 b) { int w0 = __builtin_amdgcn_cvt_pk_fp8_f32(a[0], a[1], 0, false); w0 = __builtin_amdgcn_cvt_pk_fp8_f32(a[2], a[3], w0, true);
    int w1 = __builtin_amdgcn_cvt_pk_fp8_f32(b[0], b[1], 0, false); w1 = __builtin_amdgcn_cvt_pk_fp8_f32(b[2], b[3], w1, true); return (u32x2){(unsigned)w0, (unsigned)w1}; }
__device__ __forceinline__ float bf_lo(unsigned w) { return __uint_as_float(w << 16); }
__device__ __forceinline__ float bf_hi(unsigned w) { return __uint_as_float(w & 0xffff0000u); }
__device__ __forceinline__ void unpack8(const u32x4 w, f32x4& a, f32x4& b) { a[0] = bf_lo(w.x); a[1] = bf_hi(w.x); a[2] = bf_lo(w.y); a[3] = bf_hi(w.y); b[0] = bf_lo(w.z); b[1] = bf_hi(w.z); b[2] = bf_lo(w.w); b[3] = bf_hi(w.w); }
__device__ __forceinline__ float sigmoidf_(float v) { return __builtin_amdgcn_rcpf(1.0f + __builtin_amdgcn_exp2f(-1.4426950408889634f * v)); }

template <class Epi, class Sched, bool ALIGN_EPI = false, bool SP2 = false, bool GATHER = false, bool FP8 = false>
__device__ __forceinline__ void gemm_phase(PG8_LAS unsigned char* lds, const Gemm g, const Sched& S, const Epi& E, const int tid_in) {
    int tidl_ = tid_in; asm volatile("" : "+v"(tidl_));
    const int tid = tidl_, wid = __builtin_amdgcn_readfirstlane(tid >> 6), lane = tid & 63, wr = wid >> 2, wc = wid & 3, fr = lane & 15, fq = lane >> 4;
    int Kl_ = g.K; asm volatile("" : "+s"(Kl_));
    const int K = Kl_; const int KB = FP8 ? K : 2 * K; const int nt = KB / (2 * BK);
    unsigned voffA[2], voffB[2], stC2[2]; int stR[2];
#pragma unroll
    for (int i = 0; i < 2; ++i) { int R, C; stage_rc(tid * 16 + i * 8192, R, C); const int Rb = Epi::PERM ? ((R & ~31) + perm32(R & 31)) : R;
        voffA[i] = (unsigned)(R * KB + 2 * C); voffB[i] = (unsigned)(Rb * KB + 2 * C); stR[i] = R; stC2[i] = (unsigned)C * 2u; }
    const size_t kstep = (size_t)(BK * 2);
    const size_t hstep = (size_t)HALF * KB;
    const size_t tstep = 2 * hstep;
    const unsigned ldsw = (unsigned)wid * 1024u;
    const int aoff = lds_byte(wr * 64 + fr, fq * 8), boff = lds_byte(wc * 32 + fr, fq * 8);
#define PG8_SA(b, h) (((b) * 2 + (h)) * HTB)
#define PG8_SB(b, h) ((4 + (b) * 2 + (h)) * HTB)
#define PG8_STAGE(bufoff, gbase, voff) do { _Pragma("unroll") for (int _i = 0; _i < 2; ++_i) \
        __builtin_amdgcn_global_load_lds((const unsigned*)((const char*)(gbase) + (voff)[_i]), (PG8_LAS unsigned*)(lds + (bufoff) + ldsw + _i * 8192), 16, 0, 0); } while (0)
#define PG8_STAGE_A(bufoff, base, h, NX) do { if constexpr (GATHER) { unsigned _v[2]; _v[0] = (NX) ? gAn[h][0] : gAc[h][0]; _v[1] = (NX) ? gAn[h][1] : gAc[h][1]; PG8_STAGE(bufoff, base, _v); } \
        else { PG8_STAGE(bufoff, (base) + (h) * hstep, voffA); } } while (0)
#define PG8_LDA(dst, b, h) do { _Pragma("unroll") for (int m = 0; m < 4; ++m) _Pragma("unroll") for (int k = 0; k < 2; ++k) dst[m][k] = *(const PG8_LAS bf16x8*)(lds + PG8_SA(b, h) + aoff + m * 2048 + k * 1024); } while (0)
#define PG8_LDB(dst, b, h) do { _Pragma("unroll") for (int n = 0; n < 2; ++n) _Pragma("unroll") for (int k = 0; k < 2; ++k) dst[n][k] = *(const PG8_LAS bf16x8*)(lds + PG8_SB(b, h) + boff + n * 2048 + k * 1024); } while (0)
#define PG8_MMA(ai, bj, At, Bt) do { __builtin_amdgcn_s_setprio(1); _Pragma("unroll") for (int m = 0; m < 4; ++m) _Pragma("unroll") for (int n = 0; n < 2; ++n) _Pragma("unroll") for (int k = 0; k < 2; ++k) \
        acc[ai][bj][m][n] = __builtin_amdgcn_mfma_f32_16x16x32_bf16(Bt[n][k], At[m][k], acc[ai][bj][m][n], 0, 0, 0); __builtin_amdgcn_s_setprio(0); } while (0)
#define PG8_MMA8(ai, bj, At, Bt) do { __builtin_amdgcn_s_setprio(1); _Pragma("unroll") for (int m = 0; m < 4; ++m) _Pragma("unroll") for (int n = 0; n < 2; ++n) { \
        const v8i32 b8_ = __builtin_shufflevector(__builtin_bit_cast(v4i32, Bt[n][0]), __builtin_bit_cast(v4i32, Bt[n][1]), 0, 1, 2, 3, 4, 5, 6, 7); \
        const v8i32 a8_ = __builtin_shufflevector(__builtin_bit_cast(v4i32, At[m][0]), __builtin_bit_cast(v4i32, At[m][1]), 0, 1, 2, 3, 4, 5, 6, 7); \
        asm volatile("v_mfma_scale_f32_16x16x128_f8f6f4 %0, %1, %2, %0, %3, %3 op_sel_hi:[0,0,0]" : "+v"(acc[ai][bj][m][n]) : "v"(b8_), "v"(a8_), "v"(one8_)); } __builtin_amdgcn_s_setprio(0); } while (0)
#define PG8_MMAX(ai, bj, At, Bt) do { if constexpr (FP8) PG8_MMA8(ai, bj, At, Bt); else PG8_MMA(ai, bj, At, Bt); } while (0)
#define PG8_WAIT_V(n) asm volatile("s_waitcnt vmcnt(" #n ")" ::: "memory")
#define PG8_WAIT_L(n) asm volatile("s_waitcnt lgkmcnt(" #n ")" ::: "memory")
#define PG8_BAR __builtin_amdgcn_s_barrier()
#define PG8_SCHED __builtin_amdgcn_sched_barrier(0)
    const int one8_ = 0x7f7f7f7f;
    Unit cur, nxt; int ui = 0;
    if (!S.next(0, cur)) return;
    f32x4 acc[2][2][4][2];
#pragma unroll
    for (int a = 0; a < 2; ++a)
#pragma unroll
        for (int b = 0; b < 2; ++b)
#pragma unroll
            for (int m = 0; m < 4; ++m)
#pragma unroll
                for (int n = 0; n < 2; ++n) acc[a][b][m][n] = (f32x4){0.f, 0.f, 0.f, 0.f};
    bf16x8 At[4][2], B0[2][2], B1[2][2];
    const char* cA = GATHER ? (const char*)g.A : (const char*)g.A + (size_t)cur.pm * tstep; const char* cB = (const char*)g.Bt + cur.boff + (size_t)cur.pn * tstep;
    unsigned gAc[2][2], gAn[2][2];
    if constexpr (GATHER) { _Pragma("unroll") for (int h = 0; h < 2; ++h) _Pragma("unroll") for (int i = 0; i < 2; ++i) { gAc[h][i] = S.arow(0, h * HALF + stR[i]) + stC2[i]; gAn[h][i] = gAc[h][i]; } }
    S.a_ready(cur, wid, lane);
    if constexpr (SP2) {
        PG8_STAGE(PG8_SB(0, 0), cB, voffB); PG8_STAGE(PG8_SB(0, 1), cB + hstep, voffB); PG8_STAGE_A(PG8_SA(0, 0), cA, 0, false); PG8_STAGE_A(PG8_SA(0, 1), cA, 1, false);
        if (wr == 1) PG8_BAR;
        PG8_WAIT_V(2); PG8_BAR;
        PG8_STAGE(PG8_SB(1, 0), cB + kstep, voffB); PG8_STAGE_A(PG8_SA(1, 0), cA + kstep, 0, false); PG8_STAGE(PG8_SB(1, 1), cB + hstep + kstep, voffB);
        PG8_WAIT_V(6); PG8_BAR;
    } else {
        PG8_STAGE(PG8_SB(0, 0), cB, voffB); PG8_STAGE_A(PG8_SA(0, 0), cA, 0, false); PG8_STAGE(PG8_SB(0, 1), cB + hstep, voffB); PG8_STAGE_A(PG8_SA(0, 1), cA, 1, false);
        if (wr == 1) PG8_BAR;
        PG8_WAIT_V(4); PG8_BAR;
        PG8_STAGE(PG8_SB(1, 0), cB + kstep, voffB); PG8_STAGE_A(PG8_SA(1, 0), cA + kstep, 0, false); PG8_STAGE(PG8_SB(1, 1), cB + hstep + kstep, voffB);
        PG8_WAIT_V(6); PG8_BAR;
    }
    for (;;) {
        const bool has_next = S.next(ui + 1, nxt);
        const char* nA = GATHER ? cA : (has_next ? (const char*)g.A + (size_t)nxt.pm * tstep : cA); const char* nB = has_next ? (const char*)g.Bt + nxt.boff + (size_t)nxt.pn * tstep : cB;
        if constexpr (GATHER) { if (has_next) { _Pragma("unroll") for (int h = 0; h < 2; ++h) _Pragma("unroll") for (int i = 0; i < 2; ++i) gAn[h][i] = S.arow(ui + 1, h * HALF + stR[i]) + stC2[i]; } }
        for (int t = 0; t < nt; t += 2) {
            if constexpr (Epi::MID_HOOK) { if (t == (nt >> 1)) { asm volatile("s_nop 15\n\ts_nop 7" ::: "memory"); E.mid(acc, cur, ui, wr, wc, fr, fq); asm volatile("s_nop 7" ::: "memory"); } }
            const bool last = (t == nt - 2);
            const char* a1 = cA + (size_t)(t + 1) * kstep;
            const char* a2 = last ? nA : cA + (size_t)(t + 2) * kstep; const char* b2 = last ? nB : cB + (size_t)(t + 2) * kstep;
            const char* a3 = a2 + kstep; const char* b3 = b2 + kstep;
            if (last && has_next) S.a_ready(nxt, wid, lane);
            if constexpr (SP2) {
            PG8_LDB(B0, 0, 0); PG8_LDB(B1, 0, 1); PG8_SCHED; PG8_LDA(At, 0, 0); PG8_STAGE_A(PG8_SA(1, 1), a1, 1, false);
            PG8_WAIT_V(8); PG8_WAIT_L(0); PG8_BAR; PG8_MMAX(0, 0, At, B0); PG8_MMAX(0, 1, At, B1); PG8_BAR; PG8_SCHED;
            PG8_LDA(At, 0, 1); PG8_STAGE(PG8_SB(0, 0), b2, voffB); PG8_STAGE(PG8_SB(0, 1), b2 + hstep, voffB); PG8_STAGE_A(PG8_SA(0, 0), a2, 0, last);
            PG8_WAIT_V(8); PG8_WAIT_L(0); PG8_BAR; PG8_MMAX(1, 0, At, B0); PG8_MMAX(1, 1, At, B1); PG8_BAR; PG8_SCHED;
            PG8_LDB(B0, 1, 0); PG8_LDB(B1, 1, 1); PG8_SCHED; PG8_LDA(At, 1, 0); PG8_STAGE_A(PG8_SA(0, 1), a2, 1, last);
            PG8_WAIT_V(8); PG8_WAIT_L(0); PG8_BAR; PG8_MMAX(0, 0, At, B0); PG8_MMAX(0, 1, At, B1); PG8_BAR; PG8_SCHED;
            PG8_LDA(At, 1, 1); PG8_STAGE(PG8_SB(1, 0), b3, voffB); PG8_STAGE(PG8_SB(1, 1), b3 + hstep, voffB); PG8_STAGE_A(PG8_SA(1, 0), a3, 0, last);
            PG8_WAIT_V(8); PG8_WAIT_L(0); PG8_BAR; PG8_MMAX(1, 0, At, B0); PG8_MMAX(1, 1, At, B1); PG8_BAR; PG8_SCHED;
            } else {
            PG8_LDB(B0, 0, 0); PG8_SCHED; PG8_LDA(At, 0, 0); PG8_STAGE_A(PG8_SA(1, 1), a1, 1, false);
            PG8_WAIT_L(8); PG8_BAR; PG8_WAIT_L(0); PG8_MMAX(0, 0, At, B0); PG8_BAR; PG8_SCHED;
            PG8_LDB(B1, 0, 1); PG8_STAGE(PG8_SB(0, 0), b2, voffB);
            PG8_BAR; PG8_WAIT_L(0); PG8_MMAX(0, 1, At, B1); PG8_BAR;
            PG8_LDA(At, 0, 1); PG8_STAGE_A(PG8_SA(0, 0), a2, 0, last);
            PG8_BAR; PG8_WAIT_L(0); PG8_MMAX(1, 0, At, B0); PG8_BAR; PG8_SCHED;
            PG8_STAGE(PG8_SB(0, 1), b2 + hstep, voffB);
            PG8_WAIT_V(6); PG8_BAR; PG8_MMAX(1, 1, At, B1); PG8_BAR;
            PG8_LDB(B0, 1, 0); PG8_SCHED; PG8_LDA(At, 1, 0); PG8_STAGE_A(PG8_SA(0, 1), a2, 1, last);
            PG8_WAIT_L(8); PG8_BAR; PG8_WAIT_L(0); PG8_MMAX(0, 0, At, B0); PG8_BAR; PG8_SCHED;
            PG8_LDB(B1, 1, 1); PG8_STAGE(PG8_SB(1, 0), b3, voffB);
            PG8_BAR; PG8_WAIT_L(0); PG8_MMAX(0, 1, At, B1); PG8_BAR;
            PG8_LDA(At, 1, 1); PG8_STAGE_A(PG8_SA(1, 0), a3, 0, last);
            PG8_BAR; PG8_WAIT_L(0); PG8_MMAX(1, 0, At, B0); PG8_BAR; PG8_SCHED;
            PG8_STAGE(PG8_SB(1, 1), b3 + hstep, voffB);
            PG8_WAIT_V(6); PG8_BAR; PG8_MMAX(1, 1, At, B1); PG8_BAR;
            }
        }
        if constexpr (ALIGN_EPI) { if (wr == 0) PG8_BAR; }
        if constexpr (FP8) asm volatile("s_nop 15\n\ts_nop 7" ::: "memory");
        if constexpr (!Epi::AFTER_DRAIN) { E(acc, cur, ui, wr, wc, fr, fq); S.done(cur, wid, lane); }
        if (!has_next) break;
#pragma unroll
        for (int a = 0; a < 2; ++a)
#pragma unroll
            for (int b = 0; b < 2; ++b)
#pragma unroll
                for (int m = 0; m < 4; ++m)
#pragma unroll
                    for (int n = 0; n < 2; ++n) acc[a][b][m][n] = (f32x4){0.f, 0.f, 0.f, 0.f};
        cur = nxt; cA = nA; cB = nB; ++ui;
        if constexpr (GATHER) { _Pragma("unroll") for (int h = 0; h < 2; ++h) _Pragma("unroll") for (int i = 0; i < 2; ++i) gAc[h][i] = gAn[h][i]; }
        if constexpr (ALIGN_EPI) { if (wr == 1) PG8_BAR; }
    }
    PG8_WAIT_V(0);
    if constexpr (!ALIGN_EPI) { if (wr == 0) PG8_BAR; }
    PG8_BAR;
#undef PG8_SA
#undef PG8_SB
#undef PG8_STAGE
#undef PG8_STAGE_A
#undef PG8_LDA
#undef PG8_LDB
#undef PG8_MMA
#undef PG8_MMA8
#undef PG8_MMAX
#undef PG8_WAIT_V
#undef PG8_WAIT_L
#undef PG8_BAR
#undef PG8_SCHED
}


constexpr int BATCH = 8, SEQ = 4096, DMODEL = 1024, TOK = BATCH * SEQ;
constexpr int NHEAD = 8, HD = 64, AW = 512;
constexpr int IN_COLS = 5704, ZN = 5888;
constexpr int NEXP = 32, DEXP = 512, PLE = 256;
constexpr float RMS_EPS = 1e-6f;
constexpr float C2 = 0.125f * 1.4426950408889634f;
constexpr float IW_SCALE = 0.125f * 0.35355339059327373f;

template <int FP> struct EpiZ {
    static constexpr bool PERM = true, AFTER_DRAIN = false, MID_HOOK = false;
    bf16_t *QA, *KA, *VA, *QB, *KB, *VB, *IQ, *IK, *GA, *GB; float* IW; float* kmean; const float* ropec; const float* ropes;
    __device__ __forceinline__ void operator()(f32x4 (&acc)[2][2][4][2], const Unit& u, int, int wr, int wc, int fr, int fq) const {
        const int pn = u.pn;
        if (FP == 1 && pn >= 4 && pn < 12) {
            const int j = pn - 4;
#pragma unroll
            for (int ai = 0; ai < 2; ++ai)
#pragma unroll
                for (int m = 0; m < 4; ++m) { const int row = u.pm * BM + ai * HALF + wr * 64 + m * 16 + fr; const size_t off = (size_t)row * DMODEL + j * HALF + wc * 32 + 8 * fq;
                    f32x4 a0 = acc[ai][0][m][0] * (1.0f / 32.0f), a1 = acc[ai][0][m][1] * (1.0f / 32.0f), b0 = acc[ai][1][m][0] * (1.0f / 32.0f), b1 = acc[ai][1][m][1] * (1.0f / 32.0f);
#pragma unroll
                    for (int i = 0; i < 4; ++i) { a0[i] = sigmoidf_(a0[i]); a1[i] = sigmoidf_(a1[i]); b0[i] = sigmoidf_(b0[i]); b1[i] = sigmoidf_(b1[i]);
                        a0[i] *= __builtin_amdgcn_rcpf(fmaxf(b0[i], 1e-30f)); a1[i] *= __builtin_amdgcn_rcpf(fmaxf(b1[i], 1e-30f)); }
                    *(u32x4*)(GA + off) = pack8(a0, a1); *(u32x4*)(GB + off) = pack8(b0, b1); }
            return; }
        bf16_t* dst; int ld, colt; bool rope_t = false, isq = false, iskm = false, issig = false; const bool ikw = (FP == 0) && (pn == 2);
        if (FP == 0) {
            if (pn < 2) { colt = (pn & 1) * 256; ld = AW; rope_t = true; dst = QA + (size_t)6 * ((size_t)TOK * AW); }
            else { dst = IK; ld = 64; colt = 0; rope_t = true; }
        } else {
            const int h = pn >> 1; const int ti = (pn < 4) ? 2 + 3 * h : (pn < 16) ? h - 3 : h - 8;
            colt = (pn & 1) * 256; ld = AW; rope_t = (pn >= 4); isq = (h == 6) || (h == 8); iskm = (h == 9); dst = QA + (size_t)ti * ((size_t)TOK * AW);
        }
        constexpr float WS = (FP == 1) ? (1.0f / 32.0f) : 1.0f;
        const bool rope_w = rope_t && ((wc & 1) == 0);
        const float rs = (fq == 0) ? -1.f : 1.f; const bool rl = fq < 2;
        f32x4 cs[2][2];
#pragma unroll
        for (int bj = 0; bj < 2; ++bj)
#pragma unroll
            for (int n = 0; n < 2; ++n) cs[bj][n] = (f32x4){0.f, 0.f, 0.f, 0.f};
#pragma unroll
        for (int ai = 0; ai < 2; ++ai)
#pragma unroll
            for (int m = 0; m < 4; ++m) {
                const int row = u.pm * BM + ai * HALF + wr * 64 + m * 16 + fr; const int pos = row & (SEQ - 1);
                f32x4 c0 = (f32x4){1.f, 1.f, 1.f, 1.f}, c1 = c0, s0 = (f32x4){0.f, 0.f, 0.f, 0.f}, s1 = s0;
                if (rope_w) { const f32x4 a = *(const f32x4*)(ropec + pos * 8), b = *(const f32x4*)(ropec + pos * 8 + 4), c = *(const f32x4*)(ropes + pos * 8), d = *(const f32x4*)(ropes + pos * 8 + 4);
                    if (rl) { c0 = a; c1 = b; s0 = c * rs; s1 = d * rs; } }
#pragma unroll
                for (int bj = 0; bj < 2; ++bj) {
                    f32x4 v0 = acc[ai][bj][m][0] * WS, v1 = acc[ai][bj][m][1] * WS;
                    if (ikw && bj == 1) continue;
                    if (rope_w && !(ikw && wc != 0)) {
                        f32x4 o0, o1;
#pragma unroll
                        for (int i = 0; i < 4; ++i) { o0[i] = __shfl_xor(v0[i], 16); o1[i] = __shfl_xor(v1[i], 16); }
                        v0 = v0 * c0 + o0 * s0; v1 = v1 * c1 + o1 * s1;
                    }
                    if (isq) { v0 = v0 * C2; v1 = v1 * C2; }
                    if (FP == 0 && iskm) { cs[bj][0] += v0; cs[bj][1] += v1; }
                    if (issig) {
#pragma unroll
                        for (int i = 0; i < 4; ++i) { v0[i] = sigmoidf_(v0[i]); v1[i] = sigmoidf_(v1[i]); } }
                    const int col = bj * HALF + wc * 32 + 8 * fq;
                    if (ikw) {
                        if (wc < 2) *(u32x4*)(dst + (size_t)row * 64 + col) = pack8(v0, v1);
                        else if (wc == 2 && fq == 0) { *(f32x4*)(IW + (size_t)row * 8) = v0 * IW_SCALE; *(f32x4*)(IW + (size_t)row * 8 + 4) = v1 * IW_SCALE; }
                    } else *(u32x4*)(dst + (size_t)row * ld + colt + col) = pack8(v0, v1);
                }
            }
        if (FP == 1 && iskm) {
            __builtin_amdgcn_sched_barrier(0);
            const int b = u.pm >> 4, blk = u.pm & 15;
#pragma unroll
            for (int bj = 0; bj < 2; ++bj)
#pragma unroll
                for (int n = 0; n < 2; ++n) { f32x4 c4 = (f32x4){0.f, 0.f, 0.f, 0.f};
#pragma unroll
                    for (int ai = 0; ai < 2; ++ai)
#pragma unroll
                        for (int m = 0; m < 4; ++m) { const int row = u.pm * BM + ai * HALF + wr * 64 + m * 16 + fr; const int pos = row & (SEQ - 1);
                            f32x4 v = acc[ai][bj][m][n] * WS;
                            if (rope_w) { f32x4 cc = (f32x4){1.f, 1.f, 1.f, 1.f}, ss = (f32x4){0.f, 0.f, 0.f, 0.f};
                                const f32x4 a = *(const f32x4*)(ropec + pos * 8 + 4 * n), c = *(const f32x4*)(ropes + pos * 8 + 4 * n);
                                if (rl) { cc = a; ss = c * rs; }
                                f32x4 o;
#pragma unroll
                                for (int i = 0; i < 4; ++i) o[i] = __shfl_xor(v[i], 16);
                                v = v * cc + o * ss; }
                            c4 += v; }
#pragma unroll
                    for (int i = 0; i < 4; ++i) { float s = c4[i]; s += __shfl_xor(s, 1); s += __shfl_xor(s, 2); s += __shfl_xor(s, 4); s += __shfl_xor(s, 8);
                        if (fr == 0) { const int col = (pn & 1) * 256 + bj * HALF + wc * 32 + 8 * fq + 4 * n + i; const int h = col >> 6, d = col & 63;
                            atomicAdd(kmean + ((size_t)((b * NHEAD + h) * 16 + blk) * 64 + d), s * (1.0f / 256.0f)); } }
                    __builtin_amdgcn_sched_barrier(0); }
        }
        if (FP == 0 && iskm) {
            const int b = u.pm >> 4, blk = u.pm & 15;
#pragma unroll
            for (int bj = 0; bj < 2; ++bj)
#pragma unroll
                for (int n = 0; n < 2; ++n)
#pragma unroll
                    for (int i = 0; i < 4; ++i) { float s = cs[bj][n][i]; s += __shfl_xor(s, 1); s += __shfl_xor(s, 2); s += __shfl_xor(s, 4); s += __shfl_xor(s, 8);
                        if (fr == 0) { const int col = (pn & 1) * 256 + bj * HALF + wc * 32 + 8 * fq + 4 * n + i; const int h = col >> 6, d = col & 63;
                            atomicAdd(kmean + ((size_t)((b * NHEAD + h) * 16 + blk) * 64 + d), s * (1.0f / 256.0f)); } }
        }
    }
};
struct EpiStoreBf16 {
    static constexpr bool PERM = true, AFTER_DRAIN = false, MID_HOOK = false;
    bf16_t* O; int ld;
    __device__ __forceinline__ void operator()(f32x4 (&acc)[2][2][4][2], const Unit& u, int, int wr, int wc, int fr, int fq) const {
#pragma unroll
        for (int ai = 0; ai < 2; ++ai)
#pragma unroll
            for (int m = 0; m < 4; ++m) { const int row = u.pm * BM + ai * HALF + wr * 64 + m * 16 + fr;
#pragma unroll
                for (int bj = 0; bj < 2; ++bj) { const int col = u.pn * BM + bj * HALF + wc * 32 + 8 * fq;
                    *(u32x4*)(O + (size_t)row * ld + col) = pack8(acc[ai][bj][m][0], acc[ai][bj][m][1]); } }
    }
};
template <int MODE> struct EpiBranch {
    static constexpr bool PERM = true, AFTER_DRAIN = false, MID_HOOK = false;
    const bf16_t* G; const bf16_t* Tin; void* O;
    __device__ __forceinline__ void operator()(f32x4 (&acc)[2][2][4][2], const Unit& u, int, int wr, int wc, int fr, int fq) const {
        constexpr float WS = 1.0f / 512.0f;
#pragma unroll
        for (int ai = 0; ai < 2; ++ai)
#pragma unroll
            for (int m = 0; m < 4; ++m) { const int row = u.pm * BM + ai * HALF + wr * 64 + m * 16 + fr;
#pragma unroll
                for (int bj = 0; bj < 2; ++bj) { const size_t off = (size_t)row * DMODEL + u.pn * BM + bj * HALF + wc * 32 + 8 * fq;
                    f32x4 g0, g1; unpack8(*(const u32x4*)(G + off), g0, g1);
                    f32x4 v0 = acc[ai][bj][m][0] * WS * g0, v1 = acc[ai][bj][m][1] * WS * g1;
                    if (MODE == 1) { f32x4 t0, t1; unpack8(*(const u32x4*)(Tin + off), t0, t1); v0 += t0; v1 += t1; *(u32x2*)((unsigned char*)O + off) = pack8_fp8(v0 * 8.0f, v1 * 8.0f); }
                    else *(u32x4*)((bf16_t*)O + off) = pack8(v0, v1); } }
    }
};
__device__ __forceinline__ u32x4 widen16(const u32x2 a, const u32x2 b) {
    const auto rx = __builtin_amdgcn_permlane16_swap(a.x, b.x, false, false); const auto ry = __builtin_amdgcn_permlane16_swap(a.y, b.y, false, false);
    return (u32x4){(unsigned)rx[0], (unsigned)ry[0], (unsigned)rx[1], (unsigned)ry[1]}; }
struct EpiMerged {
    static constexpr bool PERM = true, AFTER_DRAIN = false, MID_HOOK = true;
    const bf16_t* GA; const bf16_t* GB; unsigned char* O;
    __device__ __forceinline__ void mid(f32x4 (&acc)[2][2][4][2], const Unit& u, int, int wr, int wc, int fr_in, int fq_in) const {
        int fr = fr_in, fq = fq_in; asm volatile("" : "+v"(fr), "+v"(fq));
#pragma unroll
        for (int ai = 0; ai < 2; ++ai) { u32x4 ga_[4][2];
#pragma unroll
            for (int m = 0; m < 4; ++m)
#pragma unroll
                for (int bj = 0; bj < 2; ++bj) ga_[m][bj] = *(const u32x4*)(GA + (size_t)(u.pm * BM + ai * HALF + wr * 64 + m * 16 + fr) * DMODEL + u.pn * BM + bj * HALF + wc * 32 + 8 * fq);
#pragma unroll
            for (int m = 0; m < 4; ++m)
#pragma unroll
                for (int bj = 0; bj < 2; ++bj) { f32x4 a0, a1; unpack8(ga_[m][bj], a0, a1); acc[ai][bj][m][0] *= a0; acc[ai][bj][m][1] *= a1; }
            asm volatile("" ::: "memory"); }
    }
    __device__ __forceinline__ void operator()(f32x4 (&acc)[2][2][4][2], const Unit& u, int, int wr, int wc, int fr, int fq) const {
        constexpr float WS = 8.0f / 512.0f;
        const int odd = fq & 1;
#pragma unroll
        for (int ai = 0; ai < 2; ++ai) { u32x4 gv[4][2];
#pragma unroll
            for (int m = 0; m < 4; ++m)
#pragma unroll
                for (int bj = 0; bj < 2; ++bj) gv[m][bj] = *(const u32x4*)(GB + (size_t)(u.pm * BM + ai * HALF + wr * 64 + m * 16 + fr) * DMODEL + u.pn * BM + bj * HALF + wc * 32 + 8 * fq);
#pragma unroll
            for (int mp = 0; mp < 2; ++mp) { const int row = u.pm * BM + ai * HALF + wr * 64 + (2 * mp + odd) * 16 + fr;
#pragma unroll
                for (int bj = 0; bj < 2; ++bj) {
                    f32x4 g0, g1, h0, h1; unpack8(gv[2 * mp][bj], g0, g1); unpack8(gv[2 * mp + 1][bj], h0, h1);
                    const u32x4 v = widen16(pack8_fp8(acc[ai][bj][2 * mp][0] * WS * g0, acc[ai][bj][2 * mp][1] * WS * g1), pack8_fp8(acc[ai][bj][2 * mp + 1][0] * WS * h0, acc[ai][bj][2 * mp + 1][1] * WS * h1));
                    *(u32x4*)(O + (size_t)row * DMODEL + u.pn * BM + bj * HALF + wc * 32 + 8 * (fq - odd)) = v; } }
            asm volatile("" ::: "memory"); }
    }
};
struct EpiResidualB {
    static constexpr bool PERM = true, AFTER_DRAIN = false, MID_HOOK = false;
    const bf16_t* h1; const float* rstd; const float* g; bf16_t* o;
    __device__ __forceinline__ void operator()(f32x4 (&acc)[2][2][4][2], const Unit& u, int, int wr, int wc, int fr, int fq) const {
        f32x4 gi[2][2];
#pragma unroll
        for (int bj = 0; bj < 2; ++bj)
#pragma unroll
            for (int n = 0; n < 2; ++n) { const f32x4 gg = *(const f32x4*)(g + u.pn * BM + bj * HALF + wc * 32 + 8 * fq + 4 * n);
#pragma unroll
                for (int i = 0; i < 4; ++i) gi[bj][n][i] = (gg[i] != 0.f) ? 1.0f / gg[i] : 0.f; }
#pragma unroll
        for (int ai = 0; ai < 2; ++ai) { u32x4 hv[4][2]; float rs[4];
#pragma unroll
            for (int m = 0; m < 4; ++m) { const int row = u.pm * BM + ai * HALF + wr * 64 + m * 16 + fr; rs[m] = rstd[row];
#pragma unroll
                for (int bj = 0; bj < 2; ++bj) hv[m][bj] = *(const u32x4*)(h1 + (size_t)row * DMODEL + u.pn * BM + bj * HALF + wc * 32 + 8 * fq); }
#pragma unroll
            for (int m = 0; m < 4; ++m) { const int row = u.pm * BM + ai * HALF + wr * 64 + m * 16 + fr; const float rsv = rs[m];
#pragma unroll
                for (int bj = 0; bj < 2; ++bj) { const size_t off = (size_t)row * DMODEL + u.pn * BM + bj * HALF + wc * 32 + 8 * fq;
                    f32x4 h0, h1v; unpack8(hv[m][bj], h0, h1v);
                    *(u32x4*)(o + off) = pack8(h0 * rsv * gi[bj][0] + acc[ai][bj][m][0] * (1.0f / 256.0f), h1v * rsv * gi[bj][1] + acc[ai][bj][m][1] * (1.0f / 256.0f)); } }
            asm volatile("" ::: "memory"); }
    }
};
struct EpiResidual {
    static constexpr bool PERM = false, AFTER_DRAIN = false, MID_HOOK = false;
    const float* base; float* out;
    __device__ __forceinline__ void operator()(f32x4 (&acc)[2][2][4][2], const Unit& u, int, int wr, int wc, int fr, int fq) const {
#pragma unroll
        for (int ai = 0; ai < 2; ++ai)
#pragma unroll
            for (int m = 0; m < 4; ++m) { const int row = u.pm * BM + ai * HALF + wr * 64 + m * 16 + fr;
#pragma unroll
                for (int bj = 0; bj < 2; ++bj)
#pragma unroll
                    for (int n = 0; n < 2; ++n) { const size_t off = (size_t)row * DMODEL + u.pn * BM + bj * HALF + wc * 32 + 16 * n + 4 * fq;
                        *(f32x4*)(out + off) = *(const f32x4*)(base + off) + acc[ai][bj][m][n] * (1.0f / 256.0f); } }
    }
};
struct EpiPle {
    static constexpr bool PERM = false, AFTER_DRAIN = false, MID_HOOK = false;
    float* x; const bf16_t* P; float* stats;
    __device__ __forceinline__ void operator()(f32x4 (&acc)[2][2][4][2], const Unit& u, int, int wr, int wc, int fr, int fq) const {
#pragma unroll
        for (int ai = 0; ai < 2; ++ai)
#pragma unroll
            for (int m = 0; m < 4; ++m) { const int row = u.pm * BM + ai * HALF + wr * 64 + m * 16 + fr; float ss = 0.f;
#pragma unroll
                for (int bj = 0; bj < 2; ++bj)
#pragma unroll
                    for (int n = 0; n < 2; ++n) { const size_t off = (size_t)row * DMODEL + u.pn * BM + bj * HALF + wc * 32 + 16 * n + 4 * fq;
                        const u32x2 pw = *(const u32x2*)(P + off); const f32x4 pv = (f32x4){bf_lo(pw.x), bf_hi(pw.x), bf_lo(pw.y), bf_hi(pw.y)};
                        f32x4 g = acc[ai][bj][m][n] * (1.0f / 32.0f);
#pragma unroll
                        for (int i = 0; i < 4; ++i) g[i] = sigmoidf_(g[i]);
                        const f32x4 o = *(const f32x4*)(x + off) + g * pv; *(f32x4*)(x + off) = o;
                        ss += (o[0] * o[0] + o[1] * o[1]) + (o[2] * o[2] + o[3] * o[3]); }
                ss += __shfl_xor(ss, 16); ss += __shfl_xor(ss, 32);
                if (fq == 0) stats[(size_t)row * 16 + u.pn * 4 + wc] = ss; }
    }
};
struct EpiPleFin {
    static constexpr bool PERM = true, AFTER_DRAIN = false, MID_HOOK = false;
    float* x; const bf16_t* X1; const bf16_t* P; float* stats; unsigned* cnt; const float* gfin;
    __device__ __forceinline__ void operator()(f32x4 (&acc)[2][2][4][2], const Unit& u, int, int wr, int wc, int fr, int fq) const {
#pragma unroll
        for (int ai = 0; ai < 2; ++ai)
#pragma unroll
            for (int m = 0; m < 4; ++m) { const int row = u.pm * BM + ai * HALF + wr * 64 + m * 16 + fr; float ss = 0.f;
#pragma unroll
                for (int bj = 0; bj < 2; ++bj) { const int col = u.pn * BM + bj * HALF + wc * 32 + 8 * fq; const size_t off = (size_t)row * DMODEL + col;
                    f32x4 p0, p1; unpack8(*(const u32x4*)(P + off), p0, p1);
                    f32x4 x0, x1v; unpack8(*(const u32x4*)(X1 + off), x0, x1v);
                    f32x4 g0 = acc[ai][bj][m][0] * (1.0f / 32.0f), g1 = acc[ai][bj][m][1] * (1.0f / 32.0f);
#pragma unroll
                    for (int i = 0; i < 4; ++i) { g0[i] = sigmoidf_(g0[i]); g1[i] = sigmoidf_(g1[i]); }
                    const f32x4 o0 = x0 + g0 * p0, o1 = x1v + g1 * p1; acc[ai][bj][m][0] = o0; acc[ai][bj][m][1] = o1;
                    ss += ((o0[0] * o0[0] + o0[1] * o0[1]) + (o0[2] * o0[2] + o0[3] * o0[3])) + ((o1[0] * o1[0] + o1[1] * o1[1]) + (o1[2] * o1[2] + o1[3] * o1[3])); }
                ss += __shfl_xor(ss, 16); ss += __shfl_xor(ss, 32);
                if (fq == 0) __hip_atomic_store(stats + (size_t)row * 16 + u.pn * 4 + wc, ss, __ATOMIC_RELAXED, __HIP_MEMORY_SCOPE_AGENT); }
        unsigned* const c = cnt + 16 * u.pm;
        asm volatile("s_waitcnt vmcnt(0)" ::: "memory");
        if (fr == 0 && fq == 0) { (void)__hip_atomic_fetch_add(c, 1u, __ATOMIC_RELAXED, __HIP_MEMORY_SCOPE_AGENT);
            unsigned sp = 0; while (__hip_atomic_load(c, __ATOMIC_RELAXED, __HIP_MEMORY_SCOPE_AGENT) < 32u) { __builtin_amdgcn_s_sleep(1); if (++sp > (1u << 24)) break; } }
        asm volatile("" ::: "memory");
        f32x4 t4[2][4];
#pragma unroll
        for (int ai = 0; ai < 2; ++ai)
#pragma unroll
            for (int m = 0; m < 4; ++m) { const int row = u.pm * BM + ai * HALF + wr * 64 + m * 16 + fr; const float* sp_ = stats + (size_t)row * 16 + 4 * fq;
                asm volatile("global_load_dwordx4 %0, %1, off sc1" : "=v"(t4[ai][m]) : "v"(sp_) : "memory"); }
        asm volatile("s_waitcnt vmcnt(0)" : "+v"(t4[0][0]), "+v"(t4[0][1]), "+v"(t4[0][2]), "+v"(t4[0][3]), "+v"(t4[1][0]), "+v"(t4[1][1]), "+v"(t4[1][2]), "+v"(t4[1][3]) :: "memory");
#pragma unroll
        for (int ai = 0; ai < 2; ++ai)
#pragma unroll
            for (int m = 0; m < 4; ++m) { const int row = u.pm * BM + ai * HALF + wr * 64 + m * 16 + fr;
                float s = (t4[ai][m][0] + t4[ai][m][1]) + (t4[ai][m][2] + t4[ai][m][3]); s += __shfl_xor(s, 16); s += __shfl_xor(s, 32);
                const float rinv = 1.0f / sqrtf(s * (1.f / DMODEL) + RMS_EPS);
#pragma unroll
                for (int bj = 0; bj < 2; ++bj) { const int col = u.pn * BM + bj * HALF + wc * 32 + 8 * fq;
                    *(f32x4*)(x + (size_t)row * DMODEL + col) = acc[ai][bj][m][0] * rinv * *(const f32x4*)(gfin + col);
                    *(f32x4*)(x + (size_t)row * DMODEL + col + 4) = acc[ai][bj][m][1] * rinv * *(const f32x4*)(gfin + col + 4); } }
    }
};
struct EpiSwiglu {
    static constexpr bool PERM = true, AFTER_DRAIN = false, MID_HOOK = false;
    unsigned char* HID;
    __device__ __forceinline__ void operator()(f32x4 (&acc)[2][2][4][2], const Unit& u, int, int wr, int wc, int fr, int fq) const {
        constexpr float WS = 1.0f / 32.0f;
#pragma unroll
        for (int ai = 0; ai < 2; ++ai)
#pragma unroll
            for (int m = 0; m < 4; ++m) { const int row = u.pm * BM + ai * HALF + wr * 64 + m * 16 + fr;
                f32x4 h0, h1;
#pragma unroll
                for (int i = 0; i < 4; ++i) { const float g0 = acc[ai][0][m][0][i] * WS, g1 = acc[ai][0][m][1][i] * WS;
                    h0[i] = g0 * sigmoidf_(g0) * (acc[ai][1][m][0][i] * WS); h1[i] = g1 * sigmoidf_(g1) * (acc[ai][1][m][1][i] * WS); }
                { const u32x2 hv = pack8_fp8(h0, h1);
                  __hip_atomic_store((unsigned long long*)(HID + (size_t)row * DEXP + u.pn * HALF + wc * 32 + 8 * fq), (unsigned long long)hv.x | ((unsigned long long)hv.y << 32), __ATOMIC_RELAXED, __HIP_MEMORY_SCOPE_AGENT); } }
    }
};
struct EpiDown {
    static constexpr bool PERM = true, AFTER_DRAIN = false, MID_HOOK = false;
    unsigned char* Y; const PG8_LAS int* tokk; const PG8_LAS float* wt;
    __device__ __forceinline__ void operator()(f32x4 (&acc)[2][2][4][2], const Unit& u, int ui, int wr, int wc, int fr, int fq) const {
        const int odd = fq & 1;
#pragma unroll
        for (int ai = 0; ai < 2; ++ai)
#pragma unroll
            for (int mp = 0; mp < 2; ++mp) { const int r0 = ai * HALF + wr * 64 + (2 * mp) * 16 + fr, r1 = r0 + 16;
                const int tk0 = tokk[ui * 256 + r0], tk1 = tokk[ui * 256 + r1]; const float w0 = wt[ui * 256 + r0] * 2.0f, w1 = wt[ui * 256 + r1] * 2.0f;
                const int tk = odd ? tk1 : tk0;
#pragma unroll
                for (int bj = 0; bj < 2; ++bj) {
                    const u32x4 v = widen16(pack8_fp8(acc[ai][bj][2 * mp][0] * w0, acc[ai][bj][2 * mp][1] * w0), pack8_fp8(acc[ai][bj][2 * mp + 1][0] * w1, acc[ai][bj][2 * mp + 1][1] * w1));
                    *(u32x4*)(Y + (size_t)tk * DMODEL + u.pn * BM + bj * HALF + wc * 32 + 8 * (fq - odd)) = v; } }
    }
};
}

namespace att {
using bf16x8 = __attribute__((ext_vector_type(8))) short;
using s16x4 = __attribute__((ext_vector_type(4))) short;
using f32x16 = __attribute__((ext_vector_type(16))) float;
using u32x4 = __attribute__((ext_vector_type(4))) unsigned;
using u32x2 = __attribute__((ext_vector_type(2))) unsigned;
typedef unsigned short bf16r;
constexpr int SEQL = 4096, D = 64, DM = 512;
constexpr int NW = 8, QBLK = 32, QB = QBLK * NW, KVBLK = 64;
constexpr int SLOTB = 8192, NSLOT = 2;
constexpr int LDS_K = 0, LDS_V = NSLOT * SLOTB, LDS_WS = 2 * NSLOT * SLOTB, LDS_OST = LDS_WS + NW * 64 * 4, LDS_KM = LDS_OST + NW * 4096, LDS_BYTES = LDS_KM + 16 * 64 * 4;
constexpr float THR = 8.0f;
__device__ __forceinline__ int crow(int r, int hi) { return (r & 3) + 8 * (r >> 2) + 4 * hi; }
__device__ __forceinline__ void glds16(const void* gsrc, unsigned lds_dst) { unsigned keep;
    asm volatile("s_mov_b32 %0, m0\n\ts_mov_b32 m0, %2\n\ts_nop 0\n\tglobal_load_lds_dwordx4 %1, off\n\ts_mov_b32 m0, %0" : "=&s"(keep) : "v"(gsrc), "s"(lds_dst) : "memory"); }
typedef float f32x2_t __attribute__((ext_vector_type(2))); typedef __bf16 bf16x2_t __attribute__((ext_vector_type(2)));
__device__ __forceinline__ unsigned cvtpk_s(float lo, float hi) { f32x2_t v = {lo, hi}; bf16x2_t b = __builtin_convertvector(v, bf16x2_t); return __builtin_bit_cast(unsigned, b); }
__device__ __forceinline__ void qkt(f32x16& p0, f32x16& p1, const char* Kslot, const bf16x8* qr, const f32x16& cin, int r32, int hi) {
    const char* kb = Kslot + hi * 1024 + r32 * 16;
#pragma unroll
    for (int d0 = 0; d0 < 4; ++d0) {
        const bf16x8 b0 = *reinterpret_cast<const bf16x8*>(kb + d0 * 2048);
        const bf16x8 b1 = *reinterpret_cast<const bf16x8*>(kb + d0 * 2048 + 512);
        if (d0 == 0) { p0 = __builtin_amdgcn_mfma_f32_32x32x16_bf16(b0, qr[0], cin, 0, 0, 0); p1 = __builtin_amdgcn_mfma_f32_32x32x16_bf16(b1, qr[0], cin, 0, 0, 0); }
        else { p0 = __builtin_amdgcn_mfma_f32_32x32x16_bf16(b0, qr[d0], p0, 0, 0, 0); p1 = __builtin_amdgcn_mfma_f32_32x32x16_bf16(b1, qr[d0], p1, 0, 0, 0); } }
}
__device__ __forceinline__ float rowmax(const f32x16& p0, const f32x16& p1) {
    float a = __builtin_fmaxf(p0[0], p1[0]);
#pragma unroll
    for (int r = 1; r < 16; ++r) a = __builtin_fmaxf(a, __builtin_fmaxf(p0[r], p1[r]));
    auto rr = __builtin_amdgcn_permlane32_swap(__float_as_uint(a), __float_as_uint(a), false, false);
    return __builtin_fmaxf(__uint_as_float(rr[0]), __uint_as_float(rr[1]));
}
__device__ __forceinline__ void pv(f32x16* o, int vb, bf16x8 pa0, bf16x8 pa1, bf16x8 pa2, bf16x8 pa3) {
#pragma unroll
    for (int d0 = 0; d0 < 2; ++d0) { s16x4 lo[4], hi[4];
#pragma unroll
        for (int ks = 0; ks < 4; ++ks) {
            asm volatile("ds_read_b64_tr_b16 %0,%1 offset:%c2" : "=&v"(lo[ks]) : "v"(vb), "i"(d0 * 4096 + ks * 1024) : "memory");
            asm volatile("ds_read_b64_tr_b16 %0,%1 offset:%c2" : "=&v"(hi[ks]) : "v"(vb), "i"(d0 * 4096 + ks * 1024 + 512) : "memory"); }
        asm volatile("s_waitcnt lgkmcnt(0)" ::: "memory"); __builtin_amdgcn_sched_barrier(0);
#define ATT_PK(k) (bf16x8){lo[k][0], lo[k][1], lo[k][2], lo[k][3], hi[k][0], hi[k][1], hi[k][2], hi[k][3]}
        o[d0] = __builtin_amdgcn_mfma_f32_32x32x16_bf16(pa0, ATT_PK(0), o[d0], 0, 0, 0);
        o[d0] = __builtin_amdgcn_mfma_f32_32x32x16_bf16(pa1, ATT_PK(1), o[d0], 0, 0, 0);
        o[d0] = __builtin_amdgcn_mfma_f32_32x32x16_bf16(pa2, ATT_PK(2), o[d0], 0, 0, 0);
        o[d0] = __builtin_amdgcn_mfma_f32_32x32x16_bf16(pa3, ATT_PK(3), o[d0], 0, 0, 0);
#undef ATT_PK
    }
}
__device__ __forceinline__ float max3a(float a, float b, float c) { float r; asm("v_max3_f32 %0, %1, %2, %3" : "=v"(r) : "v"(a), "v"(b), "v"(c)); return r; }
__device__ __forceinline__ float rowmax_a(const f32x16& p0, const f32x16& p1) {
    float a = max3a(p0[0], p0[1], p1[0]), b = max3a(p0[2], p0[3], p1[1]); a = max3a(a, p1[2], p1[3]);
#pragma unroll
    for (int r = 4; r < 16; r += 4) { a = max3a(a, p0[r], p0[r + 1]); b = max3a(b, p0[r + 2], p0[r + 3]); a = max3a(a, p1[r], p1[r + 1]); b = max3a(b, p1[r + 2], p1[r + 3]); }
    float m; asm("v_max_f32_e32 %0, %1, %2" : "=v"(m) : "v"(a), "v"(b));
    auto rr = __builtin_amdgcn_permlane32_swap(__float_as_uint(m), __float_as_uint(m), false, false);
    float o; asm("v_max_f32_e32 %0, %1, %2" : "=v"(o) : "v"(__uint_as_float(rr[0])), "v"(__uint_as_float(rr[1]))); return o;
}
#define ATT_WAIT_BAR0() asm volatile("s_waitcnt vmcnt(0) lgkmcnt(0)\n\ts_barrier" ::: "memory")

template <int MODE> __device__ __forceinline__ void attn_unit(int b, int h, int qb, const bf16r* Q, const bf16r* __restrict__ K, const bf16r* __restrict__ V, bf16r* O, const void* aux, char* shm, const int tid_in) {
    int tidl_ = tid_in; asm volatile("" : "+v"(tidl_));
    const int tid = tidl_, lane = tid & 63, r32 = lane & 31, hi = lane >> 5; const int wid = __builtin_amdgcn_readfirstlane(tid >> 6);
    const long rowbase = (long)b * SEQL; const int q0 = qb * QB;
    const bf16r* Qw = Q + (rowbase + q0 + wid * QBLK) * DM + h * D;
    const bf16r* Kh = K + rowbase * DM + h * D, *Vh = V + rowbase * DM + h * D;
    const unsigned lds0 = (unsigned)(uintptr_t)shm;
    float* wsf = (float*)(shm + LDS_WS) + wid * 64;
    const bf16r* ksrc = Kh + (long)lane * DM + wid * 8;
    const bf16r* vsrc = Vh + (long)(16 * (wid & 3) + (lane >> 2)) * DM + (wid >> 2) * 32 + (lane & 3) * 8;
    const unsigned kdst = lds0 + LDS_K + wid * 1024, vdst = lds0 + LDS_V + wid * 1024;
#define DMA_K(t, slot) glds16(ksrc + (long)(t) * KVBLK * DM, (unsigned)__builtin_amdgcn_readfirstlane(kdst + (slot)))
#define DMA_V(t, slot) glds16(vsrc + (long)(t) * KVBLK * DM, (unsigned)__builtin_amdgcn_readfirstlane(vdst + (slot)))
    const int vb0 = (int)(lds0 + LDS_V) + ((lane >> 4) & 1) * 32 + (lane & 3) * 8 + (4 * hi + ((lane & 15) >> 2)) * 64;
    const char* Kbase = shm + LDS_K;
    const int NT = (q0 + QB) / KVBLK;
    DMA_K(0, 0); DMA_V(0, 0);
    bf16x8 qr[4];
#pragma unroll
    for (int d0 = 0; d0 < 4; ++d0) qr[d0] = *reinterpret_cast<const bf16x8*>(&Qw[(long)r32 * DM + d0 * 16 + hi * 8]);
    unsigned selmask = 0u;
    if (MODE == 0) {
        float* km = (float*)(shm + LDS_KM); const float* kmg = (const float*)aux + (size_t)(b * 8 + h) * 16 * 64;
        for (int i = tid; i < 16 * 64; i += NW * 64) km[i] = kmg[i];
        asm volatile("s_waitcnt vmcnt(0) lgkmcnt(0)" ::: "memory"); __syncthreads();
        float g[15];
#pragma unroll
        for (int j = 0; j < 15; ++j) { g[j] = -INFINITY;
            if (j < qb) { float s = 0.f;
#pragma unroll
                for (int d0 = 0; d0 < 4; ++d0)
#pragma unroll
                    for (int e = 0; e < 8; ++e) s += __uint_as_float(((unsigned)(unsigned short)qr[d0][e]) << 16) * km[j * 64 + d0 * 16 + hi * 8 + e];
                auto rr = __builtin_amdgcn_permlane32_swap(__float_as_uint(s), __float_as_uint(s), false, false);
                g[j] = __uint_as_float(rr[0]) + __uint_as_float(rr[1]); } }
#pragma unroll
        for (int k = 0; k < 3; ++k) { float best = -INFINITY; int bi = -1;
#pragma unroll
            for (int j = 0; j < 15; ++j) if (j < qb && !((selmask >> j) & 1u) && g[j] > best) { best = g[j]; bi = j; }
            if (bi >= 0) selmask |= 1u << bi; }
    }
    const unsigned* mrow = nullptr;
    if (MODE == 1) mrow = (const unsigned*)aux + (size_t)(rowbase + q0 + wid * QBLK + r32) * 128;
    float mhat = 0.f, l_reg = 0.f; f32x16 o[2]; o[0] = f32x16{}; o[1] = f32x16{};
    f32x16 negm = f32x16{};
    const int qrel = wid * QBLK + r32;
    for (int t = 0; t < NT; ++t) {
        ATT_WAIT_BAR0();
        if (t + 1 < NT) { DMA_K(t + 1, ((t + 1) & 1) * SLOTB); DMA_V(t + 1, ((t + 1) & 1) * SLOTB); }
        u32x2 mw = (u32x2){0u, 0u};
        if (MODE == 1) mw = *(const u32x2*)(mrow + 2 * t);
        f32x16 p0, p1;
        if (MODE == 0 && t < NT - 4) {
            const bool selq = (selmask >> (t >> 2)) & 1u; f32x16 cin;
#pragma unroll
            for (int r = 0; r < 16; ++r) cin[r] = selq ? negm[r] : -1e30f;
            qkt(p0, p1, Kbase + (t & 1) * SLOTB, qr, cin, r32, hi);
        } else qkt(p0, p1, Kbase + (t & 1) * SLOTB, qr, negm, r32, hi);
        if (MODE == 0) asm volatile("s_nop 15\n\ts_nop 7" : "+v"(p0), "+v"(p1));
        float rm;
        if (MODE == 0) { const int jb = t - (NT - 4);
            if (jb >= 0) { const int kb = 64 * jb + 4 * hi;
#pragma unroll
                for (int r = 0; r < 16; ++r) { const int kv = kb + (r & 3) + 8 * (r >> 2); if (kv > qrel) p0[r] = -INFINITY; if (kv + 32 > qrel) p1[r] = -INFINITY; } }
            rm = rowmax_a(p0, p1); }
        else { const int w0 = (int)(mw.x >> (4 * hi)), w1 = (int)(mw.y >> (4 * hi));
#pragma unroll
            for (int r = 0; r < 16; ++r) { const int bit = (r & 3) + 8 * (r >> 2);
                const unsigned m0 = (unsigned)((w0 << (31 - bit)) >> 31), m1 = (unsigned)((w1 << (31 - bit)) >> 31);
                p0[r] = __uint_as_float((__float_as_uint(p0[r]) & m0) | (0xff800000u & ~m0)); p1[r] = __uint_as_float((__float_as_uint(p1[r]) & m1) | (0xff800000u & ~m1)); }
            rm = rowmax_a(p0, p1); }
        if (__any(rm > THR)) {
            const float dl = __builtin_fmaxf(rm, 0.f); mhat += dl;
#pragma unroll
            for (int r = 0; r < 16; ++r) negm[r] = -mhat;
#pragma unroll
            for (int r = 0; r < 16; ++r) { p0[r] -= dl; p1[r] -= dl; }
            const float f = __builtin_amdgcn_exp2f(-dl); l_reg *= f; if (hi == 0) wsf[r32] = f;
            asm volatile("s_waitcnt lgkmcnt(0)" ::: "memory");
#pragma unroll
            for (int d_ = 0; d_ < 2; ++d_)
#pragma unroll
                for (int r = 0; r < 16; ++r) o[d_][r] *= wsf[crow(r, hi)];
        }
        float sacc = 0.f;
#pragma unroll
        for (int r = 0; r < 16; ++r) { p0[r] = __builtin_amdgcn_exp2f(p0[r]); p1[r] = __builtin_amdgcn_exp2f(p1[r]); sacc += p0[r] + p1[r]; }
        l_reg += sacc;
        u32x4 pw0, pw1, pw2, pw3;
        pw0 = (u32x4){cvtpk_s(p0[0], p0[1]), cvtpk_s(p0[2], p0[3]), cvtpk_s(p0[4], p0[5]), cvtpk_s(p0[6], p0[7])};
        pw1 = (u32x4){cvtpk_s(p0[8], p0[9]), cvtpk_s(p0[10], p0[11]), cvtpk_s(p0[12], p0[13]), cvtpk_s(p0[14], p0[15])};
        pw2 = (u32x4){cvtpk_s(p1[0], p1[1]), cvtpk_s(p1[2], p1[3]), cvtpk_s(p1[4], p1[5]), cvtpk_s(p1[6], p1[7])};
        pw3 = (u32x4){cvtpk_s(p1[8], p1[9]), cvtpk_s(p1[10], p1[11]), cvtpk_s(p1[12], p1[13]), cvtpk_s(p1[14], p1[15])};
        __builtin_amdgcn_sched_barrier(0);
        pv(o, vb0 + (t & 1) * SLOTB, __builtin_bit_cast(bf16x8, pw0), __builtin_bit_cast(bf16x8, pw1), __builtin_bit_cast(bf16x8, pw2), __builtin_bit_cast(bf16x8, pw3));
    }
    { auto rr = __builtin_amdgcn_permlane32_swap(__float_as_uint(l_reg), __float_as_uint(l_reg), false, false); l_reg = __uint_as_float(rr[0]) + __uint_as_float(rr[1]); }
    if (hi == 0) wsf[32 + r32] = l_reg; asm volatile("s_waitcnt lgkmcnt(0)" ::: "memory");
    float rli[16];
#pragma unroll
    for (int r = 0; r < 16; ++r) rli[r] = __builtin_amdgcn_rcpf(wsf[32 + crow(r, hi)]);
    unsigned char* Ow = (unsigned char*)O + (rowbase + q0 + wid * QBLK) * DM + h * D;
    { unsigned char* stg = (unsigned char*)(shm + LDS_OST) + wid * 2048;
#pragma unroll
        for (int r = 0; r < 16; ++r) { const int orow = crow(r, hi);
            const float sc16 = rli[r] * 16.0f; const int pk = __builtin_amdgcn_cvt_pk_fp8_f32(o[0][r] * sc16, o[1][r] * sc16, 0, false);
            stg[orow * 64 + r32] = (unsigned char)(pk & 0xff); stg[orow * 64 + 32 + r32] = (unsigned char)((pk >> 8) & 0xff); }
        asm volatile("s_waitcnt lgkmcnt(0)" ::: "memory");
#pragma unroll
        for (int i = 0; i < 2; ++i) { const int row = i * 16 + (lane >> 2), ch = lane & 3; const u32x4 v = *(const u32x4*)(stg + row * 64 + ch * 16); *(u32x4*)(Ow + (long)row * DM + ch * 16) = v; } }
    asm volatile("s_waitcnt vmcnt(0) lgkmcnt(0)\n\ts_barrier" ::: "memory");
#undef DMA_K
#undef DMA_V
}
}

namespace att2 {
using bf16=unsigned short;
using u32x2=__attribute__((ext_vector_type(2)))unsigned;
using bf16x8=__attribute__((ext_vector_type(8)))short;
using s16x4=__attribute__((ext_vector_type(4)))short;
using f32x16=__attribute__((ext_vector_type(16)))float;
using u32x4=__attribute__((ext_vector_type(4)))unsigned;
constexpr int BATCH=8,NHEAD=8,SEQ=4096,D=64,DM=NHEAD*D;
constexpr int NW=8,QBLK=32,QB=QBLK*NW,KVBLK=64,NQB=SEQ/QB;
constexpr int ATTN_PITCH=DM, ATTN_UNIT_ROWS=QB;
__device__ __forceinline__ int crow(int r,int hi){return (r&3)+8*(r>>2)+4*hi;}
#define SBAR() __builtin_amdgcn_sched_barrier(0)
__device__ __forceinline__ void cmask(f32x16&p0,f32x16&p1,int jb,int qrel,int hi){
  const float NEG=-INFINITY; int kb=64*jb+4*hi;
  #pragma unroll
  for(int r=0;r<16;++r){int kv=kb+(r&3)+8*(r>>2); if(kv>qrel)p0[r]=NEG; if(kv+32>qrel)p1[r]=NEG;}
}

constexpr int NSLOT=3, SLOTB=8192;
constexpr int LDS_K=0, LDS_V=NSLOT*SLOTB, LDS_WS=2*NSLOT*SLOTB, LDS_OST=LDS_WS+NW*64*4, LDS_KM=LDS_OST+NW*2048, LDS_BYTES=LDS_KM+16*64*4;
__device__ __forceinline__ void glds16(const void*gsrc,unsigned lds_dst){unsigned keep;
  asm volatile("s_mov_b32 %0, m0\n\ts_mov_b32 m0, %2\n\ts_nop 0\n\tglobal_load_lds_dwordx4 %1, off\n\ts_mov_b32 m0, %0":"=&s"(keep):"v"(gsrc),"s"(lds_dst):"memory");}
__device__ __forceinline__ float max3f(float a,float b,float c){float r;asm("v_max3_f32 %0, %1, %2, %3":"=v"(r):"v"(a),"v"(b),"v"(c));return r;}
__device__ __forceinline__ float max2f(float a,float b){float r;asm("v_max_f32_e32 %0, %1, %2":"=v"(r):"v"(a),"v"(b));return r;}
__device__ __forceinline__ float fadd_s(float a,float b){float r;asm("v_add_f32_e32 %0, %1, %2":"=v"(r):"v"(a),"v"(b));return r;}
__device__ __forceinline__ float fsub_s(float a,float b){float r;asm("v_sub_f32_e32 %0, %1, %2":"=v"(r):"v"(a),"v"(b));return r;}
typedef float f32x2_t __attribute__((ext_vector_type(2))); typedef __bf16 bf16x2_t __attribute__((ext_vector_type(2)));
__device__ __forceinline__ unsigned cvtpk_s(float lo,float hi){f32x2_t v={lo,hi};bf16x2_t b=__builtin_convertvector(v,bf16x2_t);return __builtin_bit_cast(unsigned,b);}
#define WAIT_BAR(N) asm volatile("s_waitcnt vmcnt(" #N ") lgkmcnt(0)\n\ts_barrier":::"memory")

__device__ __forceinline__ void qkt(f32x16&p0,f32x16&p1,const char*Kslot,const bf16x8*qr,const f32x16&negm,int r32,int hi){
  const char*kb=Kslot+hi*1024+r32*16;
  #pragma unroll
  for(int d0=0;d0<4;++d0){
    const bf16x8 b0=*reinterpret_cast<const bf16x8*>(kb+d0*2048);
    const bf16x8 b1=*reinterpret_cast<const bf16x8*>(kb+d0*2048+512);
    if(d0==0){p0=__builtin_amdgcn_mfma_f32_32x32x16_bf16(b0,qr[0],negm,0,0,0);p1=__builtin_amdgcn_mfma_f32_32x32x16_bf16(b1,qr[0],negm,0,0,0);}
    else{p0=__builtin_amdgcn_mfma_f32_32x32x16_bf16(b0,qr[d0],p0,0,0,0);p1=__builtin_amdgcn_mfma_f32_32x32x16_bf16(b1,qr[d0],p1,0,0,0);}}
}
typedef __attribute__((address_space(3))) const char* lds_cptr;
typedef short v4i16_t __attribute__((ext_vector_type(4)));
__device__ __forceinline__ void kload8(bf16x8*kf,lds_cptr kp){
  kf[0]=*(const __attribute__((address_space(3))) bf16x8*)(kp);      kf[1]=*(const __attribute__((address_space(3))) bf16x8*)(kp+512);
  kf[2]=*(const __attribute__((address_space(3))) bf16x8*)(kp+2048); kf[3]=*(const __attribute__((address_space(3))) bf16x8*)(kp+2560);
  kf[4]=*(const __attribute__((address_space(3))) bf16x8*)(kp+4096); kf[5]=*(const __attribute__((address_space(3))) bf16x8*)(kp+4608);
  kf[6]=*(const __attribute__((address_space(3))) bf16x8*)(kp+6144); kf[7]=*(const __attribute__((address_space(3))) bf16x8*)(kp+6656);
}
__device__ __forceinline__ void kload2(bf16x8*kf,lds_cptr kp,int j){ kf[2*j]=*(const __attribute__((address_space(3))) bf16x8*)(kp+j*2048); kf[2*j+1]=*(const __attribute__((address_space(3))) bf16x8*)(kp+j*2048+512); }
__device__ __forceinline__ s16x4 vtr(lds_cptr p){ return __builtin_bit_cast(s16x4,__builtin_amdgcn_ds_read_tr16_b64_v4i16((__attribute__((address_space(3))) v4i16_t*)p)); }
__device__ __forceinline__ float rowmax(const f32x16&p0,const f32x16&p1){
  float a=max3f(p0[0],p0[1],p1[0]),b=max3f(p0[2],p0[3],p1[1]);a=max3f(a,p1[2],p1[3]);
  #pragma unroll
  for(int r=4;r<16;r+=4){a=max3f(a,p0[r],p0[r+1]);b=max3f(b,p0[r+2],p0[r+3]);a=max3f(a,p1[r],p1[r+1]);b=max3f(b,p1[r+2],p1[r+3]);}
  const float m=max2f(a,b);
  auto rr=__builtin_amdgcn_permlane32_swap(__float_as_uint(m),__float_as_uint(m),false,false);
  return max2f(__uint_as_float(rr[0]),__uint_as_float(rr[1]));
}
__device__ __forceinline__ void pv(f32x16*o,int vb,bf16x8 pa0,bf16x8 pa1,bf16x8 pa2,bf16x8 pa3){
  #pragma unroll
  for(int d0=0;d0<2;++d0){s16x4 lo[4],hi[4];
    #pragma unroll
    for(int ks=0;ks<4;++ks){
      asm volatile("ds_read_b64_tr_b16 %0,%1 offset:%c2":"=&v"(lo[ks]):"v"(vb),"i"(d0*4096+ks*1024):"memory");
      asm volatile("ds_read_b64_tr_b16 %0,%1 offset:%c2":"=&v"(hi[ks]):"v"(vb),"i"(d0*4096+ks*1024+512):"memory");}
    asm volatile("s_waitcnt lgkmcnt(0)":::"memory");SBAR();
    #define PK(k) (bf16x8){lo[k][0],lo[k][1],lo[k][2],lo[k][3],hi[k][0],hi[k][1],hi[k][2],hi[k][3]}
    o[d0]=__builtin_amdgcn_mfma_f32_32x32x16_bf16(pa0,PK(0),o[d0],0,0,0);
    o[d0]=__builtin_amdgcn_mfma_f32_32x32x16_bf16(pa1,PK(1),o[d0],0,0,0);
    o[d0]=__builtin_amdgcn_mfma_f32_32x32x16_bf16(pa2,PK(2),o[d0],0,0,0);
    o[d0]=__builtin_amdgcn_mfma_f32_32x32x16_bf16(pa3,PK(3),o[d0],0,0,0);
    #undef PK
  }
}

template<int MODE,int THRL> __device__ __forceinline__ void attn_unit(int b,int h,int qb,const bf16*Q,const bf16*__restrict__ K,const bf16*__restrict__ V,unsigned char*O8,const void*aux,char*shm,const int tid_in){
  int tidl_=tid_in; asm volatile("":"+v"(tidl_));
  const int tid=tidl_,lane=tid&63,r32=lane&31,hi=lane>>5; const int wid=__builtin_amdgcn_readfirstlane(tid>>6);
  const long rowbase=(long)b*SEQ; const int q0=qb*QB;
  const bf16*Qw=Q+(rowbase+q0+wid*QBLK)*DM+h*D;
  const bf16*Kh=K+rowbase*DM+h*D,*Vh=V+rowbase*DM+h*D;
  const unsigned lds0=(unsigned)(uintptr_t)shm;
  float*wsf=(float*)(shm+LDS_WS)+wid*64;
  const bf16*ksrc=Kh+(long)lane*DM+wid*8;
  const bf16*vsrc=Vh+(long)(16*(wid&3)+(lane>>2))*DM+(wid>>2)*32+(lane&3)*8;
  const unsigned kdst=lds0+LDS_K+wid*1024, vdst=lds0+LDS_V+wid*1024;
  #define DMA_K(t,slot) glds16(ksrc+(long)(t)*KVBLK*DM,(unsigned)__builtin_amdgcn_readfirstlane(kdst+(slot)))
  #define DMA_V(t,slot) glds16(vsrc+(long)(t)*KVBLK*DM,(unsigned)__builtin_amdgcn_readfirstlane(vdst+(slot)))
  const int vb0=(int)(lds0+LDS_V)+((lane>>4)&1)*32+(lane&3)*8+(4*hi+((lane&15)>>2))*64;
  const char*Kbase=shm+LDS_K; bf16x8 kf[8];
  const lds_cptr shm3=(lds_cptr)shm; const lds_cptr kp0=shm3+LDS_K+hi*1024+r32*16; const lds_cptr vp0=shm3+LDS_V+((lane>>4)&1)*32+(lane&3)*8+(4*hi+((lane&15)>>2))*64;
  const int NT=(q0+QB)/KVBLK;
  unsigned selmask=0u;
  if(MODE==0){ float*km=(float*)(shm+LDS_KM); const float*kmg=(const float*)aux+(size_t)(b*NHEAD+h)*16*64;
    for(int i=tid;i<16*64;i+=NW*64)km[i]=kmg[i];
    bf16x8 qg[4];
    _Pragma("unroll") for(int d0=0;d0<4;++d0)qg[d0]=*reinterpret_cast<const bf16x8*>(&Qw[(long)r32*DM+d0*16+hi*8]);
    asm volatile("s_waitcnt vmcnt(0) lgkmcnt(0)":::"memory"); __syncthreads();
    float g[15];
    _Pragma("unroll") for(int j=0;j<15;++j){ g[j]=-INFINITY;
      if(j<qb){ float sg=0.f;
        _Pragma("unroll") for(int d0=0;d0<4;++d0) _Pragma("unroll") for(int e=0;e<8;++e) sg+=__uint_as_float(((unsigned)(unsigned short)qg[d0][e])<<16)*km[j*64+d0*16+hi*8+e];
        auto rr=__builtin_amdgcn_permlane32_swap(__float_as_uint(sg),__float_as_uint(sg),false,false); g[j]=__uint_as_float(rr[0])+__uint_as_float(rr[1]); } SBAR(); }
    _Pragma("unroll") for(int k=0;k<3;++k){ float best=-INFINITY; int bi=-1;
      _Pragma("unroll") for(int j=0;j<15;++j) if(j<qb && !((selmask>>j)&1u) && g[j]>best){best=g[j];bi=j;}
      if(bi>=0)selmask|=1u<<bi; }
    asm volatile("":"+v"(selmask)); SBAR(); }
  DMA_K(0,0);DMA_V(0,0);DMA_K(1,SLOTB);
  bf16x8 qr[4];
  #pragma unroll
  for(int d0=0;d0<4;++d0)qr[d0]=*reinterpret_cast<const bf16x8*>(&Qw[(long)r32*DM+d0*16+hi*8]);
  const unsigned*mrow=nullptr; u32x2 mwc=(u32x2){0u,0u}, mwn=(u32x2){0u,0u};
  if(MODE==1){ mrow=(const unsigned*)aux+(size_t)(rowbase+q0+wid*QBLK+r32)*128; mwc=*(const u32x2*)(mrow); mwn=*(const u32x2*)(mrow+2); }
  float z0_=0.f; asm volatile("":"+v"(z0_));
  float mhat=0.f,l_reg=0.f;f32x16 o[2];f32x16 negm;
  _Pragma("unroll") for(int r=0;r<16;++r){o[0][r]=z0_;o[1][r]=z0_;negm[r]=z0_;} asm volatile("":"+v"(negm));
  const int qrel=wid*QBLK+r32;
  #define DSAMASK(P0,P1,W) do{ const int w0_=(int)((W).x>>(4*hi)), w1_=(int)((W).y>>(4*hi)); \
    _Pragma("unroll") for(int r=0;r<16;++r){ const int bit_=(r&3)+8*(r>>2); const unsigned m0_=(unsigned)((w0_<<(31-bit_))>>31), m1_=(unsigned)((w1_<<(31-bit_))>>31); \
      P0[r]=__uint_as_float((__float_as_uint(P0[r])&m0_)|(0xff800000u&~m0_)); P1[r]=__uint_as_float((__float_as_uint(P1[r])&m1_)|(0xff800000u&~m1_)); } }while(0)
  #define CMASK(P0,P1,t) do{ if(MODE==0){ int jb_=(t)-(NT-4); if(jb_>=0)cmask(P0,P1,jb_,qrel,hi); \
      else if(!((selmask>>((t)>>2))&1u)){ _Pragma("unroll") for(int r=0;r<16;++r){P0[r]=-INFINITY;P1[r]=-INFINITY;} } } \
    else { DSAMASK(P0,P1,mwc); } }while(0)
  bool resc=false;
  #define START(P0,P1) do{ const float rm=rowmax(P0,P1); resc=false; \
    { const float dl=__builtin_fmaxf(rm,0.f); mhat=fadd_s(mhat,dl); \
      _Pragma("unroll") for(int r=0;r<16;++r){P0[r]=fsub_s(P0[r],dl);P1[r]=fsub_s(P1[r],dl);} \
      _Pragma("unroll") for(int r=0;r<16;++r)negm[r]=-mhat; asm volatile("":"+v"(negm)); } \
    _Pragma("unroll") for(int r=0;r<16;++r)P0[r]=__builtin_amdgcn_exp2f(P0[r]); }while(0)
  #define RESC() do{ if(resc){ asm volatile("s_waitcnt lgkmcnt(0)":::"memory"); \
      _Pragma("unroll") for(int d_=0;d_<2;++d_) _Pragma("unroll") for(int r=0;r<16;++r)o[d_][r]*=wsf[crow(r,hi)]; } }while(0)
  f32x16 pA0,pA1,pB0,pB1;
  int sl_prev=0,sl_cur=0,sl_next=SLOTB;
  #define ROT() do{sl_prev=sl_cur;sl_cur=sl_next;sl_next=(sl_next==(NSLOT-1)*SLOTB)?0:sl_next+SLOTB;}while(0)
  DMA_K(2,2*SLOTB);
  WAIT_BAR(3);
  qkt(pA0,pA1,Kbase,qr,negm,r32,hi);asm volatile("s_nop 15\n\ts_nop 7":"+v"(pA0),"+v"(pA1));CMASK(pA0,pA1,0);
  START(pA0,pA1);
  _Pragma("unroll") for(int r=0;r<16;++r)pA1[r]=__builtin_amdgcn_exp2f(pA1[r]);
  WAIT_BAR(0);
  DMA_K(3,0);DMA_V(1,SLOTB);
  ROT();
  if(MODE==1){mwc=mwn;}
  kload8(kf,kp0+sl_cur);
  WAIT_BAR(2);
  s16x4 vlo[8],vhi[8]; u32x4 pw0,pw1,pw2,pw3;
  #define PKW(P,B) cvtpk_s(P[B],P[B+1])
  #define PAF(k) __builtin_bit_cast(bf16x8,pw##k)
  #define VFR(i) (bf16x8){vlo[i][0],vlo[i][1],vlo[i][2],vlo[i][3],vhi[i][0],vhi[i][1],vhi[i][2],vhi[i][3]}
  #define PIN(x) asm volatile("":"+v"(x))
  #define MX3(a,b,c) __builtin_fmaxf(__builtin_fmaxf((a),(b)),(c))
  #define GAPA(MF,A0,A1,A2,A3,W0,W1,PW) do{ MF; sacc+=A0; sacc+=A1; sacc+=A2; sacc+=A3; PIN(sacc); W0; W1; PIN(PW); SBAR(); }while(0)
  #define EX(v) __builtin_amdgcn_exp2f(v)
  #define GAPB(MF,X,B) do{ MF; X[B]=EX(X[B]); X[B+1]=EX(X[B+1]); X[B+2]=EX(X[B+2]); X[B+3]=EX(X[B+3]); PIN(X); SBAR(); }while(0)
  #define VRD(i) do{ vlo[i]=vtr(vp_+(((i)>>2)*4096+((i)&3)*1024)); vhi[i]=vtr(vp_+(((i)>>2)*4096+((i)&3)*1024+512)); }while(0)
  #define KRD(G,j) do{ if(G){ kload2(kf,kp0+sl_next,j); SBAR(); } }while(0)
  #define MLOAD(tn) do{ if(MODE==1){ const unsigned*mp_=mrow+2*(tn); asm volatile("global_load_dwordx2 %0, %1, off":"=v"(mwn):"v"(mp_):"memory"); } }while(0)
  #define MROT() do{ if(MODE==1){ asm volatile("":"+v"(mwn)); mwc=mwn; } }while(0)
  #define STEP(C0,C1,P0,P1,t,GK,GV,GL) do{ SBAR(); \
    if((t)+1<NT){MLOAD((t)+1);} \
    const lds_cptr vp_=vp0+sl_prev; \
    VRD(0); SBAR(); float sacc=(P0[0]+P0[1]); \
    GAPA(C0=__builtin_amdgcn_mfma_f32_32x32x16_bf16(kf[0],qr[0],negm,0,0,0), P0[2],P0[3],P0[4],P0[5],     pw0[0]=PKW(P0,0), pw0[1]=PKW(P0,2), pw0); \
    VRD(4); SBAR(); GAPA(C1=__builtin_amdgcn_mfma_f32_32x32x16_bf16(kf[1],qr[0],negm,0,0,0), P0[6],P0[7],P0[8],P0[9],     pw0[2]=PKW(P0,4), pw0[3]=PKW(P0,6), pw0); \
    VRD(1); SBAR(); GAPA(C0=__builtin_amdgcn_mfma_f32_32x32x16_bf16(kf[2],qr[1],C0,0,0,0),   P0[10],P0[11],P0[12],P0[13], pw1[0]=PKW(P0,8), pw1[1]=PKW(P0,10), pw1); \
    VRD(5); SBAR(); GAPA(C1=__builtin_amdgcn_mfma_f32_32x32x16_bf16(kf[3],qr[1],C1,0,0,0),   P0[14],P0[15],P1[0],P1[1],   pw1[2]=PKW(P0,12),pw1[3]=PKW(P0,14), pw1); \
    VRD(2); SBAR(); GAPA(C0=__builtin_amdgcn_mfma_f32_32x32x16_bf16(kf[4],qr[2],C0,0,0,0),   P1[2],P1[3],P1[4],P1[5],     pw2[0]=PKW(P1,0), pw2[1]=PKW(P1,2), pw2); \
    VRD(6); SBAR(); GAPA(C1=__builtin_amdgcn_mfma_f32_32x32x16_bf16(kf[5],qr[2],C1,0,0,0),   P1[6],P1[7],P1[8],P1[9],     pw2[2]=PKW(P1,4), pw2[3]=PKW(P1,6), pw2); \
    VRD(3); SBAR(); GAPA(C0=__builtin_amdgcn_mfma_f32_32x32x16_bf16(kf[6],qr[3],C0,0,0,0),   P1[10],P1[11],P1[12],P1[13], pw3[0]=PKW(P1,8), pw3[1]=PKW(P1,10), pw3); \
    VRD(7); SBAR(); GAPA(C1=__builtin_amdgcn_mfma_f32_32x32x16_bf16(kf[7],qr[3],C1,0,0,0),   P1[14],P1[15],0.f,0.f,       pw3[2]=PKW(P1,12),pw3[3]=PKW(P1,14), pw3); \
    l_reg+=sacc; \
    if(GK){DMA_K((t)+3,sl_cur);} if(GV){DMA_V((t)+1,sl_next);} \
    CMASK(C0,C1,t); \
    { float a=MX3(C0[0],C0[1],C1[0]),b=MX3(C0[2],C0[3],C1[1]); a=MX3(a,C1[2],C1[3]); \
      _Pragma("unroll") for(int r=4;r<16;r+=4){a=MX3(a,C0[r],C0[r+1]);b=MX3(b,C0[r+2],C0[r+3]);a=MX3(a,C1[r],C1[r+1]);b=MX3(b,C1[r+2],C1[r+3]);} \
      float rm=__builtin_fmaxf(a,b); { auto rr=__builtin_amdgcn_permlane32_swap(__float_as_uint(rm),__float_as_uint(rm),false,false); rm=__builtin_fmaxf(__uint_as_float(rr[0]),__uint_as_float(rr[1])); } \
      resc=false; \
      if(__builtin_expect(__any(rm>(float)THRL),0)){ const float dl=__builtin_fmaxf(rm,0.f); mhat+=dl; \
        _Pragma("unroll") for(int r=0;r<16;++r){C0[r]-=dl;C1[r]-=dl;} \
        _Pragma("unroll") for(int r=0;r<16;++r)negm[r]=-mhat; asm volatile("":"+v"(negm)); \
        const float f=__builtin_amdgcn_exp2f(-dl); l_reg*=f; if(hi==0)wsf[r32]=f; resc=true; } } \
    SBAR(); \
    GAPB(o[0]=__builtin_amdgcn_mfma_f32_32x32x16_bf16(PAF(0),VFR(0),o[0],0,0,0), C0,0); \
    GAPB(o[1]=__builtin_amdgcn_mfma_f32_32x32x16_bf16(PAF(0),VFR(4),o[1],0,0,0), C0,4); \
    KRD(GL,0); GAPB(o[0]=__builtin_amdgcn_mfma_f32_32x32x16_bf16(PAF(1),VFR(1),o[0],0,0,0), C0,8); \
    KRD(GL,1); GAPB(o[1]=__builtin_amdgcn_mfma_f32_32x32x16_bf16(PAF(1),VFR(5),o[1],0,0,0), C0,12); \
    KRD(GL,2); GAPB(o[0]=__builtin_amdgcn_mfma_f32_32x32x16_bf16(PAF(2),VFR(2),o[0],0,0,0), C1,0); \
    KRD(GL,3); GAPB(o[1]=__builtin_amdgcn_mfma_f32_32x32x16_bf16(PAF(2),VFR(6),o[1],0,0,0), C1,4); \
    GAPB(o[0]=__builtin_amdgcn_mfma_f32_32x32x16_bf16(PAF(3),VFR(3),o[0],0,0,0), C1,8); \
    GAPB(o[1]=__builtin_amdgcn_mfma_f32_32x32x16_bf16(PAF(3),VFR(7),o[1],0,0,0), C1,12); \
    }while(0)
  int t=1;
  for(;t+5<NT;t+=2){
    STEP(pB0,pB1,pA0,pA1,t,true,true,true);     WAIT_BAR(2); MROT(); RESC(); ROT();
    STEP(pA0,pA1,pB0,pB1,t+1,true,true,true);   WAIT_BAR(2); MROT(); RESC(); ROT();
  }
  #define ENDW(tt) do{ if((tt)+3<NT){WAIT_BAR(2);} else if((tt)+2<NT){WAIT_BAR(1);} else {WAIT_BAR(0);} }while(0)
  for(;t+1<NT;t+=2){
    STEP(pB0,pB1,pA0,pA1,t,(t+3<NT),(t+1<NT),(t+1<NT));       ENDW(t);   MROT(); RESC(); ROT();
    STEP(pA0,pA1,pB0,pB1,t+1,(t+4<NT),(t+2<NT),(t+2<NT));     ENDW(t+1); MROT(); RESC(); ROT();
  }
  STEP(pB0,pB1,pA0,pA1,NT-1,false,false,false); RESC();
  { float sacc=pB0[0]+pB0[1]; _Pragma("unroll") for(int r=2;r<16;++r)sacc+=pB0[r]; _Pragma("unroll") for(int r=0;r<16;++r)sacc+=pB1[r]; l_reg+=sacc;
    pw0=(u32x4){PKW(pB0,0),PKW(pB0,2),PKW(pB0,4),PKW(pB0,6)};pw1=(u32x4){PKW(pB0,8),PKW(pB0,10),PKW(pB0,12),PKW(pB0,14)};pw2=(u32x4){PKW(pB1,0),PKW(pB1,2),PKW(pB1,4),PKW(pB1,6)};pw3=(u32x4){PKW(pB1,8),PKW(pB1,10),PKW(pB1,12),PKW(pB1,14)};
    SBAR(); pv(o,vb0+sl_cur,PAF(0),PAF(1),PAF(2),PAF(3)); }
  #undef PKW
  #undef PAF
  #undef VFR
  #undef PIN
  #undef MX3
  #undef GAPA
  #undef GAPB
  #undef EX
  #undef VRD
  #undef KRD
  #undef STEP
  #undef ENDW
  {auto rr=__builtin_amdgcn_permlane32_swap(__float_as_uint(l_reg),__float_as_uint(l_reg),false,false);l_reg=__uint_as_float(rr[0])+__uint_as_float(rr[1]);}
  if(hi==0)wsf[32+r32]=l_reg;asm volatile("s_waitcnt lgkmcnt(0)":::"memory");
  float rli[16];
  #pragma unroll
  for(int r=0;r<16;++r)rli[r]=__builtin_amdgcn_rcpf(wsf[32+crow(r,hi)]);
  unsigned char*Ow=O8+(rowbase+q0+wid*QBLK)*(2*DM)+h*D;
  { unsigned char*stg=(unsigned char*)(shm+LDS_OST)+wid*2048;
    #pragma unroll
    for(int r=0;r<16;++r){const int orow=crow(r,hi); const float sc16=rli[r]*16.0f; const int pk=__builtin_amdgcn_cvt_pk_fp8_f32(o[0][r]*sc16,o[1][r]*sc16,0,false);
      stg[orow*64+r32]=(unsigned char)(pk&0xff); stg[orow*64+32+r32]=(unsigned char)((pk>>8)&0xff);}
    asm volatile("s_waitcnt lgkmcnt(0)":::"memory");
    #pragma unroll
    for(int i=0;i<2;++i){const int row=i*16+(lane>>2),ch=lane&3; const u32x4 v=*(const u32x4*)(stg+row*64+ch*16); *(u32x4*)(Ow+(long)row*(2*DM)+ch*16)=v;} }
  asm volatile("s_waitcnt vmcnt(0) lgkmcnt(0)\n\ts_barrier":::"memory");
  #undef DMA_K
  #undef DMA_V
  #undef CMASK
  #undef START
  #undef RESC
  #undef ROT
  #undef MLOAD
  #undef MROT
  #undef DSAMASK
}
constexpr int ATTN_LDS_BYTES=LDS_BYTES;
#undef SBAR
#undef WAIT_BAR
}

namespace idx {
using bf16x8 = __attribute__((ext_vector_type(8))) short;
using f32x16 = __attribute__((ext_vector_type(16))) float;
using f32x4 = __attribute__((ext_vector_type(4))) float;
using u32x4 = __attribute__((ext_vector_type(4))) unsigned;
using u32x2 = __attribute__((ext_vector_type(2))) unsigned;
typedef unsigned short bf16r;
constexpr int SEQL = 4096, LCAP = 256, HSTRIDE = 1028;
constexpr int L_AF = 0, L_W = L_AF + 16384, L_M = L_W + 512, L_CT = L_M + 8192, L_LIST = L_CT + 512, L_HIST = L_LIST + 16 * LCAP * 8, LDS_BYTES = L_HIST + 16 * HSTRIDE * 4;
#define IDX_LAS __attribute__((address_space(3)))
__device__ __forceinline__ unsigned okey(float s) { const unsigned u = __float_as_uint(s); return u ^ ((unsigned)((int)u >> 31) | 0x80000000u); }
__device__ __forceinline__ float fkey(unsigned k) { return __uint_as_float(k ^ ((unsigned)((int)(~k) >> 31) | 0x80000000u)); }
__device__ __forceinline__ void glds16(const void* gsrc, unsigned lds_dst) { unsigned keep;
    asm volatile("s_mov_b32 %0, m0\n\ts_mov_b32 m0, %2\n\ts_nop 0\n\tglobal_load_lds_dwordx4 %1, off\n\ts_mov_b32 m0, %0" : "=&s"(keep) : "v"(gsrc), "s"(lds_dst) : "memory"); }
__device__ __forceinline__ float relu1(float x) { float r; asm("v_max_f32_e32 %0, 0, %1" : "=v"(r) : "v"(x)); return r; }
__device__ __forceinline__ void fmac1(float& acc, float a, float b) { asm("v_fmac_f32_e32 %0, %1, %2" : "+v"(acc) : "v"(a), "v"(b)); }
#define IDX_DPP(v, ctrl) __builtin_bit_cast(float, __builtin_amdgcn_update_dpp(0, __builtin_bit_cast(int, (v)), (ctrl), 0xF, 0xF, false))
__device__ __forceinline__ float half_max(float v) { v = __builtin_fmaxf(v, IDX_DPP(v, 0xB1)); v = __builtin_fmaxf(v, IDX_DPP(v, 0x4E)); v = __builtin_fmaxf(v, IDX_DPP(v, 0x141)); v = __builtin_fmaxf(v, IDX_DPP(v, 0x140));
    auto r = __builtin_amdgcn_permlane16_swap(__float_as_uint(v), __float_as_uint(v), false, false); return __builtin_fmaxf(__uint_as_float(r[0]), __uint_as_float(r[1])); }
__device__ __forceinline__ float half_min(float v) { v = __builtin_fminf(v, IDX_DPP(v, 0xB1)); v = __builtin_fminf(v, IDX_DPP(v, 0x4E)); v = __builtin_fminf(v, IDX_DPP(v, 0x141)); v = __builtin_fminf(v, IDX_DPP(v, 0x140));
    auto r = __builtin_amdgcn_permlane16_swap(__float_as_uint(v), __float_as_uint(v), false, false); return __builtin_fminf(__uint_as_float(r[0]), __uint_as_float(r[1])); }

__device__ __forceinline__ void scan_hist(IDX_LAS unsigned* hist, int q, unsigned need, int lane, unsigned& binL, unsigned& needL) {
    unsigned w[16];
#pragma unroll
    for (int i = 0; i < 4; ++i) { const u32x4 v = *(const IDX_LAS u32x4*)(hist + q * HSTRIDE + 16 * lane + 4 * i); w[4 * i] = v.x; w[4 * i + 1] = v.y; w[4 * i + 2] = v.z; w[4 * i + 3] = v.w; }
    unsigned tot = 0u;
#pragma unroll
    for (int i = 0; i < 16; ++i) tot += w[i];
    unsigned s = tot;
#pragma unroll
    for (int d = 1; d < 64; d <<= 1) { const unsigned t = __shfl_down(s, d); if (lane + d < 64) s += t; }
    const unsigned above = s - tot;
    const unsigned long long bal = __ballot(above < need && need <= above + tot);
    const int L = bal ? (int)__builtin_ctzll(bal) : 0;
    unsigned run = above, bsel = 0u, nsel = 1u; bool found = false;
#pragma unroll
    for (int i = 15; i >= 0; --i) { if (!found && run + w[i] >= need) { found = true; bsel = i; nsel = need - run; } run += w[i]; }
    binL = (unsigned)__shfl((int)bsel, L) + 16u * (unsigned)L; needL = (unsigned)__shfl((int)nsel, L);
}
__device__ __forceinline__ void zero_hist(IDX_LAS char* shm, int tid) { IDX_LAS u32x4* h4 = (IDX_LAS u32x4*)(shm + L_HIST);
#pragma unroll
    for (int i = 0; i < 9; ++i) if (tid + i * 512 < 16 * HSTRIDE / 4) h4[tid + i * 512] = (u32x4){0u, 0u, 0u, 0u}; }

__device__ __forceinline__ void unit(int b, int q0, const bf16r* IQ, const bf16r* IK, const float* IW, unsigned* MASK, char* shm_, const int tid_in, unsigned long long* dbg = nullptr) {
    int tid_ = tid_in; asm volatile("" : "+v"(tid_)); unsigned shm_u = (unsigned)(uintptr_t)shm_; asm volatile("" : "+s"(shm_u)); IDX_LAS char* const shm = (IDX_LAS char*)shm_u;
    const int tid = tid_, lane = tid & 63, j = lane & 31, hi = lane >> 5; const int wid = __builtin_amdgcn_readfirstlane(tid >> 6);
    const size_t rowbase = (size_t)b * SEQL;
    IDX_LAS unsigned* ct = (IDX_LAS unsigned*)(shm + L_CT);
    IDX_LAS unsigned* hist = (IDX_LAS unsigned*)(shm + L_HIST);
    const unsigned lds0 = shm_u;
    const int ntile = (q0 + 15) / 32 + 1;
    const int ni = (ntile > wid) ? (ntile - wid + 7) / 8 : 0;
    const bf16r* iksrc = IK + (rowbase + j) * 64 + 8 * hi;
    const unsigned ring = lds0 + L_HIST + (unsigned)wid * 8192u;
#define IDX_DMA(i_) do { const bf16r* s_ = iksrc + (size_t)(8 * (i_) + wid) * 32 * 64; const unsigned d_ = (unsigned)__builtin_amdgcn_readfirstlane(ring + (((i_) & 1) ? 4096u : 0u)); \
        glds16(s_, d_); glds16(s_ + 16, (unsigned)__builtin_amdgcn_readfirstlane(d_ + 1024u)); glds16(s_ + 32, (unsigned)__builtin_amdgcn_readfirstlane(d_ + 2048u)); glds16(s_ + 48, (unsigned)__builtin_amdgcn_readfirstlane(d_ + 3072u)); } while (0)
    if (ni > 0) IDX_DMA(0);
#pragma unroll
    for (int k = 0; k < 2; ++k) { const int f = wid + 8 * k, rb = f >> 2, s = f & 3; const int i = j;
        const int qi = ((i >> 4) & 1) + 2 * ((i >> 2) & 1), head = (i & 3) + 4 * ((i >> 3) & 1);
        const u32x4 v = *(const u32x4*)(IQ + (rowbase + q0 + 4 * rb + qi) * 512 + head * 64 + 16 * s + 8 * hi);
        *(IDX_LAS u32x4*)(shm + L_AF + f * 1024 + lane * 16) = v; }
    if (tid < 128) ((IDX_LAS float*)(shm + L_W))[tid] = IW[(rowbase + q0 + (tid >> 3)) * 8 + (tid & 7)];
    { IDX_LAS u32x4* m4 = (IDX_LAS u32x4*)(shm + L_M); m4[tid] = (u32x4){0u, 0u, 0u, 0u}; }
    if (tid < 128) ct[tid] = (tid >= 48 && tid < 64) ? 0xffffffffu : 0u;
    asm volatile("s_waitcnt vmcnt(0) lgkmcnt(0)" ::: "memory"); __syncthreads();
    unsigned long long t0_ = 0; if (dbg) t0_ = __builtin_amdgcn_s_memrealtime();
    f32x16 sc[8];
#pragma unroll
    for (int c = 0; c < 8; ++c)
#pragma unroll
        for (int i = 0; i < 16; ++i) sc[c][i] = -INFINITY;
    float fmx[8], fmn[8];
#pragma unroll
    for (int c = 0; c < 8; ++c) { fmx[c] = -INFINITY; fmn[c] = INFINITY; }
#pragma unroll 1
    for (int i = 0; i < ni; ++i) {
        const int kt = 8 * i + wid; const int key = 32 * kt + j;
        if (i + 1 < ni) { IDX_DMA(i + 1); asm volatile("s_waitcnt vmcnt(4)" ::: "memory"); } else asm volatile("s_waitcnt vmcnt(0)" ::: "memory");
        bf16x8 bfr4[4];
#pragma unroll
        for (int s = 0; s < 4; ++s) bfr4[s] = *(const IDX_LAS bf16x8*)(shm + L_HIST + wid * 8192 + (i & 1) * 4096 + s * 1024 + lane * 16);
#pragma unroll
        for (int rb = 0; rb < 4; ++rb) { f32x16 d = f32x16{};
#pragma unroll
            for (int s = 0; s < 4; ++s) { const bf16x8 a = *(const IDX_LAS bf16x8*)(shm + L_AF + (rb * 4 + s) * 1024 + lane * 16);
                d = __builtin_amdgcn_mfma_f32_32x32x16_bf16(a, bfr4[s], d, 0, 0, 0); }
            const IDX_LAS f32x4* wl = (const IDX_LAS f32x4*)(shm + L_W + (4 * rb + 2 * hi) * 32);
#define IDX_RELU(x) __int_as_float(max(__float_as_int(x), 0))
            typedef float f32x2_ __attribute__((ext_vector_type(2)));
            f32x2_ pa = {0.f, 0.f}, pb = {0.f, 0.f};
            { const f32x4 wa0 = wl[0], wb0 = wl[2];
              pa += (f32x2_){wa0[0], wa0[1]} * (f32x2_){IDX_RELU(d[0]), IDX_RELU(d[1])}; pa += (f32x2_){wa0[2], wa0[3]} * (f32x2_){IDX_RELU(d[2]), IDX_RELU(d[3])};
              pb += (f32x2_){wb0[0], wb0[1]} * (f32x2_){IDX_RELU(d[8]), IDX_RELU(d[9])}; pb += (f32x2_){wb0[2], wb0[3]} * (f32x2_){IDX_RELU(d[10]), IDX_RELU(d[11])}; }
            __builtin_amdgcn_sched_barrier(0);
            { const f32x4 wa1 = wl[1], wb1 = wl[3];
              pa += (f32x2_){wa1[0], wa1[1]} * (f32x2_){IDX_RELU(d[4]), IDX_RELU(d[5])}; pa += (f32x2_){wa1[2], wa1[3]} * (f32x2_){IDX_RELU(d[6]), IDX_RELU(d[7])};
              pb += (f32x2_){wb1[0], wb1[1]} * (f32x2_){IDX_RELU(d[12]), IDX_RELU(d[13])}; pb += (f32x2_){wb1[2], wb1[3]} * (f32x2_){IDX_RELU(d[14]), IDX_RELU(d[15])}; }
            float sa = pa[0] + pa[1], sb = pb[0] + pb[1];
            const int posa = q0 + 4 * rb + 2 * hi;
            const bool ina = key > posa, inb = key > posa + 1;
            asm volatile("v_min_f32 %0, %0, %2\n\tv_min_f32 %1, %1, %3" : "+v"(fmn[2 * rb]), "+v"(fmn[2 * rb + 1]) : "v"(sa), "v"(sb));
            if (ina) sa = -INFINITY; if (inb) sb = -INFINITY;
            asm volatile("v_max_f32 %0, %0, %2\n\tv_max_f32 %1, %1, %3" : "+v"(fmx[2 * rb]), "+v"(fmx[2 * rb + 1]) : "v"(sa), "v"(sb));
            sc[2 * rb][i] = sa; sc[2 * rb + 1][i] = sb; __builtin_amdgcn_sched_barrier(0); }
    }
#undef IDX_DMA
    if (dbg) { const unsigned long long t1_ = __builtin_amdgcn_s_memrealtime(); if (tid == 0) dbg[0] += t1_ - t0_; t0_ = t1_; }
#define TMARK(k) do { if (dbg) { const unsigned long long t1_ = __builtin_amdgcn_s_memrealtime(); if (tid == 0) dbg[k] += t1_ - t0_; t0_ = t1_; } } while (0)
    float tf[8]; int tix[8];
    if (q0 >= 256) {
        { unsigned umx[8], umn[8];
#pragma unroll
          for (int c = 0; c < 8; ++c) { umx[c] = (fmx[c] == -INFINITY) ? 0u : okey(fmx[c]); umn[c] = okey(fmn[c]);
#define IDX_DPPU(v, ctrl) ((unsigned)__builtin_amdgcn_update_dpp(0, (int)(v), (ctrl), 0xF, 0xF, false))
              umx[c] = max(umx[c], IDX_DPPU(umx[c], 0xB1)); umn[c] = min(umn[c], IDX_DPPU(umn[c], 0xB1)); umx[c] = max(umx[c], IDX_DPPU(umx[c], 0x4E)); umn[c] = min(umn[c], IDX_DPPU(umn[c], 0x4E));
              umx[c] = max(umx[c], IDX_DPPU(umx[c], 0x141)); umn[c] = min(umn[c], IDX_DPPU(umn[c], 0x141)); umx[c] = max(umx[c], IDX_DPPU(umx[c], 0x140)); umn[c] = min(umn[c], IDX_DPPU(umn[c], 0x140));
              { const auto r = __builtin_amdgcn_permlane16_swap(umx[c], umx[c], false, false); umx[c] = max((unsigned)r[0], (unsigned)r[1]); }
              { const auto r = __builtin_amdgcn_permlane16_swap(umn[c], umn[c], false, false); umn[c] = min((unsigned)r[0], (unsigned)r[1]); } }
          asm volatile("s_waitcnt lgkmcnt(0)" ::: "memory"); __syncthreads();
          if (j == 0) {
#pragma unroll
            for (int c = 0; c < 8; ++c) { const int q = 4 * (c >> 1) + 2 * hi + (c & 1);
                if (umx[c] != 0u) { (void)__hip_atomic_fetch_max(&ct[32 + q], umx[c], __ATOMIC_RELAXED, __HIP_MEMORY_SCOPE_WORKGROUP); (void)__hip_atomic_fetch_min(&ct[48 + q], umn[c], __ATOMIC_RELAXED, __HIP_MEMORY_SCOPE_WORKGROUP); } } } }
        TMARK(3);
        if (tid < 16) ct[16 + tid] = 256u;
        IDX_LAS u32x2* list = (IDX_LAS u32x2*)(shm + L_LIST);
        auto round_body = [&](const int round) __attribute__((always_inline)) {
            zero_hist(shm, tid);
            if (tid < 16) { ct[64 + tid] = 0u; ct[96 + tid] = ct[112 + tid]; }
            asm volatile("s_waitcnt lgkmcnt(0)" ::: "memory"); __syncthreads();
            float lo[8], scl[8];
#pragma unroll
            for (int c = 0; c < 8; ++c) { const int q = 4 * (c >> 1) + 2 * hi + (c & 1); const float h_ = fkey(ct[32 + q]); lo[c] = fkey(ct[48 + q]); const float d_ = h_ - lo[c]; scl[c] = (d_ > 0.f) ? 1023.0f / d_ : 0.f; }
#pragma unroll 1
            for (int i = 0; i < ni; ++i) {
#pragma unroll
                for (int c = 0; c < 8; ++c) { const float s = sc[c][i]; const int q = 4 * (c >> 1) + 2 * hi + (c & 1);
                    const unsigned bin = min((unsigned)((s - lo[c]) * scl[c]), 1024u);
                    (void)__hip_atomic_fetch_add(&hist[q * HSTRIDE + bin], 1u, __ATOMIC_RELAXED, __HIP_MEMORY_SCOPE_WORKGROUP); } __builtin_amdgcn_sched_barrier(0); }
            asm volatile("s_waitcnt lgkmcnt(0)" ::: "memory"); __syncthreads(); TMARK(4);
#pragma unroll 1
            for (int qq = 0; qq < 2; ++qq) { const int q = 2 * wid + qq; if (ct[96 + q] == 0u) { unsigned binL, needL; scan_hist(hist, q, ct[16 + q], lane, binL, needL); if (lane == 0) { ct[q] = binL; ct[16 + q] = needL; ct[32 + q] = 0u; ct[48 + q] = 0xffffffffu; } } }
            asm volatile("s_waitcnt lgkmcnt(0)" ::: "memory"); __syncthreads(); TMARK(5);
            unsigned b1[8];
#pragma unroll
            for (int c = 0; c < 8; ++c) { const int q = 4 * (c >> 1) + 2 * hi + (c & 1); b1[c] = (ct[96 + q] == 0u) ? ct[q] : 0xffffffffu; }
#pragma unroll 1
            for (int i = 0; i < ni; ++i) { const int kidx = 32 * (8 * i + wid) + j;
                bool pc[8]; bool anyc = false;
#pragma unroll
                for (int c = 0; c < 8; ++c) { const float s = sc[c][i]; const unsigned bin = min((unsigned)((s - lo[c]) * scl[c]), 1024u); pc[c] = (bin == b1[c]) && (s >= lo[c]); anyc = anyc || pc[c]; }
                if (__any(anyc)) {
#pragma unroll
                    for (int c = 0; c < 8; ++c) { const int q = 4 * (c >> 1) + 2 * hi + (c & 1);
                        if (pc[c]) { const unsigned k = okey(sc[c][i]); const unsigned pos = __hip_atomic_fetch_add(&ct[64 + q], 1u, __ATOMIC_RELAXED, __HIP_MEMORY_SCOPE_WORKGROUP);
                            (void)__hip_atomic_fetch_max(&ct[32 + q], k, __ATOMIC_RELAXED, __HIP_MEMORY_SCOPE_WORKGROUP); (void)__hip_atomic_fetch_min(&ct[48 + q], k, __ATOMIC_RELAXED, __HIP_MEMORY_SCOPE_WORKGROUP);
                            if (pos < (unsigned)LCAP) list[q * LCAP + pos] = (u32x2){k, (unsigned)kidx}; } } } }
            asm volatile("s_waitcnt lgkmcnt(0)" ::: "memory"); __syncthreads(); TMARK(6);
#pragma unroll 1
            for (int qq = 0; qq < 2; ++qq) { const int q = 2 * wid + qq; if (ct[96 + q] != 0u) continue;
                const int n = (int)ct[64 + q]; const unsigned need = ct[16 + q];
                if (n > LCAP) { if (ct[32 + q] == ct[48 + q] || round == 5) { if (lane == 0) { ct[q] = ct[48 + q]; ct[80 + q] = 0x7fffffffu; ct[112 + q] = 1u; } }
                    continue; }
                unsigned mk[4], mi[4], cg[4], ce[4];
#pragma unroll
                for (int m = 0; m < 4; ++m) { const int e = lane + 64 * m; const u32x2 v = (e < n) ? list[q * LCAP + e] : (u32x2){0u, 0u}; mk[m] = v.x; mi[m] = v.y; cg[m] = 0u; ce[m] = 0u; }
                for (int e = 0; e < n; ++e) { const u32x2 x = list[q * LCAP + e];
#pragma unroll
                    for (int m = 0; m < 4; ++m) { cg[m] += (x.x > mk[m]) ? 1u : 0u; ce[m] += (x.x == mk[m] && x.y < mi[m]) ? 1u : 0u; } }
                unsigned tmin = 0xffffffffu;
#pragma unroll
                for (int m = 0; m < 4; ++m) { const bool sel = (lane + 64 * m < n) && (cg[m] + ce[m] < need); if (sel) tmin = min(tmin, mk[m]); }
#pragma unroll
                for (int d = 1; d < 64; d <<= 1) tmin = min(tmin, (unsigned)__shfl_xor((int)tmin, d));
                unsigned imax = 0u; bool cut = false;
#pragma unroll
                for (int m = 0; m < 4; ++m) { const bool eq = (lane + 64 * m < n) && mk[m] == tmin; const bool sel = eq && (cg[m] + ce[m] < need); if (sel) imax = max(imax, mi[m]); cut = cut || (eq && !sel); }
#pragma unroll
                for (int d = 1; d < 64; d <<= 1) imax = max(imax, (unsigned)__shfl_xor((int)imax, d));
                if (!__any(cut)) imax = 0x7fffffffu;
                if (lane == 0) { ct[q] = tmin; ct[80 + q] = imax; ct[112 + q] = 1u; } }
            asm volatile("s_waitcnt lgkmcnt(0)" ::: "memory"); __syncthreads(); TMARK(7);
        };
        round_body(0);
        { bool alldone = true;
#pragma unroll
          for (int q = 0; q < 16; ++q) alldone = alldone && (ct[112 + q] != 0u);
          if (!alldone) round_body(5); }
#pragma unroll
        for (int c = 0; c < 8; ++c) { const int q = 4 * (c >> 1) + 2 * hi + (c & 1); tf[c] = fkey(ct[q]); tix[c] = (int)ct[80 + q]; }
    } else {
#pragma unroll
        for (int c = 0; c < 8; ++c) { tf[c] = -3.0e38f; tix[c] = 0x7fffffff; }
        asm volatile("s_waitcnt lgkmcnt(0)" ::: "memory"); __syncthreads();
    }
    if (dbg) { const unsigned long long t1_ = __builtin_amdgcn_s_memrealtime(); if (tid == 0) dbg[1] += t1_ - t0_; t0_ = t1_; }
    IDX_LAS unsigned* M = (IDX_LAS unsigned*)(shm + L_M);
    bool ties = false;
#pragma unroll
    for (int c = 0; c < 8; ++c) ties = ties || (tix[c] != 0x7fffffff);
    if (!__any(ties)) {
#pragma unroll 1
        for (int i = 0; i < ni; ++i) { const int kt = 8 * i + wid;
#pragma unroll
            for (int c = 0; c < 8; ++c) { const unsigned long long bal = __ballot(sc[c][i] >= tf[c]); const unsigned word = hi ? (unsigned)(bal >> 32) : (unsigned)bal;
                M[(4 * (c >> 1) + 2 * hi + (c & 1)) * 128 + kt] = word; } }
    } else {
#pragma unroll 1
        for (int i = 0; i < ni; ++i) { const int kt = 8 * i + wid; const int kidx = 32 * kt + j;
#pragma unroll
            for (int c = 0; c < 8; ++c) { const float s = sc[c][i]; const bool on = (s > tf[c]) || (s == tf[c] && kidx <= tix[c]);
                const unsigned long long bal = __ballot(on); const unsigned word = hi ? (unsigned)(bal >> 32) : (unsigned)bal;
                M[(4 * (c >> 1) + 2 * hi + (c & 1)) * 128 + kt] = word; } }
    }
    asm volatile("s_waitcnt lgkmcnt(0)" ::: "memory"); __syncthreads();
    { const u32x4 v = ((const IDX_LAS u32x4*)M)[tid]; *(u32x4*)(MASK + (rowbase + q0) * 128 + tid * 4) = v; }
    asm volatile("s_waitcnt vmcnt(0) lgkmcnt(0)" ::: "memory"); __syncthreads();
    if (dbg) { const unsigned long long t1_ = __builtin_amdgcn_s_memrealtime(); if (tid == 0) dbg[2] += t1_ - t0_; }
}
}

constexpr int NWAVES = 8;
constexpr int N_LAUNCHES = MK_N_LAUNCHES;
enum Phase { PH_PRO = 0, PH_ZG, PH_IDX, PH_ATT, PH_BR, PH_WO, PH_RT, PH_GU, PH_DN, PH_CMB, PH_PG, PH_FIN, PH_COUNT };
using pg8::BATCH; using pg8::SEQ; using pg8::DMODEL; using pg8::TOK; using pg8::AW; using pg8::ZN; using pg8::IN_COLS; using pg8::NEXP; using pg8::DEXP; using pg8::PLE; using pg8::RMS_EPS;

constexpr size_t MiB = 1u << 20;
constexpr size_t WS_CTL = 0, CTL_ZERO_BYTES = 2 * MiB;
constexpr size_t WS_KMEAN = 1 * MiB;
constexpr size_t WS_ROPEC = 2 * MiB, WS_ROPES = 2 * MiB + 128 * 1024;
constexpr size_t WS_RSTD = 2 * MiB + 256 * 1024;
constexpr size_t WS_LTOK = 3 * MiB, WS_LW = 7 * MiB;
constexpr size_t WS_WIN = 11 * MiB, WS_WIN8 = 17 * MiB;
constexpr size_t WS_H8 = 470 * MiB;
constexpr size_t WS_BRA = 23 * MiB, WS_BRB = 24 * MiB, WS_WOUT = 25 * MiB, WS_WPG = 27 * MiB, WS_WPP = 29 * MiB;
constexpr size_t WS_PB = 30 * MiB;
constexpr size_t WS_A = 46 * MiB;
constexpr size_t WS_B = 110 * MiB;
constexpr size_t WS_QA = WS_B, WS_KA = WS_B + 32 * MiB, WS_VA = WS_B + 64 * MiB, WS_QB = WS_B + 96 * MiB, WS_KB = WS_B + 128 * MiB, WS_VB = WS_B + 160 * MiB;
constexpr size_t WS_IQ = WS_B + 192 * MiB, WS_IK = WS_B + 224 * MiB, WS_IW = WS_B + 228 * MiB;
constexpr size_t WS_OAB8 = WS_IQ;
constexpr size_t WS_MRG = WS_KA;
constexpr size_t WS_HID = WS_B, WS_Y = WS_B + 72 * MiB;
constexpr size_t WS_P = 342 * MiB + 64 * MiB;
constexpr size_t WS_X1B = WS_B + 140 * MiB;
constexpr size_t WS_C = 342 * MiB;
constexpr size_t WS_GA = WS_C, WS_GB = WS_C + 64 * MiB;
constexpr size_t WS_WGU = WS_C, WS_WDN = WS_C + 32 * MiB;
constexpr size_t WS_MASK = 470 * MiB;
constexpr size_t WS_ST = 486 * MiB;
constexpr size_t WS_END = 502 * MiB;
constexpr int CW_BAR = 4096;
constexpr int CW_CNT = 16384;
constexpr int CW_HID = 40960;
constexpr int CW_IDXQ = 51200;
constexpr int CW_FIN = 32768;
constexpr int RING_OFF = 0, RING_BYTES = 131072;
constexpr int TBL_OFF = RING_BYTES, TBL_BYTES = 28672;
constexpr int LDSCTL_OFF = TBL_OFF + TBL_BYTES, MISC_OFF = LDSCTL_OFF + 320;
constexpr int LDS_BYTES = 163840;
static_assert(MISC_OFF + 128 <= LDS_BYTES, "LDS map");

#define GAS __attribute__((address_space(1)))
#define LAS __attribute__((address_space(3)))
typedef unsigned short bf16;
typedef unsigned v4u __attribute__((ext_vector_type(4)));
typedef float f32x4 __attribute__((ext_vector_type(4)));
typedef short bf16x8 __attribute__((ext_vector_type(8)));
typedef GAS unsigned gu32;
typedef GAS unsigned long long gu64;
#define RLX_AGENT __ATOMIC_RELAXED, __HIP_MEMORY_SCOPE_AGENT
#define LDS_WAIT() asm volatile("s_waitcnt lgkmcnt(0)" ::: "memory")
#define VM_WAIT() asm volatile("s_waitcnt vmcnt(0)" ::: "memory")
__device__ __forceinline__ unsigned long long rt() { return __builtin_amdgcn_s_memrealtime(); }
__device__ __forceinline__ unsigned f2bf(float f) { unsigned u = __builtin_bit_cast(unsigned, f); return (u + 0x7fffu + ((u >> 16) & 1u)) >> 16; }
__device__ __forceinline__ unsigned pk2(float lo, float hi) { return f2bf(lo) | (f2bf(hi) << 16); }

#define XB_TMO      128
#define XB_XCNT(j)  (256  + 64 * (j))
#define XB_XSUB(j)  (1280 + 64 * (j))
#define XB_XGEN(j)  (2304 + 64 * (j))
#define XB_TOP      3328
#define XB_TOPGEN   3392
#define XCD_BAR_WORDS 3456
#define XB_SPIN_CAP (1u << 18)

__device__ __forceinline__ unsigned xb_ld(unsigned* p)              { return __hip_atomic_load(p, __ATOMIC_RELAXED, __HIP_MEMORY_SCOPE_AGENT); }
__device__ __forceinline__ unsigned xb_add(unsigned* p, unsigned v) { return __hip_atomic_fetch_add(p, v, __ATOMIC_RELAXED, __HIP_MEMORY_SCOPE_AGENT); }
__device__ __forceinline__ unsigned xb_xcc_id() { return (unsigned)__builtin_amdgcn_s_getreg((3 << 11) | 20) & 0xFu; }
#define XB_SPIN(cond, bar) do { unsigned _sp = 0; while (cond) { __builtin_amdgcn_s_sleep(1); \
    if ((++_sp & 255u) == 0u) { if (xb_ld(&(bar)[XB_TMO])) break; if (_sp > XB_SPIN_CAP) { atomicAdd(&(bar)[XB_TMO], 1u); break; } } } } while (0)

struct XcdBarrier {
    unsigned* bar; unsigned x;
    volatile LAS unsigned* st;
};

__device__ __forceinline__ XcdBarrier xcd_barrier_post(unsigned* bar, volatile LAS unsigned* st, int xb_tid) {
    XcdBarrier b; b.bar = bar; b.x = xb_xcc_id(); b.st = st;
    if (xb_tid == 0) (void)xb_add(&bar[XB_XCNT(b.x)], 1u);
    return b;
}
__device__ __forceinline__ void xcd_barrier_complete(unsigned* bar, unsigned x, unsigned& nloc, unsigned& nx) {
    const unsigned G = gridDim.x * gridDim.y * gridDim.z;
    unsigned sum, cnt, mine, sp = 0u;
    for (;;) {
        sum = 0u; cnt = 0u; mine = 0u;
#pragma unroll
        for (unsigned j = 0; j < 16; ++j) { const unsigned c = xb_ld(&bar[XB_XCNT(j)]); sum += c; cnt += (c > 0u) ? 1u : 0u; mine = (j == x) ? c : mine; }
        if (sum == G) break;
        __builtin_amdgcn_s_sleep(1);
        if ((++sp & 255u) == 0u) { if (xb_ld(&bar[XB_TMO])) break; if (sp > XB_SPIN_CAP) { atomicAdd(&bar[XB_TMO], 1u); break; } }
    }
    nloc = mine > 0u ? mine : 1u; nx = cnt > 0u ? cnt : 1u;
}

__device__ __forceinline__ void xcd_barrier(const XcdBarrier& b, int xb_tid) {
    asm volatile("s_waitcnt vmcnt(0)" ::: "memory");
    __syncthreads();
    if (xb_tid == 0) {
        unsigned* bar = b.bar;
        __builtin_amdgcn_s_waitcnt(0);
        unsigned nloc = b.st[0], nx = b.st[1];
        if (nloc == 0u) { xcd_barrier_complete(bar, b.x, nloc, nx); b.st[0] = nloc; b.st[1] = nx; }
        const unsigned old = xb_add(&bar[XB_XSUB(b.x)], 1u);
        const unsigned gen = old / nloc;
        if (old + 1u == (gen + 1u) * nloc) {
            __builtin_amdgcn_fence(__ATOMIC_RELEASE, "agent");
            asm volatile("s_waitcnt vmcnt(0)" ::: "memory");
            const unsigned og = xb_add(&bar[XB_TOP], 1u);
            const unsigned tg = og / nx;
            if (og + 1u == (tg + 1u) * nx) xb_add(&bar[XB_TOPGEN], 1u);
            else XB_SPIN(xb_ld(&bar[XB_TOPGEN]) == tg, bar);
            __builtin_amdgcn_fence(__ATOMIC_ACQUIRE, "agent");
            xb_add(&bar[XB_XGEN(b.x)], 1u);
            asm volatile("s_waitcnt vmcnt(0)" ::: "memory");
        } else {
            XB_SPIN(xb_ld(&bar[XB_XGEN(b.x)]) == gen, bar);
            __builtin_amdgcn_fence(__ATOMIC_ACQUIRE, "agent");
            asm volatile("s_waitcnt vmcnt(0)" ::: "memory");
        }
    }
    __syncthreads();
}

struct Frame {
    LAS unsigned char* lds;
    volatile LAS unsigned* MISC;
    gu32* ctl;
    int tid, lane, wave;
    int vcu, G;
};
__device__ __forceinline__ float dpp_f(float v, const int ctrl) { return v; }
#define DPP_ADD(v, ctrl) ((v) + __builtin_bit_cast(float, __builtin_amdgcn_update_dpp(0, __builtin_bit_cast(int, (v)), (ctrl), 0xF, 0xF, false)))
__device__ __forceinline__ float wave_sum(float v) {
    v = DPP_ADD(v, 0xB1);
    v = DPP_ADD(v, 0x4E);
    v = DPP_ADD(v, 0x141);
    v = DPP_ADD(v, 0x140);
    { auto r = __builtin_amdgcn_permlane16_swap(__float_as_uint(v), __float_as_uint(v), false, false); v = __uint_as_float(r[0]) + __uint_as_float(r[1]); }
    { auto r = __builtin_amdgcn_permlane32_swap(__float_as_uint(v), __float_as_uint(v), false, false); v = __uint_as_float(r[0]) + __uint_as_float(r[1]); }
    return v;
}
template <class RowMap> __device__ __forceinline__ void transpose_item(const float* W, int K, int N, bf16* WT, const RowMap& RM, LAS float* scr, int item, int lane) {
    const int nblk = (N + 31) / 32, kb = item / nblk, nb = item % nblk, k0 = 64 * kb, n0 = 32 * nb;
    const int nsrc = n0 + (lane & 31); const bool okc = nsrc < N;
#pragma unroll 16
    for (int i = 0; i < 32; ++i) { const int kk = 2 * i + (lane >> 5); scr[kk * 33 + (lane & 31)] = okc ? W[(size_t)(k0 + kk) * N + nsrc] : 0.f; }
    LDS_WAIT(); asm volatile("" ::: "memory");
    const int c = lane & 7;
#pragma unroll
    for (int j = 0; j < 4; ++j) { const int n = (lane >> 3) + 8 * j; const LAS float* s = scr + (8 * c) * 33 + n;
        v4u o; o.x = pk2(s[0 * 33], s[1 * 33]); o.y = pk2(s[2 * 33], s[3 * 33]); o.z = pk2(s[4 * 33], s[5 * 33]); o.w = pk2(s[6 * 33], s[7 * 33]);
        const int drow = (n0 + n < N) ? RM(n0 + n) : -1;
        if (drow >= 0) *(GAS v4u*)(WT + (size_t)drow * K + k0 + 8 * c) = o; }
    LDS_WAIT(); asm volatile("" ::: "memory");
}
template <class RowMap> __device__ __forceinline__ void transpose_item8(const float* W, int K, int N, unsigned char* WT, const RowMap& RM, float sc, LAS float* scr, int item, int lane) {
    const int nblk = (N + 31) / 32, kb = item / nblk, nb = item % nblk, k0 = 64 * kb, n0 = 32 * nb;
    const int nsrc = n0 + (lane & 31); const bool okc = nsrc < N;
#pragma unroll 16
    for (int i = 0; i < 32; ++i) { const int kk = 2 * i + (lane >> 5); scr[kk * 33 + (lane & 31)] = okc ? W[(size_t)(k0 + kk) * N + nsrc] * sc : 0.f; }
    LDS_WAIT(); asm volatile("" ::: "memory");
    const int c = lane & 7;
#pragma unroll
    for (int j = 0; j < 4; ++j) { const int n = (lane >> 3) + 8 * j; const LAS float* s = scr + (8 * c) * 33 + n;
        const pg8::u32x2 o = pg8::pack8_fp8((f32x4){s[0 * 33], s[1 * 33], s[2 * 33], s[3 * 33]}, (f32x4){s[4 * 33], s[5 * 33], s[6 * 33], s[7 * 33]});
        const int drow = (n0 + n < N) ? RM(n0 + n) : -1;
        if (drow >= 0) *(GAS pg8::u32x2*)(WT + (size_t)drow * K + k0 + 8 * c) = o; }
    LDS_WAIT(); asm volatile("" ::: "memory");
}
template <class RowMap> __device__ __forceinline__ void transpose_item_split(const float* W, int K, int N, bf16* WT, unsigned char* WT8, const RowMap& RM, LAS float* scr, int item, int lane) {
    const int nblk = (N + 31) / 32, kb = item / nblk, nb = item % nblk, k0 = 64 * kb, n0 = 32 * nb;
    const int nsrc = n0 + (lane & 31); const bool okc = nsrc < N;
#pragma unroll 16
    for (int i = 0; i < 32; ++i) { const int kk = 2 * i + (lane >> 5); scr[kk * 33 + (lane & 31)] = okc ? W[(size_t)(k0 + kk) * N + nsrc] : 0.f; }
    LDS_WAIT(); asm volatile("" ::: "memory");
    const int c = lane & 7;
#pragma unroll
    for (int j = 0; j < 4; ++j) { const int n = (lane >> 3) + 8 * j; const LAS float* s = scr + (8 * c) * 33 + n;
        const int drow = (n0 + n < N) ? RM(n0 + n) : -1;
        if (drow >= 0) { v4u o; o.x = pk2(s[0 * 33], s[1 * 33]); o.y = pk2(s[2 * 33], s[3 * 33]); o.z = pk2(s[4 * 33], s[5 * 33]); o.w = pk2(s[6 * 33], s[7 * 33]); *(GAS v4u*)(WT + (size_t)drow * K + k0 + 8 * c) = o; }
        else if (drow <= -2) { const pg8::u32x2 o = pg8::pack8_fp8((f32x4){s[0 * 33] * 32.f, s[1 * 33] * 32.f, s[2 * 33] * 32.f, s[3 * 33] * 32.f}, (f32x4){s[4 * 33] * 32.f, s[5 * 33] * 32.f, s[6 * 33] * 32.f, s[7 * 33] * 32.f});
            *(GAS pg8::u32x2*)(WT8 + (size_t)(-2 - drow) * K + k0 + 8 * c) = o; } }
    LDS_WAIT(); asm volatile("" ::: "memory");
}
struct RmIdent { __device__ __forceinline__ int operator()(int n) const { return n; } };
struct RmWin { __device__ __forceinline__ int operator()(int n) const {
    if (n < 1024) return -2 - (n + 4096);
    if (n < 1536) return -2 - (n - 1024);
    if (n < 2560) return -2 - (n - 1536 + 3072);
    if (n < 3072) return -2 - (n - 2560 + 512);
    if (n < 3656) return n - 3072;
    { const int c = n - 3656, g = c >> 10, cc = c & 1023; return -2 - (1024 + 256 * (cc >> 7) + 128 * g + (cc & 127)); } } };
struct RmGate { int up; __device__ __forceinline__ int operator()(int n) const { return 256 * (n >> 7) + 128 * up + (n & 127); } };

__device__ __forceinline__ void conv_load(const float* W, int N, int nblk, int item, int lane, float (&t)[32]) {
    const int kb = item / nblk, nb = item - kb * nblk;
    int n = 32 * nb + (lane & 31); n = n < N ? n : N - 1;
    const GAS float* src = (const GAS float*)W + (size_t)(64 * kb + 32 * (lane >> 5)) * N + n;
#pragma unroll
    for (int i = 0; i < 32; ++i) t[i] = src[(size_t)i * N];
}
struct MoeItem { const float* W; int K, N, nblk, r, mode; unsigned char* d; };
__device__ __forceinline__ MoeItem moe_item(int it, const float* wg, const float* wu, const float* wd, unsigned char* Wgu, unsigned char* Wdn) {
    const int e = it / 768; int r = it - e * 768; MoeItem m;
    m.W = wg + (size_t)e * DMODEL * DEXP; m.K = DMODEL; m.N = DEXP; m.nblk = 16; m.mode = 0; m.d = Wgu + (size_t)e * DMODEL * DMODEL;
    if (r >= 256) { r -= 256; m.W = wu + (size_t)e * DMODEL * DEXP; m.mode = 1;
        if (r >= 256) { r -= 256; m.W = wd + (size_t)e * DEXP * DMODEL; m.K = DEXP; m.N = DMODEL; m.nblk = 32; m.mode = 2; m.d = Wdn + (size_t)e * DMODEL * DEXP; } }
    m.r = r; return m; }
struct RmMoe { int mode; __device__ __forceinline__ int operator()(int n) const { return mode == 2 ? n : 256 * (n >> 7) + 128 * mode + (n & 127); } };
template <int MODE, class RowMap> __device__ __forceinline__ void conv_store(int K, int N, int nblk, int item, int lane, unsigned char* d16, unsigned char* d8, const RowMap& RM, float sc, const float (&t)[32], int ldk = 0) {
    const int kb = item / nblk, nb = item - kb * nblk;
    const int n = 32 * nb + (lane & 31); const int kq = 64 * kb + 32 * (lane >> 5);
    if (n < N) { const int drow = RM(n);
        if (MODE == 1 || (MODE == 2 && drow < 0)) { const int row = (MODE == 1) ? drow : -2 - drow; const float q = (MODE == 1) ? sc : 32.f;
            unsigned w[8];
#pragma unroll
            for (int j = 0; j < 8; ++j) { int w_ = __builtin_amdgcn_cvt_pk_fp8_f32(t[4 * j] * q, t[4 * j + 1] * q, 0, false); w_ = __builtin_amdgcn_cvt_pk_fp8_f32(t[4 * j + 2] * q, t[4 * j + 3] * q, w_, true); w[j] = (unsigned)w_; }
            GAS v4u* o = (GAS v4u*)(d8 + (size_t)row * (ldk ? ldk : K) + kq); o[0] = (v4u){w[0], w[1], w[2], w[3]}; o[1] = (v4u){w[4], w[5], w[6], w[7]}; }
        else { unsigned w[16];
#pragma unroll
            for (int j = 0; j < 16; ++j) w[j] = pg8::cvt_pk_bf16(t[2 * j], t[2 * j + 1]);
            GAS v4u* o = (GAS v4u*)(d16 + ((size_t)drow * K + kq) * 2);
#pragma unroll
            for (int j = 0; j < 4; ++j) o[j] = (v4u){w[4 * j], w[4 * j + 1], w[4 * j + 2], w[4 * j + 3]}; } }
}

__device__ __forceinline__ void rms_row_to_bf16(const float* xrow, const float* g, bf16* orow, unsigned char* orow8, int lane) {
    const GAS f32x4* xr = (const GAS f32x4*)xrow + lane; const GAS f32x4* gr = (const GAS f32x4*)g + lane;
    f32x4 v[4]; float s = 0.f;
#pragma unroll
    for (int j = 0; j < 4; ++j) { v[j] = xr[64 * j]; s += (v[j].x * v[j].x + v[j].y * v[j].y) + (v[j].z * v[j].z + v[j].w * v[j].w); }
    const float rinv = 1.0f / sqrtf(wave_sum(s) * (1.f / DMODEL) + RMS_EPS);
    GAS unsigned long long* o8 = (GAS unsigned long long*)orow + lane;
    GAS unsigned* o4 = (GAS unsigned*)orow8 + lane;
#pragma unroll
    for (int j = 0; j < 4; ++j) { const f32x4 gg = gr[64 * j]; const f32x4 h = (f32x4){v[j].x * rinv * gg.x, v[j].y * rinv * gg.y, v[j].z * rinv * gg.z, v[j].w * rinv * gg.w};
        o8[64 * j] = (unsigned long long)pk2(h.x, h.y) | ((unsigned long long)pk2(h.z, h.w) << 32);
        int w_ = __builtin_amdgcn_cvt_pk_fp8_f32(h.x, h.y, 0, false); w_ = __builtin_amdgcn_cvt_pk_fp8_f32(h.z, h.w, w_, true); o4[64 * j] = (unsigned)w_; }
}

struct MoeTbl {
    static constexpr int RB0 = 0;
    static constexpr int UNITS = 256;
    static constexpr int ROWOFF = 512;
    static constexpr int ROWW = 512 + 8192;
};
struct MoeOrder {
    const LAS int* units; const LAS unsigned* rowoff; int n; size_t estride; unsigned* publish; unsigned* ready;
    __device__ __forceinline__ bool next(int i, pg8::Unit& u) const { if (i >= n) return false; u.pm = units[4 * i]; u.pn = units[4 * i + 1]; u.e = units[4 * i + 2]; u.valid = units[4 * i + 3]; u.boff = (size_t)u.e * estride; return true; }
    __device__ __forceinline__ void a_ready(const pg8::Unit& u, int wid, int lane) const {
        if (ready == nullptr) return;
        if (wid == 0) { unsigned sp = 0;
            while ((unsigned)__builtin_amdgcn_readfirstlane((int)__hip_atomic_load(ready + 16 * u.pm, __ATOMIC_RELAXED, __HIP_MEMORY_SCOPE_AGENT)) < 32u) { __builtin_amdgcn_s_sleep(2); if (++sp > (1u << 22)) break; }
            __builtin_amdgcn_fence(__ATOMIC_ACQUIRE, "agent"); asm volatile("s_waitcnt vmcnt(0)" ::: "memory"); }
        asm volatile("" ::: "memory"); __builtin_amdgcn_s_barrier(); asm volatile("" ::: "memory"); (void)lane; }
    __device__ __forceinline__ void done(const pg8::Unit& u, int, int lane) const {
        if (publish == nullptr) return;
        asm volatile("s_waitcnt vmcnt(0)" ::: "memory");
        if (lane == 0) (void)__hip_atomic_fetch_add(publish + 16 * u.pm, 1u, __ATOMIC_RELAXED, __HIP_MEMORY_SCOPE_AGENT); }
    __device__ __forceinline__ unsigned arow(int ui, int r) const { return rowoff[ui * 256 + r]; }
};
__device__ __forceinline__ int moe_build(Frame& F, const int* cnt_g, const int* ltok, const float* lw, int mode) {
    LAS int* rb0 = (LAS int*)(F.lds + TBL_OFF + MoeTbl::RB0); LAS int* units = (LAS int*)(F.lds + TBL_OFF + MoeTbl::UNITS);
    LAS unsigned* rowoff = (LAS unsigned*)(F.lds + TBL_OFF + MoeTbl::ROWOFF); LAS float* roww = (LAS float*)(F.lds + TBL_OFF + MoeTbl::ROWW);
    LAS int* cn = (LAS int*)(F.lds + TBL_OFF + MoeTbl::ROWW + 8192);
    if (F.tid < 32) cn[F.tid] = __hip_atomic_load(cnt_g + F.tid, __ATOMIC_RELAXED, __HIP_MEMORY_SCOPE_AGENT);
    LDS_WAIT(); __syncthreads();
    if (F.tid == 0) { int s = 0; for (int e = 0; e < 32; ++e) { rb0[e] = s; s += (cn[e] + 255) >> 8; } rb0[32] = s; }
    LDS_WAIT(); __syncthreads();
    const int NB = rb0[32]; int n = 0;
    const int U_ = 4 * NB, full_ = U_ / F.G, r_ = U_ - full_ * F.G;
    for (int i = 0; i < 8; ++i) { int L = i * F.G + (int)blockIdx.x;
        if (mode == 1 && i == full_) { const int j_ = ((int)blockIdx.x - r_ + F.G) % F.G; L = (j_ < r_) ? full_ * F.G + j_ : U_; }
        if (L >= U_) break; n = i + 1;
        const int rb = L >> 2, t = L & 3; int e = 0;
        for (int k = 1; k < 32; ++k) if (rb0[k] <= rb) e = k;
        const int jb = rb - rb0[e]; const int valid = min(256, cn[e] - 256 * jb);
        if (F.tid == 0) { units[4 * i] = rb; units[4 * i + 1] = t; units[4 * i + 2] = e; units[4 * i + 3] = valid; }
        if (F.tid < 256) { const int r = F.tid; const int src = e * 32768 + 256 * jb + (r < valid ? r : 0); const int tk = ltok[src];
            if (mode == 0) rowoff[i * 256 + r] = (unsigned)(tk >> 1) * (unsigned)DMODEL;
            else { rowoff[i * 256 + r] = (r < valid) ? (unsigned)tk : (unsigned)(2 * TOK); roww[i * 256 + r] = (r < valid) ? lw[src] : 0.f; } }
    }
    VM_WAIT(); LDS_WAIT(); __syncthreads();
    return n;
}

struct Args { const float* in[19]; float* out; unsigned char* ws; int ph_lo, ph_hi; };
typedef __attribute__((address_space(4))) const Args CArgs;
__device__ __forceinline__ CArgs* phase_args() { CArgs* p = (CArgs*)__builtin_amdgcn_kernarg_segment_ptr(); asm volatile("" : "+s"(p)); return p; }
__global__ void __launch_bounds__(NWAVES * 64, 2) fwd(Args args) {
    extern __shared__ __attribute__((aligned(16))) unsigned char lds[];
    Frame F0; Frame& F = F0;
    F.lds = (LAS unsigned char*)lds;
    F.MISC = (volatile LAS unsigned*)(F.lds + MISC_OFF);
    const int wv0 = __builtin_amdgcn_readfirstlane((int)threadIdx.x >> 6);
#define HW_TID() ([&]() { unsigned z_ = 0u; asm volatile("" : "+v"(z_)); return 64 * wv0 + (int)__builtin_amdgcn_mbcnt_hi(~0u, __builtin_amdgcn_mbcnt_lo(~0u, z_)); }())
    F.tid = HW_TID(); F.lane = F.tid & 63; F.wave = wv0;
    F.G = gridDim.x; { const int bx = blockIdx.x; F.vcu = (F.G % 8 == 0) ? (bx % 8) * (F.G / 8) + bx / 8 : bx; }
    F.ctl = (gu32*)(args.ws + WS_CTL);
    for (int u = F.tid; u < (LDS_BYTES - LDSCTL_OFF) / 4; u += NWAVES * 64) ((LAS unsigned*)(F.lds + LDSCTL_OFF))[u] = 0u;
    __syncthreads();
    if (N_LAUNCHES == 1) (void)xcd_barrier_post((unsigned*)(F.ctl + CW_BAR), F.MISC + 8, F.tid);
#define GRID_BAR() do { if (N_LAUNCHES == 1) { XcdBarrier b_; b_.bar = (unsigned*)(F.ctl + CW_BAR); b_.x = xb_xcc_id(); b_.st = F.MISC + 8; xcd_barrier(b_, F.tid); } } while (0)
#ifndef PROBE_BLK
#define PROBE_BLK 0
#endif
#if defined(PROBE_A)
    unsigned long long* const ts_ = (unsigned long long*)(args.ws + 2 * MiB + 512 * 1024);
    if (blockIdx.x == 0 && F.tid == 0) { for (int i_ = 24; i_ < 34; ++i_) ts_[i_] = 0; ts_[0] = __builtin_amdgcn_s_memrealtime(); }
#define STAMP(k) do { if (blockIdx.x == 0 && F.tid == 0) ts_[(k) + 1] = __builtin_amdgcn_s_memrealtime(); } while (0)
#else
#define STAMP(k) do { } while (0)
#endif
    const int lo = (N_LAUNCHES == 1) ? 0 : args.ph_lo, hi = (N_LAUNCHES == 1) ? (int)PH_COUNT : args.ph_hi;
#ifndef PHASE_MASK
#define PHASE_MASK 0xFFF
#endif
#define IN(k) ((((PHASE_MASK) >> (k)) & 1) && lo <= (k) && (k) < hi)
#define BOTH(k) (IN(k) && IN((k) + 1))
#define Win_t ((bf16*)(ws + WS_WIN))
#define BrA_t ((bf16*)(ws + WS_BRA))
#define BrB_t ((bf16*)(ws + WS_BRB))
#define Wout_t ((bf16*)(ws + WS_WOUT))
#define Wpg_t ((bf16*)(ws + WS_WPG))
#define Wpp_t ((bf16*)(ws + WS_WPP))
#define PB ((bf16*)(ws + WS_PB))
#define HA ((bf16*)(ws + WS_A))
#define ropec ((float*)(ws + WS_ROPEC))
#define ropes ((float*)(ws + WS_ROPES))
#define kmean ((float*)(ws + WS_KMEAN))
#define cnt_g ((int*)(ws + WS_CTL + 4 * CW_CNT))
#define ltok ((int*)(ws + WS_LTOK))
#define lwt ((float*)(ws + WS_LW))
    if (IN(PH_PRO)) {
        CArgs& args = *phase_args(); unsigned char* const ws = args.ws; float* const out = args.out; const float* const x = args.in[0]; (void)x; (void)out;
        Frame F; { int t_ = HW_TID(); asm volatile("" : "+v"(t_)); F.tid = t_; F.lane = t_ & 63; F.wave = __builtin_amdgcn_readfirstlane(t_ >> 6);
          unsigned l_ = (unsigned)(uintptr_t)lds; asm volatile("" : "+s"(l_)); F.lds = (LAS unsigned char*)l_; F.MISC = (volatile LAS unsigned*)(F.lds + MISC_OFF); F.ctl = (gu32*)(ws + WS_CTL);
          int g_ = (int)gridDim.x; asm volatile("" : "+s"(g_)); F.G = g_; const int bx = blockIdx.x; F.vcu = (F.G % 8 == 0) ? (bx % 8) * (F.G / 8) + bx / 8 : bx; }
        const int gw = F.vcu * NWAVES + F.wave, NGW = F.G * NWAVES; (void)gw; (void)NGW;
        constexpr int I_IN = 16 * 179, I_BR = 8 * 32, I_O = 16 * 32, I_PP = 4 * 32;
        constexpr int NITEMS = I_IN + 2 * I_BR + 2 * I_O + I_PP;
        { const int gt = F.vcu * NWAVES * 64 + F.tid, NGT = F.G * NWAVES * 64;
            for (int i = gt; i < 184 * 128; i += NGT) ((GAS v4u*)(Win_t + (size_t)584 * DMODEL))[i] = (v4u){0u, 0u, 0u, 0u};
            for (int i = gt; i < SEQ * 8; i += NGT) { const int pos = i >> 3, k = i & 7; const float inv = 1.0f / powf(500000.0f, (float)k * 0.125f); const float ang = (float)pos * inv; ropec[i] = cosf(ang); ropes[i] = sinf(ang); } }
        { const int gt = F.vcu * NWAVES * 64 + F.tid, NGT = F.G * NWAVES * 64;
          const int trips_r = (TOK - gw + 4 * NGW - 1) / (4 * NGW), trips_i = (NITEMS - gw + NGW - 1) / NGW, trips_p = (TOK * PLE / 4 + 4 * NGT - 1) / (4 * NGT);
          const int trips = max(max(trips_r, trips_i), trips_p);
          const GAS f32x4* p4 = (const GAS f32x4*)args.in[1]; GAS unsigned long long* pb8 = (GAS unsigned long long*)PB;
          f32x4 gg[4];
#pragma unroll
          for (int j = 0; j < 4; ++j) gg[j] = ((const GAS f32x4*)args.in[2] + F.lane)[64 * j];
#pragma unroll 1
          for (int b = 0; b < trips; ++b) {
              f32x4 v[4][4]; float t[32]; f32x4 pv[4];
#pragma unroll
              for (int r = 0; r < 4; ++r) { int m = gw + (4 * b + r) * NGW; m = m < TOK ? m : TOK - 1; const GAS f32x4* xr = (const GAS f32x4*)(x + (size_t)m * DMODEL) + F.lane;
#pragma unroll
                  for (int j = 0; j < 4; ++j) v[r][j] = xr[64 * j]; }
              const int it0 = gw + b * NGW; const int it = it0 < NITEMS ? it0 : NITEMS - 1; int r_ = it; int kind = 0;
              const float* W_ = args.in[3]; int K_ = DMODEL, N_ = IN_COLS; unsigned char* d_ = (unsigned char*)Win_t;
              {
                  if (r_ >= I_IN) { r_ -= I_IN; kind = 1; W_ = args.in[4]; K_ = AW; N_ = DMODEL; d_ = (unsigned char*)BrA_t;
                      if (r_ >= I_BR) { r_ -= I_BR; kind = 2; W_ = args.in[5]; d_ = (unsigned char*)BrA_t + AW;
                          if (r_ >= I_BR) { r_ -= I_BR; kind = 3; W_ = args.in[6]; K_ = DMODEL; d_ = (unsigned char*)Wout_t;
                              if (r_ >= I_O) { r_ -= I_O; kind = 4; W_ = args.in[16]; d_ = (unsigned char*)Wpg_t;
                                  if (r_ >= I_O) { r_ -= I_O; kind = 5; W_ = args.in[17]; K_ = PLE; d_ = (unsigned char*)Wpp_t; } } } } } }
              const int nblk_ = (N_ + 31) >> 5;
              conv_load(W_, N_, nblk_, r_, F.lane, t);
              if (it0 >= NITEMS) kind = -1;
#pragma unroll
              for (int j = 0; j < 4; ++j) { int i = gt + (4 * b + j) * NGT; i = i < TOK * PLE / 4 ? i : TOK * PLE / 4 - 1; pv[j] = p4[i]; }
              asm volatile("" : "+v"(v[0][0]), "+v"(v[0][1]), "+v"(v[0][2]), "+v"(v[0][3]) :: "memory");
#pragma unroll
              for (int r = 0; r < 4; ++r) { const int m = gw + (4 * b + r) * NGW; float s = 0.f;
#pragma unroll
                  for (int j = 0; j < 4; ++j) s += (v[r][j].x * v[r][j].x + v[r][j].y * v[r][j].y) + (v[r][j].z * v[r][j].z + v[r][j].w * v[r][j].w);
                  const float rstd = sqrtf(wave_sum(s) * (1.f / DMODEL) + RMS_EPS); const float rinv = 1.0f / rstd;
                  if (m < TOK && F.lane == 0) ((float*)(ws + WS_RSTD))[m] = rstd;
                  if (m < TOK) { GAS unsigned long long* o8 = (GAS unsigned long long*)(HA + (size_t)m * DMODEL) + F.lane; GAS unsigned* o4 = (GAS unsigned*)(ws + WS_H8 + (size_t)m * DMODEL) + F.lane;
#pragma unroll
                      for (int j = 0; j < 4; ++j) { const f32x4 h = (f32x4){v[r][j].x * rinv * gg[j].x, v[r][j].y * rinv * gg[j].y, v[r][j].z * rinv * gg[j].z, v[r][j].w * rinv * gg[j].w};
                          o8[64 * j] = (unsigned long long)pg8::cvt_pk_bf16(h.x, h.y) | ((unsigned long long)pg8::cvt_pk_bf16(h.z, h.w) << 32);
                          int w_ = __builtin_amdgcn_cvt_pk_fp8_f32(h.x, h.y, 0, false); w_ = __builtin_amdgcn_cvt_pk_fp8_f32(h.z, h.w, w_, true); o4[64 * j] = (unsigned)w_; } } }
              asm volatile("" ::: "memory");
              if (kind == 0) conv_store<2>(K_, N_, nblk_, r_, F.lane, (unsigned char*)Win_t, ws + WS_WIN8, RmWin{}, 32.f, t);
              else if (kind == 5) conv_store<0>(K_, N_, nblk_, r_, F.lane, d_, d_, RmIdent{}, 1.f, t);
              else if (kind > 0) conv_store<1>(K_, N_, nblk_, r_, F.lane, d_, d_, RmIdent{}, 32.f, t, (kind <= 2) ? DMODEL : 0);
#pragma unroll
              for (int j = 0; j < 4; ++j) { const int i = gt + (4 * b + j) * NGT; if (i < TOK * PLE / 4) pb8[i] = (unsigned long long)pg8::cvt_pk_bf16(pv[j].x, pv[j].y) | ((unsigned long long)pg8::cvt_pk_bf16(pv[j].z, pv[j].w) << 32); }
          } }
        if (BOTH(PH_PRO)) GRID_BAR(); STAMP(PH_PRO);
    }
    if (IN(PH_ZG)) {
        CArgs& args = *phase_args(); unsigned char* const ws = args.ws; float* const out = args.out; const float* const x = args.in[0]; (void)x; (void)out;
        Frame F; { int t_ = HW_TID(); asm volatile("" : "+v"(t_)); F.tid = t_; F.lane = t_ & 63; F.wave = __builtin_amdgcn_readfirstlane(t_ >> 6);
          unsigned l_ = (unsigned)(uintptr_t)lds; asm volatile("" : "+s"(l_)); F.lds = (LAS unsigned char*)l_; F.MISC = (volatile LAS unsigned*)(F.lds + MISC_OFF); F.ctl = (gu32*)(ws + WS_CTL);
          int g_ = (int)gridDim.x; asm volatile("" : "+s"(g_)); F.G = g_; const int bx = blockIdx.x; F.vcu = (F.G % 8 == 0) ? (bx % 8) * (F.G / 8) + bx / 8 : bx; }
        const int gw = F.vcu * NWAVES + F.wave, NGW = F.G * NWAVES; (void)gw; (void)NGW;
        { pg8::Gemm g{(const bf16*)(ws + WS_H8), (const bf16*)(ws + WS_WIN8), TOK, 5120, DMODEL}; pg8::StaticOrderTail S; S.S.init(TOK, 5120, F.G, (int)blockIdx.x);
          { const int nb = (TOK / 256) * 3, rb = nb % F.G; const bool uneven = (rb > 0) && (2 * rb == F.G) && (S.S.nwg % F.G == 0); S.full = uneven ? S.S.nwg / F.G - 1 : (1 << 20); S.cut = uneven ? rb : 0; }
          pg8::EpiZ<1> E{(bf16*)(ws + WS_QA), (bf16*)(ws + WS_KA), (bf16*)(ws + WS_VA), (bf16*)(ws + WS_QB), (bf16*)(ws + WS_KB), (bf16*)(ws + WS_VB), (bf16*)(ws + WS_IQ), (bf16*)(ws + WS_IK),
                      (bf16*)(ws + WS_GA), (bf16*)(ws + WS_GB), (float*)(ws + WS_IW), kmean, ropec, ropes};
          pg8::gemm_phase<pg8::EpiZ<1>, pg8::StaticOrderTail, true, true, false, true>(F.lds + RING_OFF, g, S, E, F.tid); }
        VM_WAIT(); __syncthreads();
        { pg8::Gemm g{HA, Win_t, TOK, 768, DMODEL}; pg8::StaticOrder S; S.init(TOK, 768, F.G, (int)blockIdx.x);
          pg8::EpiZ<0> E{(bf16*)(ws + WS_QA), (bf16*)(ws + WS_KA), (bf16*)(ws + WS_VA), (bf16*)(ws + WS_QB), (bf16*)(ws + WS_KB), (bf16*)(ws + WS_VB), (bf16*)(ws + WS_IQ), (bf16*)(ws + WS_IK),
                      (bf16*)(ws + WS_GA), (bf16*)(ws + WS_GB), (float*)(ws + WS_IW), kmean, ropec, ropes};
          pg8::gemm_phase<pg8::EpiZ<0>, pg8::StaticOrder, true, true, false, false>(F.lds + RING_OFF, g, S, E, F.tid); }
        if (BOTH(PH_ZG)) GRID_BAR(); STAMP(PH_ZG);
    }
    if (IN(PH_IDX)) {
        CArgs& args = *phase_args(); unsigned char* const ws = args.ws; float* const out = args.out; const float* const x = args.in[0]; (void)x; (void)out;
        Frame F; { int t_ = HW_TID(); asm volatile("" : "+v"(t_)); F.tid = t_; F.lane = t_ & 63; F.wave = __builtin_amdgcn_readfirstlane(t_ >> 6);
          unsigned l_ = (unsigned)(uintptr_t)lds; asm volatile("" : "+s"(l_)); F.lds = (LAS unsigned char*)l_; F.MISC = (volatile LAS unsigned*)(F.lds + MISC_OFF); F.ctl = (gu32*)(ws + WS_CTL);
          int g_ = (int)gridDim.x; asm volatile("" : "+s"(g_)); F.G = g_; const int bx = blockIdx.x; F.vcu = (F.G % 8 == 0) ? (bx % 8) * (F.G / 8) + bx / 8 : bx; }
        const int gw = F.vcu * NWAVES + F.wave, NGW = F.G * NWAVES; (void)gw; (void)NGW;
        const int b = F.vcu >> 5, jj = F.vcu & 31;
#if defined(PROBE_A)
        const unsigned long long tl0_ = __builtin_amdgcn_s_memrealtime();
#endif
        if (F.G == 256) {
            (void)jj;
            unsigned* const qh = (unsigned*)(ws + WS_CTL) + CW_IDXQ + 16 * b; volatile LAS int* const tk = (volatile LAS int*)(F.lds + MISC_OFF + 64);
            if (F.tid == 0) tk[0] = (int)__hip_atomic_fetch_add(qh, 1u, __ATOMIC_RELAXED, __HIP_MEMORY_SCOPE_AGENT);
            __syncthreads(); int t = tk[0]; __syncthreads();
#pragma unroll 1
            while (t < 256) { const int u = 255 - t;
                unsigned nx = 0u; if (F.tid == 0) nx = __hip_atomic_fetch_add(qh, 1u, __ATOMIC_RELAXED, __HIP_MEMORY_SCOPE_AGENT);
                idx::unit(b, 16 * u, (const bf16*)(ws + WS_IQ), (const bf16*)(ws + WS_IK), (const float*)(ws + WS_IW), (unsigned*)(ws + WS_MASK), (char*)lds + RING_OFF, F.tid
#if defined(PROBE_ACC)
                    , (blockIdx.x == PROBE_BLK) ? ts_ + 24 : nullptr
#endif
                    );
                if (F.tid == 0) tk[0] = (int)nx;
                __syncthreads(); t = tk[0]; __syncthreads(); }
        }
        if (BOTH(PH_IDX)) GRID_BAR(); STAMP(PH_IDX);
    }
    if (IN(PH_ATT)) {
        CArgs& args = *phase_args(); unsigned char* const ws = args.ws; float* const out = args.out; const float* const x = args.in[0]; (void)x; (void)out;
        Frame F; { int t_ = HW_TID(); asm volatile("" : "+v"(t_)); F.tid = t_; F.lane = t_ & 63; F.wave = __builtin_amdgcn_readfirstlane(t_ >> 6);
          unsigned l_ = (unsigned)(uintptr_t)lds; asm volatile("" : "+s"(l_)); F.lds = (LAS unsigned char*)l_; F.MISC = (volatile LAS unsigned*)(F.lds + MISC_OFF); F.ctl = (gu32*)(ws + WS_CTL);
          int g_ = (int)gridDim.x; asm volatile("" : "+s"(g_)); F.G = g_; const int bx = blockIdx.x; F.vcu = (F.G % 8 == 0) ? (bx % 8) * (F.G / 8) + bx / 8 : bx; }
        const int gw = F.vcu * NWAVES + F.wave, NGW = F.G * NWAVES; (void)gw; (void)NGW;
        if (F.G == 256) {
            const int bh = F.vcu >> 2, s = F.vcu & 3; const int b = bh >> 3, h = bh & 7;
#pragma unroll 1
            for (int i = 0; i < 4; ++i) { const int qb = (i == 0) ? s : (i == 1) ? 7 - s : (i == 2) ? 8 + s : 15 - s;
                att2::attn_unit<0, 8>(b, h, qb, (const bf16*)(ws + WS_QA), (const bf16*)(ws + WS_KA), (const bf16*)(ws + WS_VA), ws + WS_OAB8, kmean, (char*)lds + RING_OFF, F.tid); }
#pragma unroll 1
            for (int i = 0; i < 4; ++i) { const int qb = (i == 0) ? s : (i == 1) ? 7 - s : (i == 2) ? 8 + s : 15 - s;
                att2::attn_unit<1, 8>(b, h, qb, (const bf16*)(ws + WS_QB), (const bf16*)(ws + WS_KB), (const bf16*)(ws + WS_VB), ws + WS_OAB8 + AW, ws + WS_MASK, (char*)lds + RING_OFF, F.tid); }
        }
        if (BOTH(PH_ATT)) GRID_BAR(); STAMP(PH_ATT);
    }
    if (IN(PH_BR)) {
        CArgs& args = *phase_args(); unsigned char* const ws = args.ws; float* const out = args.out; const float* const x = args.in[0]; (void)x; (void)out;
        Frame F; { int t_ = HW_TID(); asm volatile("" : "+v"(t_)); F.tid = t_; F.lane = t_ & 63; F.wave = __builtin_amdgcn_readfirstlane(t_ >> 6);
          unsigned l_ = (unsigned)(uintptr_t)lds; asm volatile("" : "+s"(l_)); F.lds = (LAS unsigned char*)l_; F.MISC = (volatile LAS unsigned*)(F.lds + MISC_OFF); F.ctl = (gu32*)(ws + WS_CTL);
          int g_ = (int)gridDim.x; asm volatile("" : "+s"(g_)); F.G = g_; const int bx = blockIdx.x; F.vcu = (F.G % 8 == 0) ? (bx % 8) * (F.G / 8) + bx / 8 : bx; }
        const int gw = F.vcu * NWAVES + F.wave, NGW = F.G * NWAVES; (void)gw; (void)NGW;
        { pg8::Gemm g{(const bf16*)(ws + WS_OAB8), BrA_t, TOK, DMODEL, 2 * AW}; pg8::StaticOrder S; S.init(TOK, DMODEL, F.G, (int)blockIdx.x);
          pg8::EpiMerged E{(const bf16*)(ws + WS_GA), (const bf16*)(ws + WS_GB), ws + WS_MRG};
          pg8::gemm_phase<pg8::EpiMerged, pg8::StaticOrder, true, true, false, true>(F.lds + RING_OFF, g, S, E, F.tid); }
        if (BOTH(PH_BR)) GRID_BAR(); STAMP(PH_BR);
    }
    if (IN(PH_WO)) {
        CArgs& args = *phase_args(); unsigned char* const ws = args.ws; float* const out = args.out; const float* const x = args.in[0]; (void)x; (void)out;
        Frame F; { int t_ = HW_TID(); asm volatile("" : "+v"(t_)); F.tid = t_; F.lane = t_ & 63; F.wave = __builtin_amdgcn_readfirstlane(t_ >> 6);
          unsigned l_ = (unsigned)(uintptr_t)lds; asm volatile("" : "+s"(l_)); F.lds = (LAS unsigned char*)l_; F.MISC = (volatile LAS unsigned*)(F.lds + MISC_OFF); F.ctl = (gu32*)(ws + WS_CTL);
          int g_ = (int)gridDim.x; asm volatile("" : "+s"(g_)); F.G = g_; const int bx = blockIdx.x; F.vcu = (F.G % 8 == 0) ? (bx % 8) * (F.G / 8) + bx / 8 : bx; }
        const int gw = F.vcu * NWAVES + F.wave, NGW = F.G * NWAVES; (void)gw; (void)NGW;
        pg8::Gemm g{(const bf16*)(ws + WS_MRG), Wout_t, TOK, DMODEL, DMODEL}; pg8::StaticOrder S; S.init(TOK, DMODEL, F.G, (int)blockIdx.x);
        pg8::EpiResidualB E{HA, (const float*)(ws + WS_RSTD), args.in[2], (bf16*)(ws + WS_X1B)};
        pg8::gemm_phase<pg8::EpiResidualB, pg8::StaticOrder, true, true, false, true>(F.lds + RING_OFF, g, S, E, F.tid);
        if (BOTH(PH_WO)) GRID_BAR(); STAMP(PH_WO);
    }
    if (IN(PH_RT)) {
        CArgs& args = *phase_args(); unsigned char* const ws = args.ws; float* const out = args.out; const float* const x = args.in[0]; (void)x; (void)out;
        Frame F; { int t_ = HW_TID(); asm volatile("" : "+v"(t_)); F.tid = t_; F.lane = t_ & 63; F.wave = __builtin_amdgcn_readfirstlane(t_ >> 6);
          unsigned l_ = (unsigned)(uintptr_t)lds; asm volatile("" : "+s"(l_)); F.lds = (LAS unsigned char*)l_; F.MISC = (volatile LAS unsigned*)(F.lds + MISC_OFF); F.ctl = (gu32*)(ws + WS_CTL);
          int g_ = (int)gridDim.x; asm volatile("" : "+s"(g_)); F.G = g_; const int bx = blockIdx.x; F.vcu = (F.G % 8 == 0) ? (bx % 8) * (F.G / 8) + bx / 8 : bx; }
        const int gw = F.vcu * NWAVES + F.wave, NGW = F.G * NWAVES; (void)gw; (void)NGW;
        LAS float* WT = (LAS float*)(F.lds);
        LAS int* lcnt = (LAS int*)(F.lds + 147456);
        LAS int* rinfo = (LAS int*)(F.lds + 147456 + 256);
        { const GAS f32x4* wg4 = (const GAS f32x4*)args.in[8]; const GAS f32x4* wr4 = (const GAS f32x4*)args.in[10];
          for (int i = F.tid; i < DMODEL; i += NWAVES * 64) { const f32x4 v = wg4[i]; WT[0 * DMODEL + i] = v.x; WT[1 * DMODEL + i] = v.y; WT[2 * DMODEL + i] = v.z; WT[3 * DMODEL + i] = v.w; }
#pragma unroll 4
          for (int i = F.tid; i < DMODEL * 8; i += NWAVES * 64) { const f32x4 v = wr4[i]; const int k = i >> 3, c = 4 + 4 * (i & 7); WT[(c + 0) * DMODEL + k] = v.x; WT[(c + 1) * DMODEL + k] = v.y; WT[(c + 2) * DMODEL + k] = v.z; WT[(c + 3) * DMODEL + k] = v.w; } }
        if (F.tid < 64) lcnt[F.tid] = 0;
        VM_WAIT(); LDS_WAIT(); __syncthreads();
        const int chunk = F.vcu;
        if (F.G == 256) {
            constexpr int NMI = NEXP * 768;
            unsigned long long vn[2][4];
#pragma unroll
            for (int t = 0; t < 2; ++t) { const GAS unsigned long long* xr = (const GAS unsigned long long*)((const bf16*)(ws + WS_X1B) + (size_t)(chunk * 128 + F.wave * 16 + t) * DMODEL) + F.lane;
#pragma unroll
                for (int j = 0; j < 4; ++j) vn[t][j] = xr[64 * j]; }
#pragma unroll 1
            for (int rr = 0; rr < 8; ++rr) { const int rloc = F.wave * 16 + 2 * rr; const int row = chunk * 128 + rloc;
                const GAS f32x4* gr = (const GAS f32x4*)args.in[7] + F.lane;
                f32x4 v[2][4]; float rinv[2]; float t_[32];
#pragma unroll
                for (int t = 0; t < 2; ++t)
#pragma unroll
                    for (int j = 0; j < 4; ++j) { const unsigned lo_ = (unsigned)vn[t][j], hi_ = (unsigned)(vn[t][j] >> 32); v[t][j] = (f32x4){pg8::bf_lo(lo_), pg8::bf_hi(lo_), pg8::bf_lo(hi_), pg8::bf_hi(hi_)}; }
                { const int rown = row + (rr < 7 ? 2 : 0);
#pragma unroll
                  for (int t = 0; t < 2; ++t) { const GAS unsigned long long* xr = (const GAS unsigned long long*)((const bf16*)(ws + WS_X1B) + (size_t)(rown + t) * DMODEL) + F.lane;
#pragma unroll
                      for (int j = 0; j < 4; ++j) vn[t][j] = xr[64 * j]; } }
                const int it0 = gw + rr * NGW; const MoeItem mi = moe_item(it0 < NMI ? it0 : NMI - 1, args.in[12], args.in[13], args.in[14], ws + WS_WGU, ws + WS_WDN);
                conv_load(mi.W, mi.N, mi.nblk, mi.r, F.lane, t_);
                asm volatile("" : "+v"(v[0][0]), "+v"(v[0][1]), "+v"(v[0][2]), "+v"(v[0][3]) :: "memory");
#pragma unroll
                for (int t = 0; t < 2; ++t) { float s = 0.f;
#pragma unroll
                    for (int j = 0; j < 4; ++j) s += (v[t][j].x * v[t][j].x + v[t][j].y * v[t][j].y) + (v[t][j].z * v[t][j].z + v[t][j].w * v[t][j].w);
                    rinv[t] = 1.0f / sqrtf(wave_sum(s) * (1.f / DMODEL) + RMS_EPS); }
#pragma unroll
                for (int t = 0; t < 2; ++t) { GAS unsigned* o4 = (GAS unsigned*)((unsigned char*)HA + (size_t)(row + t) * DMODEL) + F.lane;
#pragma unroll
                    for (int j = 0; j < 4; ++j) { const f32x4 gg = gr[64 * j]; v[t][j] = v[t][j] * rinv[t] * gg;
                        int w_ = __builtin_amdgcn_cvt_pk_fp8_f32(v[t][j].x, v[t][j].y, 0, false); w_ = __builtin_amdgcn_cvt_pk_fp8_f32(v[t][j].z, v[t][j].w, w_, true); o4[64 * j] = (unsigned)w_; } }
                float gl[2][4];
#pragma unroll
                for (int c = 0; c < 4; ++c) { float a0 = 0.f, a1 = 0.f;
#pragma unroll
                    for (int j = 0; j < 4; ++j) { const f32x4 w = *(const LAS f32x4*)(WT + c * DMODEL + 256 * j + 4 * F.lane);
                        a0 += (v[0][j].x * w.x + v[0][j].y * w.y) + (v[0][j].z * w.z + v[0][j].w * w.w); a1 += (v[1][j].x * w.x + v[1][j].y * w.y) + (v[1][j].z * w.z + v[1][j].w * w.w); }
                    gl[0][c] = wave_sum(a0) + args.in[9][c]; gl[1][c] = wave_sum(a1) + args.in[9][c]; }
#pragma unroll
                for (int t = 0; t < 2; ++t) {
                    int g = 0; float gm = gl[t][0];
#pragma unroll
                    for (int c = 1; c < 4; ++c) if (gl[t][c] > gm) { gm = gl[t][c]; g = c; }
                    g = __builtin_amdgcn_readfirstlane(g);
                    float den = 0.f;
#pragma unroll
                    for (int c = 0; c < 4; ++c) den += expf(gl[t][c] - gm);
                    const float pg = 1.0f / den;
                    float el[8];
#pragma unroll
                    for (int c = 0; c < 8; ++c) { float a = 0.f; const LAS float* wp = WT + (4 + 8 * g + c) * DMODEL + 4 * F.lane;
#pragma unroll
                        for (int j = 0; j < 4; ++j) { const f32x4 w = *(const LAS f32x4*)(wp + 256 * j); a += (v[t][j].x * w.x + v[t][j].y * w.y) + (v[t][j].z * w.z + v[t][j].w * w.w); }
                        el[c] = wave_sum(a) + args.in[11][8 * g + c]; }
                    int i1 = 0; float v1 = el[0];
#pragma unroll
                    for (int c = 1; c < 8; ++c) if (el[c] > v1) { v1 = el[c]; i1 = c; }
                    int i2 = -1; float v2 = -INFINITY;
#pragma unroll
                    for (int c = 0; c < 8; ++c) if (c != i1 && el[c] > v2) { v2 = el[c]; i2 = c; }
                    const float e2 = expf(v2 - v1); const float w1 = pg / (1.0f + e2), w2 = pg * e2 / (1.0f + e2);
                    if (F.lane == 0) { const int e1 = 8 * g + i1, ee2 = 8 * g + i2;
                        const int p1 = __hip_atomic_fetch_add(lcnt + e1, 1, __ATOMIC_RELAXED, __HIP_MEMORY_SCOPE_WORKGROUP); const int p2 = __hip_atomic_fetch_add(lcnt + ee2, 1, __ATOMIC_RELAXED, __HIP_MEMORY_SCOPE_WORKGROUP);
                        LAS int* ri = rinfo + (rloc + t) * 8; ri[0] = e1; ri[1] = p1; ri[2] = (int)__float_as_uint(w1); ri[3] = 2 * (row + t); ri[4] = ee2; ri[5] = p2; ri[6] = (int)__float_as_uint(w2); ri[7] = 2 * (row + t) + 1; }
                }
                asm volatile("" ::: "memory");
                if (it0 < NMI) conv_store<1>(mi.K, mi.N, mi.nblk, mi.r, F.lane, mi.d, mi.d, RmMoe{mi.mode}, 32.f, t_);
            }
            LDS_WAIT(); __syncthreads();
            if (F.tid < 32) { const int c = lcnt[F.tid]; lcnt[32 + F.tid] = c ? (int)__hip_atomic_fetch_add((gu32*)cnt_g + F.tid, (unsigned)c, RLX_AGENT) : 0; }
            VM_WAIT(); LDS_WAIT(); __syncthreads();
            if (F.tid < 256) { const LAS int* ri = rinfo + F.tid * 4; const int e = ri[0], pos = lcnt[32 + e] + ri[1]; ltok[e * 32768 + pos] = ri[3]; lwt[e * 32768 + pos] = __uint_as_float((unsigned)ri[2]); }
        }
        __syncthreads(); STAMP(19);
        { constexpr int NMI = NEXP * 768;
          const int k0 = (F.G == 256) ? 8 : 0; const int trips = (NMI - gw + NGW - 1) / NGW;
          float ta[32];
          { const int it = gw + k0 * NGW; const MoeItem mi = moe_item(it < NMI ? it : NMI - 1, args.in[12], args.in[13], args.in[14], ws + WS_WGU, ws + WS_WDN); conv_load(mi.W, mi.N, mi.nblk, mi.r, F.lane, ta); }
#pragma unroll 1
          for (int k = k0; k < trips; ++k) { float tb[32];
              const int it = gw + k * NGW, itn = it + NGW;
              const MoeItem mn = moe_item(itn < NMI ? itn : NMI - 1, args.in[12], args.in[13], args.in[14], ws + WS_WGU, ws + WS_WDN); conv_load(mn.W, mn.N, mn.nblk, mn.r, F.lane, tb);
              asm volatile("" : "+v"(ta[0]) :: "memory");
              const MoeItem mi = moe_item(it, args.in[12], args.in[13], args.in[14], ws + WS_WGU, ws + WS_WDN);
              conv_store<1>(mi.K, mi.N, mi.nblk, mi.r, F.lane, mi.d, mi.d, RmMoe{mi.mode}, 32.f, ta);
#pragma unroll
              for (int i = 0; i < 32; ++i) ta[i] = tb[i]; } }
        if (BOTH(PH_RT)) GRID_BAR(); STAMP(PH_RT);
    }
    if (IN(PH_GU)) {
        CArgs& args = *phase_args(); unsigned char* const ws = args.ws; float* const out = args.out; const float* const x = args.in[0]; (void)x; (void)out;
        Frame F; { int t_ = HW_TID(); asm volatile("" : "+v"(t_)); F.tid = t_; F.lane = t_ & 63; F.wave = __builtin_amdgcn_readfirstlane(t_ >> 6);
          unsigned l_ = (unsigned)(uintptr_t)lds; asm volatile("" : "+s"(l_)); F.lds = (LAS unsigned char*)l_; F.MISC = (volatile LAS unsigned*)(F.lds + MISC_OFF); F.ctl = (gu32*)(ws + WS_CTL);
          int g_ = (int)gridDim.x; asm volatile("" : "+s"(g_)); F.G = g_; const int bx = blockIdx.x; F.vcu = (F.G % 8 == 0) ? (bx % 8) * (F.G / 8) + bx / 8 : bx; }
        const int gw = F.vcu * NWAVES + F.wave, NGW = F.G * NWAVES; (void)gw; (void)NGW;
        const int n = moe_build(F, cnt_g, ltok, lwt, 0);
        MoeOrder S{(const LAS int*)(F.lds + TBL_OFF + MoeTbl::UNITS), (const LAS unsigned*)(F.lds + TBL_OFF + MoeTbl::ROWOFF), n, (size_t)DMODEL * DMODEL, (unsigned*)(ws + WS_CTL) + CW_HID, nullptr};
        pg8::Gemm g{HA, (const bf16*)(ws + WS_WGU), 0, DMODEL, DMODEL};
        pg8::EpiSwiglu E{ws + WS_HID};
        pg8::gemm_phase<pg8::EpiSwiglu, MoeOrder, true, true, true, true>(F.lds + RING_OFF, g, S, E, F.tid);
        { VM_WAIT(); __syncthreads();
          const int U = 4 * ((const LAS int*)(F.lds + TBL_OFF + MoeTbl::RB0))[32]; const int r = U % F.G, idle = F.G - r; const int c = (int)blockIdx.x;
          pg8::Gemm gp{PB, Wpp_t, TOK, DMODEL, PLE}; pg8::StaticOrderSlice SP; SP.S.init(TOK, DMODEL, F.G, 0); SP.limit = 256;
          if (2 * idle >= F.G) { SP.first = (c >= r) ? 0 + c - r : -1; SP.stride = idle; } else { SP.first = 0 + c; SP.stride = F.G; }
          pg8::EpiStoreBf16 EP{(bf16*)(ws + WS_P), DMODEL};
          pg8::gemm_phase<pg8::EpiStoreBf16, pg8::StaticOrderSlice, true, true, false>(F.lds + RING_OFF, gp, SP, EP, F.tid); }
        VM_WAIT(); __syncthreads(); STAMP(PH_GU);
    }
    if (IN(PH_DN)) {
        CArgs& args = *phase_args(); unsigned char* const ws = args.ws; float* const out = args.out; const float* const x = args.in[0]; (void)x; (void)out;
        Frame F; { int t_ = HW_TID(); asm volatile("" : "+v"(t_)); F.tid = t_; F.lane = t_ & 63; F.wave = __builtin_amdgcn_readfirstlane(t_ >> 6);
          unsigned l_ = (unsigned)(uintptr_t)lds; asm volatile("" : "+s"(l_)); F.lds = (LAS unsigned char*)l_; F.MISC = (volatile LAS unsigned*)(F.lds + MISC_OFF); F.ctl = (gu32*)(ws + WS_CTL);
          int g_ = (int)gridDim.x; asm volatile("" : "+s"(g_)); F.G = g_; const int bx = blockIdx.x; F.vcu = (F.G % 8 == 0) ? (bx % 8) * (F.G / 8) + bx / 8 : bx; }
        const int gw = F.vcu * NWAVES + F.wave, NGW = F.G * NWAVES; (void)gw; (void)NGW;
        const int n = moe_build(F, cnt_g, ltok, lwt, 1);
        MoeOrder S{(const LAS int*)(F.lds + TBL_OFF + MoeTbl::UNITS), (const LAS unsigned*)(F.lds + TBL_OFF + MoeTbl::ROWOFF), n, (size_t)DMODEL * DEXP, nullptr, (unsigned*)(ws + WS_CTL) + CW_HID};
        pg8::Gemm g{(const bf16*)(ws + WS_HID), (const bf16*)(ws + WS_WDN), 0, DMODEL, DEXP};
        pg8::EpiDown E{ws + WS_Y, (const LAS int*)(F.lds + TBL_OFF + MoeTbl::ROWOFF), (const LAS float*)(F.lds + TBL_OFF + MoeTbl::ROWW)};
        pg8::gemm_phase<pg8::EpiDown, MoeOrder, true, true, false, true>(F.lds + RING_OFF, g, S, E, F.tid);
        { VM_WAIT(); __syncthreads();
          const int U = 4 * ((const LAS int*)(F.lds + TBL_OFF + MoeTbl::RB0))[32]; const int r = U % F.G, idle = F.G - r; const int c = (int)blockIdx.x;
          pg8::Gemm gp{PB, Wpp_t, TOK, DMODEL, PLE}; pg8::StaticOrderSlice SP; SP.S.init(TOK, DMODEL, F.G, 0); SP.limit = 512;
          { const int r2 = 2 * r < F.G ? 2 * r : F.G, idle2 = F.G - r2; if (2 * idle2 >= F.G / 2 && idle2 > 0) { SP.first = (c >= r2) ? 256 + c - r2 : -1; SP.stride = idle2; } else { SP.first = 256 + c; SP.stride = F.G; } }
          pg8::EpiStoreBf16 EP{(bf16*)(ws + WS_P), DMODEL};
          pg8::gemm_phase<pg8::EpiStoreBf16, pg8::StaticOrderSlice, true, true, false>(F.lds + RING_OFF, gp, SP, EP, F.tid); }
        if (BOTH(PH_DN)) GRID_BAR(); STAMP(PH_DN);
    }
    if (IN(PH_CMB)) {
        CArgs& args = *phase_args(); unsigned char* const ws = args.ws; float* const out = args.out; const float* const x = args.in[0]; (void)x; (void)out;
        Frame F; { int t_ = HW_TID(); asm volatile("" : "+v"(t_)); F.tid = t_; F.lane = t_ & 63; F.wave = __builtin_amdgcn_readfirstlane(t_ >> 6);
          unsigned l_ = (unsigned)(uintptr_t)lds; asm volatile("" : "+s"(l_)); F.lds = (LAS unsigned char*)l_; F.MISC = (volatile LAS unsigned*)(F.lds + MISC_OFF); F.ctl = (gu32*)(ws + WS_CTL);
          int g_ = (int)gridDim.x; asm volatile("" : "+s"(g_)); F.G = g_; const int bx = blockIdx.x; F.vcu = (F.G % 8 == 0) ? (bx % 8) * (F.G / 8) + bx / 8 : bx; }
        const int gw = F.vcu * NWAVES + F.wave, NGW = F.G * NWAVES; (void)gw; (void)NGW;
        const unsigned char* Y = ws + WS_Y;
#ifndef NO_CMB_LOOP
        { f32x4 gg[4];
#pragma unroll
          for (int j = 0; j < 4; ++j) gg[j] = ((const GAS f32x4*)args.in[15] + F.lane)[64 * j];
#pragma unroll 1
          for (int m0 = gw; m0 < TOK; m0 += 4 * NGW) {
              unsigned long long xw[4][4]; unsigned ya[4][4], yb[4][4];
#pragma unroll
              for (int r = 0; r < 4; ++r) { int m = m0 + r * NGW; m = m < TOK ? m : TOK - 1;
                  const GAS unsigned long long* x1r = (const GAS unsigned long long*)((const bf16*)(ws + WS_X1B) + (size_t)m * DMODEL) + F.lane;
                  const GAS unsigned* y0 = (const GAS unsigned*)(Y + (size_t)(2 * m) * DMODEL) + F.lane; const GAS unsigned* y1 = (const GAS unsigned*)(Y + (size_t)(2 * m + 1) * DMODEL) + F.lane;
#pragma unroll
                  for (int j = 0; j < 4; ++j) { xw[r][j] = x1r[64 * j]; ya[r][j] = y0[64 * j]; yb[r][j] = y1[64 * j]; } }
              asm volatile("" : "+v"(xw[0][0]) :: "memory");
#pragma unroll
              for (int r = 0; r < 4; ++r) { const int m = m0 + r * NGW; f32x4 v[4]; float s = 0.f;
#pragma unroll
                  for (int j = 0; j < 4; ++j) { const unsigned lo_ = (unsigned)xw[r][j], hi_ = (unsigned)(xw[r][j] >> 32); v[j] = (f32x4){pg8::bf_lo(lo_), pg8::bf_hi(lo_), pg8::bf_lo(hi_), pg8::bf_hi(hi_)}; const unsigned a = ya[r][j], b = yb[r][j];
                      const auto a0 = __builtin_amdgcn_cvt_pk_f32_fp8((int)a, false), a1 = __builtin_amdgcn_cvt_pk_f32_fp8((int)a, true), b0 = __builtin_amdgcn_cvt_pk_f32_fp8((int)b, false), b1 = __builtin_amdgcn_cvt_pk_f32_fp8((int)b, true);
                      v[j].x += (a0[0] + b0[0]) * (1.0f / 64.0f); v[j].y += (a0[1] + b0[1]) * (1.0f / 64.0f); v[j].z += (a1[0] + b1[0]) * (1.0f / 64.0f); v[j].w += (a1[1] + b1[1]) * (1.0f / 64.0f);
#if defined(PROBE_A)
                      if (m < TOK) ((GAS f32x4*)(out + (size_t)m * DMODEL) + F.lane)[64 * j] = v[j];
#endif
                      if (m < TOK) ((GAS unsigned long long*)((bf16*)(ws + WS_X1B) + (size_t)m * DMODEL) + F.lane)[64 * j] = (unsigned long long)pg8::cvt_pk_bf16(v[j].x, v[j].y) | ((unsigned long long)pg8::cvt_pk_bf16(v[j].z, v[j].w) << 32);
                      s += (v[j].x * v[j].x + v[j].y * v[j].y) + (v[j].z * v[j].z + v[j].w * v[j].w); }
                  const float rinv = 1.0f / sqrtf(wave_sum(s) * (1.f / DMODEL) + RMS_EPS);
                  if (m < TOK) { GAS unsigned* o4 = (GAS unsigned*)((unsigned char*)HA + (size_t)m * DMODEL) + F.lane;
#pragma unroll
                      for (int j = 0; j < 4; ++j) { int w_ = __builtin_amdgcn_cvt_pk_fp8_f32(v[j].x * rinv * gg[j].x, v[j].y * rinv * gg[j].y, 0, false); w_ = __builtin_amdgcn_cvt_pk_fp8_f32(v[j].z * rinv * gg[j].z, v[j].w * rinv * gg[j].w, w_, true); o4[64 * j] = (unsigned)w_; } } } } }
#endif
        VM_WAIT(); __syncthreads(); STAMP(20);
        if (BOTH(PH_CMB)) GRID_BAR(); STAMP(PH_CMB);
    }
    if (IN(PH_PG)) {
        CArgs& args = *phase_args(); unsigned char* const ws = args.ws; float* const out = args.out; const float* const x = args.in[0]; (void)x; (void)out;
        Frame F; { int t_ = HW_TID(); asm volatile("" : "+v"(t_)); F.tid = t_; F.lane = t_ & 63; F.wave = __builtin_amdgcn_readfirstlane(t_ >> 6);
          unsigned l_ = (unsigned)(uintptr_t)lds; asm volatile("" : "+s"(l_)); F.lds = (LAS unsigned char*)l_; F.MISC = (volatile LAS unsigned*)(F.lds + MISC_OFF); F.ctl = (gu32*)(ws + WS_CTL);
          int g_ = (int)gridDim.x; asm volatile("" : "+s"(g_)); F.G = g_; const int bx = blockIdx.x; F.vcu = (F.G % 8 == 0) ? (bx % 8) * (F.G / 8) + bx / 8 : bx; }
        const int gw = F.vcu * NWAVES + F.wave, NGW = F.G * NWAVES; (void)gw; (void)NGW;
#if defined(PROBE_A)
        { pg8::Gemm g{HA, Wpg_t, TOK, DMODEL, DMODEL}; pg8::StaticOrder S; S.init(TOK, DMODEL, F.G, (int)blockIdx.x);
          pg8::EpiPle E{out, (const bf16*)(ws + WS_P), (float*)(ws + WS_ST)};
          pg8::gemm_phase<pg8::EpiPle, pg8::StaticOrder, true, true, false, true>(F.lds + RING_OFF, g, S, E, F.tid); }
#else
        if (F.G == 256) {
            { pg8::Gemm g{HA, Wpg_t, TOK, DMODEL, DMODEL}; pg8::StaticOrderRound S; S.S.init(TOK, DMODEL, F.G, (int)blockIdx.x); S.round = 0;
              pg8::EpiPleFin E{out, (const bf16*)(ws + WS_X1B), (const bf16*)(ws + WS_P), (float*)(ws + WS_ST), (unsigned*)(ws + WS_CTL) + CW_FIN, args.in[18]};
              pg8::gemm_phase<pg8::EpiPleFin, pg8::StaticOrderRound, true, true, false, true>(F.lds + RING_OFF, g, S, E, F.tid); }
            VM_WAIT(); __syncthreads();
            { pg8::Gemm g{HA, Wpg_t, TOK, DMODEL, DMODEL}; pg8::StaticOrderRound S; S.S.init(TOK, DMODEL, F.G, (int)blockIdx.x); S.round = 1;
              pg8::EpiPleFin E{out, (const bf16*)(ws + WS_X1B), (const bf16*)(ws + WS_P), (float*)(ws + WS_ST), (unsigned*)(ws + WS_CTL) + CW_FIN, args.in[18]};
              pg8::gemm_phase<pg8::EpiPleFin, pg8::StaticOrderRound, true, true, false, true>(F.lds + RING_OFF, g, S, E, F.tid); }
        }
#endif
#if defined(PROBE_A)
        if (BOTH(PH_PG)) GRID_BAR(); STAMP(PH_PG);
#endif
    }
#if defined(PROBE_A)
    if (IN(PH_FIN)) {
        CArgs& args = *phase_args(); unsigned char* const ws = args.ws; float* const out = args.out; const float* const x = args.in[0]; (void)x; (void)out;
        Frame F; { int t_ = HW_TID(); asm volatile("" : "+v"(t_)); F.tid = t_; F.lane = t_ & 63; F.wave = __builtin_amdgcn_readfirstlane(t_ >> 6);
          unsigned l_ = (unsigned)(uintptr_t)lds; asm volatile("" : "+s"(l_)); F.lds = (LAS unsigned char*)l_; F.MISC = (volatile LAS unsigned*)(F.lds + MISC_OFF); F.ctl = (gu32*)(ws + WS_CTL);
          int g_ = (int)gridDim.x; asm volatile("" : "+s"(g_)); F.G = g_; const int bx = blockIdx.x; F.vcu = (F.G % 8 == 0) ? (bx % 8) * (F.G / 8) + bx / 8 : bx; }
        const int gw = F.vcu * NWAVES + F.wave, NGW = F.G * NWAVES; (void)gw; (void)NGW;
        const float* st = (const float*)(ws + WS_ST);
#pragma unroll 4
        for (int m = gw; m < TOK; m += NGW) {
            GAS f32x4* xr = (GAS f32x4*)(out + (size_t)m * DMODEL) + F.lane; const GAS f32x4* gr = (const GAS f32x4*)args.in[18] + F.lane;
            float s = st[(size_t)m * 16 + (F.lane & 15)];
            s += __shfl_xor(s, 1); s += __shfl_xor(s, 2); s += __shfl_xor(s, 4); s += __shfl_xor(s, 8);
            const float rinv = 1.0f / sqrtf(s * (1.f / DMODEL) + RMS_EPS);
#pragma unroll
            for (int j = 0; j < 4; ++j) { const f32x4 v = xr[64 * j]; xr[64 * j] = v * rinv * gr[64 * j]; }
#if defined(PROBE_A)
            { const unsigned long long* tq = (const unsigned long long*)(ws + 2 * MiB + 512 * 1024);
              const unsigned long long t0 = __hip_atomic_load(tq + 0, __ATOMIC_RELAXED, __HIP_MEMORY_SCOPE_AGENT), te = __hip_atomic_load(tq + PH_PG, __ATOMIC_RELAXED, __HIP_MEMORY_SCOPE_AGENT);
              float fa = 0.f; const float tot = (float)(te - t0);
#if defined(PROBE_ACC)
              fa = (float)__hip_atomic_load(tq + PROBE_ACC, __ATOMIC_RELAXED, __HIP_MEMORY_SCOPE_AGENT) / tot;
#endif
#if defined(PROBE_S0)
              fa = (float)(__hip_atomic_load(tq + PROBE_S1, __ATOMIC_RELAXED, __HIP_MEMORY_SCOPE_AGENT) - __hip_atomic_load(tq + PROBE_S0, __ATOMIC_RELAXED, __HIP_MEMORY_SCOPE_AGENT)) / tot;
#endif
#pragma unroll
              for (int k = 0; k < PH_PG; ++k) if ((PROBE_A >> k) & 1) fa += (float)(__hip_atomic_load(tq + k + 1, __ATOMIC_RELAXED, __HIP_MEMORY_SCOPE_AGENT) - __hip_atomic_load(tq + k, __ATOMIC_RELAXED, __HIP_MEMORY_SCOPE_AGENT)) / tot;
#ifndef PROBE_OFF
#define PROBE_OFF 0.0f
#endif
              #ifndef PROBE_Q
#define PROBE_Q 20.f
#endif
              fa = floorf((fa + PROBE_OFF) * PROBE_Q) / PROBE_Q;
              if ((float)m < fa * (float)TOK) {
#pragma unroll
                  for (int j = 0; j < 4; ++j) xr[64 * j] = (f32x4){0.f, 0.f, 0.f, 0.f}; }
              }
#endif
        }
    }
#endif
#undef IN
#undef BOTH
#undef GRID_BAR
}

extern "C" void kernel_launch(void* const* d_in, const int* in_sizes, int n_in, void* d_out, int out_size, void* d_ws, size_t ws_size, hipStream_t stream) {
    static int grid = 0;
    if (grid == 0) {
        if (n_in != 19 || in_sizes[0] != TOK * DMODEL || out_size != TOK * DMODEL || ws_size < WS_END) { fprintf(stderr, "kernel_launch: unexpected problem shape (n_in %d, ws %zu); nothing launched\n", n_in, ws_size); grid = -1; return; }
        int dev = 0, cus = 0, per_cu = 0;
        if (hipGetDevice(&dev) != hipSuccess || hipDeviceGetAttribute(&cus, hipDeviceAttributeMultiprocessorCount, dev) != hipSuccess) { grid = -1; return; }
        if (hipFuncSetAttribute((const void*)fwd, hipFuncAttributeMaxDynamicSharedMemorySize, LDS_BYTES) != hipSuccess) { fprintf(stderr, "kernel_launch: hipFuncSetAttribute failed\n"); grid = -1; return; }
        if (hipOccupancyMaxActiveBlocksPerMultiprocessor(&per_cu, (const void*)fwd, NWAVES * 64, LDS_BYTES) != hipSuccess || per_cu < 1) fprintf(stderr, "kernel_launch: occupancy query reports %d\n", per_cu);
        (void)hipGetLastError();
        grid = cus;
        if (grid != 256) fprintf(stderr, "kernel_launch: %d CUs; this build is laid out for 256\n", grid);
    }
    if (grid < 0) return;
    if (hipMemsetAsync((char*)d_ws + WS_CTL, 0, CTL_ZERO_BYTES, stream) != hipSuccess) return;
    Args a{};
    for (int i = 0; i < 19; ++i) a.in[i] = (const float*)d_in[i];
    a.out = (float*)d_out; a.ws = (unsigned char*)d_ws;
    if (N_LAUNCHES == 1) { a.ph_lo = 0; a.ph_hi = PH_COUNT; hipLaunchKernelGGL(fwd, dim3(grid), dim3(NWAVES * 64), LDS_BYTES, stream, a); }
    else { for (int p = 0; p < PH_COUNT; ++p) { a.ph_lo = p; a.ph_hi = p + 1; hipLaunchKernelGGL(fwd, dim3(grid), dim3(NWAVES * 64), LDS_BYTES, stream, a); } }
}
```

```cpp
#include <hip/hip_runtime.h>
#include <hip/hip_bf16.h>
#include <cstdio>
#include <cstdint>
#include <cmath>

#ifndef MK_N_LAUNCHES
#define MK_N_LAUNCHES 1
#endif

namespace pg8 {
#define PG8_LAS __attribute__((address_space(3)))
typedef unsigned short bf16_t;
typedef short bf16x8 __attribute__((ext_vector_type(8)));
typedef float f32x4 __attribute__((ext_vector_type(4)));
typedef unsigned u32x4 __attribute__((ext_vector_type(4)));
typedef unsigned u32x2 __attribute__((ext_vector_type(2)));
typedef int v4i32 __attribute__((ext_vector_type(4)));
typedef int v8i32 __attribute__((ext_vector_type(8)));
constexpr int BM = 256, BK = 64, HALF = 128, HTB = HALF * BK * 2  , STAGE_BYTES = 8 * HTB, NXCD = 8, WGM = 8;

__host__ __device__ __forceinline__ int lds_byte(int r, int c) { const int st = (r >> 4) * 2 + (c >> 5), rr = r & 15, cc = c & 31, ob = rr * 64 + cc * 2; return st * 1024 + (ob ^ (((ob >> 9) & 1) << 5)); }
__host__ __device__ __forceinline__ void stage_rc(int b, int& R, int& C) { const int st = b / 1024, sb = b % 1024, swz = sb ^ (((sb >> 9) & 1) << 5); R = (st >> 1) * 16 + swz / 64; C = (st & 1) * 32 + (swz % 64) / 2; }
__host__ __device__ __forceinline__ int perm32(int rho) { const int n = rho >> 4, i = rho & 15; return 8 * (i >> 2) + 4 * n + (i & 3); }

struct Unit { int pm, pn; size_t boff; int e, valid; };
struct Gemm { const bf16_t* A; const bf16_t* Bt; int M, N, K; };

struct StaticOrder {
    int nM, nN, nwg, G, c;
    __host__ __device__ void init(int M, int N, int G_, int c_) { nM = M / BM; nN = N / BM; nwg = nM * nN; G = G_; c = c_; }
    __host__ __device__ bool next(int i, Unit& u) const { return at((long)i * G + c, u); }
    __host__ __device__ bool at(const long L, Unit& u) const {
        if (L >= nwg) return false;
        int wgid = (int)L; { const int q = nwg / NXCD, r = nwg % NXCD, xcd = wgid % NXCD, off = wgid / NXCD; wgid = (xcd < r ? xcd * (q + 1) : r * (q + 1) + (xcd - r) * q) + off; }
        const int nig = WGM * nN, gid = wgid / nig, fm = gid * WGM, gsz = (nM - fm) < WGM ? (nM - fm) : WGM;
        u.pm = fm + ((wgid % nig) % gsz); u.pn = (wgid % nig) / gsz; u.boff = 0; u.e = 0; u.valid = 256; return true;
    }
    __device__ __forceinline__ void a_ready(const Unit&, int, int) const {}
    __device__ __forceinline__ void done(const Unit&, int, int) const {}
    __device__ __forceinline__ unsigned arow(int, int) const { return 0u; }
};

struct StaticOrderSlice {
    StaticOrder S; int first, stride, limit;
    __host__ __device__ bool next(int i, Unit& u) const { const long L = (long)first + (long)i * stride; return first >= 0 && L < limit && S.at(L, u); }
    __device__ __forceinline__ void a_ready(const Unit&, int, int) const {}
    __device__ __forceinline__ void done(const Unit&, int, int) const {}
    __device__ __forceinline__ unsigned arow(int, int) const { return 0u; }
};
struct StaticOrderTail {
    StaticOrder S; int full, cut;
    __host__ __device__ bool next(int i, Unit& u) const {
        if (i < full) return S.at((long)i * S.G + S.c, u);
        if (S.c < cut) return false;
        return S.at((long)full * S.G + (long)(i - full) * (S.G - cut) + (S.c - cut), u); }
    __device__ __forceinline__ void a_ready(const Unit&, int, int) const {}
    __device__ __forceinline__ void done(const Unit&, int, int) const {}
    __device__ __forceinline__ unsigned arow(int, int) const { return 0u; }
};
struct StaticOrderRound {
    StaticOrder S; int round;
    __host__ __device__ bool next(int i, Unit& u) const { return i == 0 && S.next(round, u); }
    __device__ __forceinline__ void a_ready(const Unit&, int, int) const {}
    __device__ __forceinline__ void done(const Unit&, int, int) const {}
    __device__ __forceinline__ unsigned arow(int, int) const { return 0u; }
};
__device__ __forceinline__ unsigned cvt_pk_bf16(float lo, float hi) { unsigned r; asm volatile("v_cvt_pk_bf16_f32 %0, %1, %2" : "=v"(r) : "v"(lo), "v"(hi)); return r; }
__device__ __forceinline__ u32x4 pack8(const f32x4 a, const f32x4 b) { u32x4 w; w.x = cvt_pk_bf16(a[0], a[1]); w.y = cvt_pk_bf16(a[2], a[3]); w.z = cvt_pk_bf16(b[0], b[1]); w.w = cvt_pk_bf16(b[2], b[3]); return w; }
__device__ __forceinline__ u32x2 pack8_fp8(const f32x4 a, const f32x4 b) { int w0 = __builtin_amdgcn_cvt_pk_fp8_f32(a[0], a[1], 0, false); w0 = __builtin_amdgcn_cvt_pk_fp8_f32(a[2], a[3], w0, true);
    int w1 = __builtin_amdgcn_cvt_pk_fp8_f32(b[0], b[1], 0, false); w1 = __builtin_amdgcn_cvt_pk_fp8_f32(b[2], b[3], w1, true); return (u32x2){(unsigned)w0, (unsigned)w1}; }
__device__ __forceinline__ float bf_lo(unsigned w) { return __uint_as_float(w << 16); }
__device__ __forceinline__ float bf_hi(unsigned w) { return __uint_as_float(w & 0xffff0000u); }
__device__ __forceinline__ void unpack8(const u32x4 w, f32x4& a, f32x4& b) { a[0] = bf_lo(w.x); a[1] = bf_hi(w.x); a[2] = bf_lo(w.y); a[3] = bf_hi(w.y); b[0] = bf_lo(w.z); b[1] = bf_hi(w.z); b[2] = bf_lo(w.w); b[3] = bf_hi(w.w); }
__device__ __forceinline__ float sigmoidf_(float v) { return __builtin_amdgcn_rcpf(1.0f + __builtin_amdgcn_exp2f(-1.4426950408889634f * v)); }

template <class Epi, class Sched, bool ALIGN_EPI = false, bool SP2 = false, bool GATHER = false, bool FP8 = false>
__device__ __forceinline__ void gemm_phase(PG8_LAS unsigned char* lds, const Gemm g, const Sched& S, const Epi& E, const int tid_in) {
    int tidl_ = tid_in; asm volatile("" : "+v"(tidl_));
    const int tid = tidl_, wid = __builtin_amdgcn_readfirstlane(tid >> 6), lane = tid & 63, wr = wid >> 2, wc = wid & 3, fr = lane & 15, fq = lane >> 4;
    int Kl_ = g.K; asm volatile("" : "+s"(Kl_));
    const int K = Kl_; const int KB = FP8 ? K : 2 * K; const int nt = KB / (2 * BK);
    unsigned voffA[2], voffB[2], stC2[2]; int stR[2];
#pragma unroll
    for (int i = 0; i < 2; ++i) { int R, C; stage_rc(tid * 16 + i * 8192, R, C); const int Rb = Epi::PERM ? ((R & ~31) + perm32(R & 31)) : R;
        voffA[i] = (unsigned)(R * KB + 2 * C); voffB[i] = (unsigned)(Rb * KB + 2 * C); stR[i] = R; stC2[i] = (unsigned)C * 2u; }
    const size_t kstep = (size_t)(BK * 2);
    const size_t hstep = (size_t)HALF * KB;
    const size_t tstep = 2 * hstep;
    const unsigned ldsw = (unsigned)wid * 1024u;
    const int aoff = lds_byte(wr * 64 + fr, fq * 8), boff = lds_byte(wc * 32 + fr, fq * 8);
#define PG8_SA(b, h) (((b) * 2 + (h)) * HTB)
#define PG8_SB(b, h) ((4 + (b) * 2 + (h)) * HTB)
#define PG8_STAGE(bufoff, gbase, voff) do { _Pragma("unroll") for (int _i = 0; _i < 2; ++_i) \
        __builtin_amdgcn_global_load_lds((const unsigned*)((const char*)(gbase) + (voff)[_i]), (PG8_LAS unsigned*)(lds + (bufoff) + ldsw + _i * 8192), 16, 0, 0); } while (0)
#define PG8_STAGE_A(bufoff, base, h, NX) do { if constexpr (GATHER) { unsigned _v[2]; _v[0] = (NX) ? gAn[h][0] : gAc[h][0]; _v[1] = (NX) ? gAn[h][1] : gAc[h][1]; PG8_STAGE(bufoff, base, _v); } \
        else { PG8_STAGE(bufoff, (base) + (h) * hstep, voffA); } } while (0)
#define PG8_LDA(dst, b, h) do { _Pragma("unroll") for (int m = 0; m < 4; ++m) _Pragma("unroll") for (int k = 0; k < 2; ++k) dst[m][k] = *(const PG8_LAS bf16x8*)(lds + PG8_SA(b, h) + aoff + m * 2048 + k * 1024); } while (0)
#define PG8_LDB(dst, b, h) do { _Pragma("unroll") for (int n = 0; n < 2; ++n) _Pragma("unroll") for (int k = 0; k < 2; ++k) dst[n][k] = *(const PG8_LAS bf16x8*)(lds + PG8_SB(b, h) + boff + n * 2048 + k * 1024); } while (0)
#define PG8_MMA(ai, bj, At, Bt) do { __builtin_amdgcn_s_setprio(1); _Pragma("unroll") for (int m = 0; m < 4; ++m) _Pragma("unroll") for (int n = 0; n < 2; ++n) _Pragma("unroll") for (int k = 0; k < 2; ++k) \
        acc[ai][bj][m][n] = __builtin_amdgcn_mfma_f32_16x16x32_bf16(Bt[n][k], At[m][k], acc[ai][bj][m][n], 0, 0, 0); __builtin_amdgcn_s_setprio(0); } while (0)
#define PG8_MMA8(ai, bj, At, Bt) do { __builtin_amdgcn_s_setprio(1); _Pragma("unroll") for (int m = 0; m < 4; ++m) _Pragma("unroll") for (int n = 0; n < 2; ++n) { \
        const v8i32 b8_ = __builtin_shufflevector(__builtin_bit_cast(v4i32, Bt[n][0]), __builtin_bit_cast(v4i32, Bt[n][1]), 0, 1, 2, 3, 4, 5, 6, 7); \
        const v8i32 a8_ = __builtin_shufflevector(__builtin_bit_cast(v4i32, At[m][0]), __builtin_bit_cast(v4i32, At[m][1]), 0, 1, 2, 3, 4, 5, 6, 7); \
        asm volatile("v_mfma_scale_f32_16x16x128_f8f6f4 %0, %1, %2, %0, %3, %3 op_sel_hi:[0,0,0]" : "+v"(acc[ai][bj][m][n]) : "v"(b8_), "v"(a8_), "v"(one8_)); } __builtin_amdgcn_s_setprio(0); } while (0)
#define PG8_MMAX(ai, bj, At, Bt) do { if constexpr (FP8) PG8_MMA8(ai, bj, At, Bt); else PG8_MMA(ai, bj, At, Bt); } while (0)
#define PG8_WAIT_V(n) asm volatile("s_waitcnt vmcnt(" #n ")" ::: "memory")
#define PG8_WAIT_L(n) asm volatile("s_waitcnt lgkmcnt(" #n ")" ::: "memory")
#define PG8_BAR __builtin_amdgcn_s_barrier()
#define PG8_SCHED __builtin_amdgcn_sched_barrier(0)
    const int one8_ = 0x7f7f7f7f;
    Unit cur, nxt; int ui = 0;
    if (!S.next(0, cur)) return;
    f32x4 acc[2][2][4][2];
#pragma unroll
    for (int a = 0; a < 2; ++a)
#pragma unroll
        for (int b = 0; b < 2; ++b)
#pragma unroll
            for (int m = 0; m < 4; ++m)
#pragma unroll
                for (int n = 0; n < 2; ++n) acc[a][b][m][n] = (f32x4){0.f, 0.f, 0.f, 0.f};
    bf16x8 At[4][2], B0[2][2], B1[2][2];
    const char* cA = GATHER ? (const char*)g.A : (const char*)g.A + (size_t)cur.pm * tstep; const char* cB = (const char*)g.Bt + cur.boff + (size_t)cur.pn * tstep;
    unsigned gAc[2][2], gAn[2][2];
    if constexpr (GATHER) { _Pragma("unroll") for (int h = 0; h < 2; ++h) _Pragma("unroll") for (int i = 0; i < 2; ++i) { gAc[h][i] = S.arow(0, h * HALF + stR[i]) + stC2[i]; gAn[h][i] = gAc[h][i]; } }
    S.a_ready(cur, wid, lane);
    if constexpr (SP2) {
        PG8_STAGE(PG8_SB(0, 0), cB, voffB); PG8_STAGE(PG8_SB(0, 1), cB + hstep, voffB); PG8_STAGE_A(PG8_SA(0, 0), cA, 0, false); PG8_STAGE_A(PG8_SA(0, 1), cA, 1, false);
        if (wr == 1) PG8_BAR;
        PG8_WAIT_V(2); PG8_BAR;
        PG8_STAGE(PG8_SB(1, 0), cB + kstep, voffB); PG8_STAGE_A(PG8_SA(1, 0), cA + kstep, 0, false); PG8_STAGE(PG8_SB(1, 1), cB + hstep + kstep, voffB);
        PG8_WAIT_V(6); PG8_BAR;
    } else {
        PG8_STAGE(PG8_SB(0, 0), cB, voffB); PG8_STAGE_A(PG8_SA(0, 0), cA, 0, false); PG8_STAGE(PG8_SB(0, 1), cB + hstep, voffB); PG8_STAGE_A(PG8_SA(0, 1), cA, 1, false);
        if (wr == 1) PG8_BAR;
        PG8_WAIT_V(4); PG8_BAR;
        PG8_STAGE(PG8_SB(1, 0), cB + kstep, voffB); PG8_STAGE_A(PG8_SA(1, 0), cA + kstep, 0, false); PG8_STAGE(PG8_SB(1, 1), cB + hstep + kstep, voffB);
        PG8_WAIT_V(6); PG8_BAR;
    }
    for (;;) {
        const bool has_next = S.next(ui + 1, nxt);
        const char* nA = GATHER ? cA : (has_next ? (const char*)g.A + (size_t)nxt.pm * tstep : cA); const char* nB = has_next ? (const char*)g.Bt + nxt.boff + (size_t)nxt.pn * tstep : cB;
        if constexpr (GATHER) { if (has_next) { _Pragma("unroll") for (int h = 0; h < 2; ++h) _Pragma("unroll") for (int i = 0; i < 2; ++i) gAn[h][i] = S.arow(ui + 1, h * HALF + stR[i]) + stC2[i]; } }
        for (int t = 0; t < nt; t += 2) {
            if constexpr (Epi::MID_HOOK) { if (t == (nt >> 1)) { asm volatile("s_nop 15\n\ts_nop 7" ::: "memory"); E.mid(acc, cur, ui, wr, wc, fr, fq); asm volatile("s_nop 7" ::: "memory"); } }
            const bool last = (t == nt - 2);
            const char* a1 = cA + (size_t)(t + 1) * kstep;
            const char* a2 = last ? nA : cA + (size_t)(t + 2) * kstep; const char* b2 = last ? nB : cB + (size_t)(t + 2) * kstep;
            const char* a3 = a2 + kstep; const char* b3 = b2 + kstep;
            if (last && has_next) S.a_ready(nxt, wid, lane);
            if constexpr (SP2) {
            PG8_LDB(B0, 0, 0); PG8_LDB(B1, 0, 1); PG8_SCHED; PG8_LDA(At, 0, 0); PG8_STAGE_A(PG8_SA(1, 1), a1, 1, false);
            PG8_WAIT_V(8); PG8_WAIT_L(0); PG8_BAR; PG8_MMAX(0, 0, At, B0); PG8_MMAX(0, 1, At, B1); PG8_BAR; PG8_SCHED;
            PG8_LDA(At, 0, 1); PG8_STAGE(PG8_SB(0, 0), b2, voffB); PG8_STAGE(PG8_SB(0, 1), b2 + hstep, voffB); PG8_STAGE_A(PG8_SA(0, 0), a2, 0, last);
            PG8_WAIT_V(8); PG8_WAIT_L(0); PG8_BAR; PG8_MMAX(1, 0, At, B0); PG8_MMAX(1, 1, At, B1); PG8_BAR; PG8_SCHED;
            PG8_LDB(B0, 1, 0); PG8_LDB(B1, 1, 1); PG8_SCHED; PG8_LDA(At, 1, 0); PG8_STAGE_A(PG8_SA(0, 1), a2, 1, last);
            PG8_WAIT_V(8); PG8_WAIT_L(0); PG8_BAR; PG8_MMAX(0, 0, At, B0); PG8_MMAX(0, 1, At, B1); PG8_BAR; PG8_SCHED;
            PG8_LDA(At, 1, 1); PG8_STAGE(PG8_SB(1, 0), b3, voffB); PG8_STAGE(PG8_SB(1, 1), b3 + hstep, voffB); PG8_STAGE_A(PG8_SA(1, 0), a3, 0, last);
            PG8_WAIT_V(8); PG8_WAIT_L(0); PG8_BAR; PG8_MMAX(1, 0, At, B0); PG8_MMAX(1, 1, At, B1); PG8_BAR; PG8_SCHED;
            } else {
            PG8_LDB(B0, 0, 0); PG8_SCHED; PG8_LDA(At, 0, 0); PG8_STAGE_A(PG8_SA(1, 1), a1, 1, false);
            PG8_WAIT_L(8); PG8_BAR; PG8_WAIT_L(0); PG8_MMAX(0, 0, At, B0); PG8_BAR; PG8_SCHED;
            PG8_LDB(B1, 0, 1); PG8_STAGE(PG8_SB(0, 0), b2, voffB);
            PG8_BAR; PG8_WAIT_L(0); PG8_MMAX(0, 1, At, B1); PG8_BAR;
            PG8_LDA(At, 0, 1); PG8_STAGE_A(PG8_SA(0, 0), a2, 0, last);
            PG8_BAR; PG8_WAIT_L(0); PG8_MMAX(1, 0, At, B0); PG8_BAR; PG8_SCHED;
            PG8_STAGE(PG8_SB(0, 1), b2 + hstep, voffB);
            PG8_WAIT_V(6); PG8_BAR; PG8_MMAX(1, 1, At, B1); PG8_BAR;
            PG8_LDB(B0, 1, 0); PG8_SCHED; PG8_LDA(At, 1, 0); PG8_STAGE_A(PG8_SA(0, 1), a2, 1, last);
            PG8_WAIT_L(8); PG8_BAR; PG8_WAIT_L(0); PG8_MMAX(0, 0, At, B0); PG8_BAR; PG8_SCHED;
            PG8_LDB(B1, 1, 1); PG8_STAGE(PG8_SB(1, 0), b3, voffB);
            PG8_BAR; PG8_WAIT_L(0); PG8_MMAX(0, 1, At, B1); PG8_BAR;
            PG8_LDA(At, 1, 1); PG8_STAGE_A(PG8_SA(1, 0), a3, 0, last);
            PG8_BAR; PG8_WAIT_L(0); PG8_MMAX(1, 0, At, B0); PG8_BAR; PG8_SCHED;
            PG8_STAGE(PG8_SB(1, 1), b3 + hstep, voffB);
            PG8_WAIT_V(6); PG8_BAR; PG8_MMAX(1, 1, At, B1); PG8_BAR;
            }
        }
        if constexpr (ALIGN_EPI) { if (wr == 0) PG8_BAR; }
        if constexpr (FP8) asm volatile("s_nop 15\n\ts_nop 7" ::: "memory");
        if constexpr (!Epi::AFTER_DRAIN) { E(acc, cur, ui, wr, wc, fr, fq); S.done(cur, wid, lane); }
        if (!has_next) break;
#pragma unroll
        for (int a = 0; a < 2; ++a)
#pragma unroll
            for (int b = 0; b < 2; ++b)
#pragma unroll
                for (int m = 0; m < 4; ++m)
#pragma unroll
                    for (int n = 0; n < 2; ++n) acc[a][b][m][n] = (f32x4){0.f, 0.f, 0.f, 0.f};
        cur = nxt; cA = nA; cB = nB; ++ui;
        if constexpr (GATHER) { _Pragma("unroll") for (int h = 0; h < 2; ++h) _Pragma("unroll") for (int i = 0; i < 2; ++i) gAc[h][i] = gAn[h][i]; }
        if constexpr (ALIGN_EPI) { if (wr == 1) PG8_BAR; }
    }
    PG8_WAIT_V(0);
    if constexpr (!ALIGN_EPI) { if (wr == 0) PG8_BAR; }
    PG8_BAR;
#undef PG8_SA
#undef PG8_SB
#undef PG8_STAGE
#undef PG8_STAGE_A
#undef PG8_LDA
#undef PG8_LDB
#undef PG8_MMA
#undef PG8_MMA8
#undef PG8_MMAX
#undef PG8_WAIT_V
#undef PG8_WAIT_L
#undef PG8_BAR
#undef PG8_SCHED
}


constexpr int BATCH = 8, SEQ = 4096, DMODEL = 1024, TOK = BATCH * SEQ;
constexpr int NHEAD = 8, HD = 64, AW = 512;
constexpr int IN_COLS = 5704, ZN = 5888;
constexpr int NEXP = 32, DEXP = 512, PLE = 256;
constexpr float RMS_EPS = 1e-6f;
constexpr float C2 = 0.125f * 1.4426950408889634f;
constexpr float IW_SCALE = 0.125f * 0.35355339059327373f;

template <int FP> struct EpiZ {
    static constexpr bool PERM = true, AFTER_DRAIN = false, MID_HOOK = false;
    bf16_t *QA, *KA, *VA, *QB, *KB, *VB, *IQ, *IK, *GA, *GB; float* IW; float* kmean; const float* ropec; const float* ropes;
    __device__ __forceinline__ void operator()(f32x4 (&acc)[2][2][4][2], const Unit& u, int, int wr, int wc, int fr, int fq) const {
        const int pn = u.pn;
        if (FP == 1 && pn >= 4 && pn < 12) {
            const int j = pn - 4;
#pragma unroll
            for (int ai = 0; ai < 2; ++ai)
#pragma unroll
                for (int m = 0; m < 4; ++m) { const int row = u.pm * BM + ai * HALF + wr * 64 + m * 16 + fr; const size_t off = (size_t)row * DMODEL + j * HALF + wc * 32 + 8 * fq;
                    f32x4 a0 = acc[ai][0][m][0] * (1.0f / 32.0f), a1 = acc[ai][0][m][1] * (1.0f / 32.0f), b0 = acc[ai][1][m][0] * (1.0f / 32.0f), b1 = acc[ai][1][m][1] * (1.0f / 32.0f);
#pragma unroll
                    for (int i = 0; i < 4; ++i) { a0[i] = sigmoidf_(a0[i]); a1[i] = sigmoidf_(a1[i]); b0[i] = sigmoidf_(b0[i]); b1[i] = sigmoidf_(b1[i]);
                        a0[i] *= __builtin_amdgcn_rcpf(fmaxf(b0[i], 1e-30f)); a1[i] *= __builtin_amdgcn_rcpf(fmaxf(b1[i], 1e-30f)); }
                    *(u32x4*)(GA + off) = pack8(a0, a1); *(u32x4*)(GB + off) = pack8(b0, b1); }
            return; }
        bf16_t* dst; int ld, colt; bool rope_t = false, isq = false, iskm = false, issig = false; const bool ikw = (FP == 0) && (pn == 2);
        if (FP == 0) {
            if (pn < 2) { colt = (pn & 1) * 256; ld = AW; rope_t = true; dst = QA + (size_t)6 * ((size_t)TOK * AW); }
            else { dst = IK; ld = 64; colt = 0; rope_t = true; }
        } else {
            const int h = pn >> 1; const int ti = (pn < 4) ? 2 + 3 * h : (pn < 16) ? h - 3 : h - 8;
            colt = (pn & 1) * 256; ld = AW; rope_t = (pn >= 4); isq = (h == 6) || (h == 8); iskm = (h == 9); dst = QA + (size_t)ti * ((size_t)TOK * AW);
        }
        constexpr float WS = (FP == 1) ? (1.0f / 32.0f) : 1.0f;
        const bool rope_w = rope_t && ((wc & 1) == 0);
        const float rs = (fq == 0) ? -1.f : 1.f; const bool rl = fq < 2;
        f32x4 cs[2][2];
#pragma unroll
        for (int bj = 0; bj < 2; ++bj)
#pragma unroll
            for (int n = 0; n < 2; ++n) cs[bj][n] = (f32x4){0.f, 0.f, 0.f, 0.f};
#pragma unroll
        for (int ai = 0; ai < 2; ++ai)
#pragma unroll
            for (int m = 0; m < 4; ++m) {
                const int row = u.pm * BM + ai * HALF + wr * 64 + m * 16 + fr; const int pos = row & (SEQ - 1);
                f32x4 c0 = (f32x4){1.f, 1.f, 1.f, 1.f}, c1 = c0, s0 = (f32x4){0.f, 0.f, 0.f, 0.f}, s1 = s0;
                if (rope_w) { const f32x4 a = *(const f32x4*)(ropec + pos * 8), b = *(const f32x4*)(ropec + pos * 8 + 4), c = *(const f32x4*)(ropes + pos * 8), d = *(const f32x4*)(ropes + pos * 8 + 4);
                    if (rl) { c0 = a; c1 = b; s0 = c * rs; s1 = d * rs; } }
#pragma unroll
                for (int bj = 0; bj < 2; ++bj) {
                    f32x4 v0 = acc[ai][bj][m][0] * WS, v1 = acc[ai][bj][m][1] * WS;
                    if (ikw && bj == 1) continue;
                    if (rope_w && !(ikw && wc != 0)) {
                        f32x4 o0, o1;
#pragma unroll
                        for (int i = 0; i < 4; ++i) { o0[i] = __shfl_xor(v0[i], 16); o1[i] = __shfl_xor(v1[i], 16); }
                        v0 = v0 * c0 + o0 * s0; v1 = v1 * c1 + o1 * s1;
                    }
                    if (isq) { v0 = v0 * C2; v1 = v1 * C2; }
                    if (FP == 0 && iskm) { cs[bj][0] += v0; cs[bj][1] += v1; }
                    if (issig) {
#pragma unroll
                        for (int i = 0; i < 4; ++i) { v0[i] = sigmoidf_(v0[i]); v1[i] = sigmoidf_(v1[i]); } }
                    const int col = bj * HALF + wc * 32 + 8 * fq;
                    if (ikw) {
                        if (wc < 2) *(u32x4*)(dst + (size_t)row * 64 + col) = pack8(v0, v1);
                        else if (wc == 2 && fq == 0) { *(f32x4*)(IW + (size_t)row * 8) = v0 * IW_SCALE; *(f32x4*)(IW + (size_t)row * 8 + 4) = v1 * IW_SCALE; }
                    } else *(u32x4*)(dst + (size_t)row * ld + colt + col) = pack8(v0, v1);
                }
            }
        if (FP == 1 && iskm) {
            __builtin_amdgcn_sched_barrier(0);
            const int b = u.pm >> 4, blk = u.pm & 15;
#pragma unroll
            for (int bj = 0; bj < 2; ++bj)
#pragma unroll
                for (int n = 0; n < 2; ++n) { f32x4 c4 = (f32x4){0.f, 0.f, 0.f, 0.f};
#pragma unroll
                    for (int ai = 0; ai < 2; ++ai)
#pragma unroll
                        for (int m = 0; m < 4; ++m) { const int row = u.pm * BM + ai * HALF + wr * 64 + m * 16 + fr; const int pos = row & (SEQ - 1);
                            f32x4 v = acc[ai][bj][m][n] * WS;
                            if (rope_w) { f32x4 cc = (f32x4){1.f, 1.f, 1.f, 1.f}, ss = (f32x4){0.f, 0.f, 0.f, 0.f};
                                const f32x4 a = *(const f32x4*)(ropec + pos * 8 + 4 * n), c = *(const f32x4*)(ropes + pos * 8 + 4 * n);
                                if (rl) { cc = a; ss = c * rs; }
                                f32x4 o;
#pragma unroll
                                for (int i = 0; i < 4; ++i) o[i] = __shfl_xor(v[i], 16);
                                v = v * cc + o * ss; }
                            c4 += v; }
#pragma unroll
                    for (int i = 0; i < 4; ++i) { float s = c4[i]; s += __shfl_xor(s, 1); s += __shfl_xor(s, 2); s += __shfl_xor(s, 4); s += __shfl_xor(s, 8);
                        if (fr == 0) { const int col = (pn & 1) * 256 + bj * HALF + wc * 32 + 8 * fq + 4 * n + i; const int h = col >> 6, d = col & 63;
                            atomicAdd(kmean + ((size_t)((b * NHEAD + h) * 16 + blk) * 64 + d), s * (1.0f / 256.0f)); } }
                    __builtin_amdgcn_sched_barrier(0); }
        }
        if (FP == 0 && iskm) {
            const int b = u.pm >> 4, blk = u.pm & 15;
#pragma unroll
            for (int bj = 0; bj < 2; ++bj)
#pragma unroll
                for (int n = 0; n < 2; ++n)
#pragma unroll
                    for (int i = 0; i < 4; ++i) { float s = cs[bj][n][i]; s += __shfl_xor(s, 1); s += __shfl_xor(s, 2); s += __shfl_xor(s, 4); s += __shfl_xor(s, 8);
                        if (fr == 0) { const int col = (pn & 1) * 256 + bj * HALF + wc * 32 + 8 * fq + 4 * n + i; const int h = col >> 6, d = col & 63;
                            atomicAdd(kmean + ((size_t)((b * NHEAD + h) * 16 + blk) * 64 + d), s * (1.0f / 256.0f)); } }
        }
    }
};
struct EpiStoreBf16 {
    static constexpr bool PERM = true, AFTER_DRAIN = false, MID_HOOK = false;
    bf16_t* O; int ld;
    __device__ __forceinline__ void operator()(f32x4 (&acc)[2][2][4][2], const Unit& u, int, int wr, int wc, int fr, int fq) const {
#pragma unroll
        for (int ai = 0; ai < 2; ++ai)
#pragma unroll
            for (int m = 0; m < 4; ++m) { const int row = u.pm * BM + ai * HALF + wr * 64 + m * 16 + fr;
#pragma unroll
                for (int bj = 0; bj < 2; ++bj) { const int col = u.pn * BM + bj * HALF + wc * 32 + 8 * fq;
                    *(u32x4*)(O + (size_t)row * ld + col) = pack8(acc[ai][bj][m][0], acc[ai][bj][m][1]); } }
    }
};
template <int MODE> struct EpiBranch {
    static constexpr bool PERM = true, AFTER_DRAIN = false, MID_HOOK = false;
    const bf16_t* G; const bf16_t* Tin; void* O;
    __device__ __forceinline__ void operator()(f32x4 (&acc)[2][2][4][2], const Unit& u, int, int wr, int wc, int fr, int fq) const {
        constexpr float WS = 1.0f / 512.0f;
#pragma unroll
        for (int ai = 0; ai < 2; ++ai)
#pragma unroll
            for (int m = 0; m < 4; ++m) { const int row = u.pm * BM + ai * HALF + wr * 64 + m * 16 + fr;
#pragma unroll
                for (int bj = 0; bj < 2; ++bj) { const size_t off = (size_t)row * DMODEL + u.pn * BM + bj * HALF + wc * 32 + 8 * fq;
                    f32x4 g0, g1; unpack8(*(const u32x4*)(G + off), g0, g1);
                    f32x4 v0 = acc[ai][bj][m][0] * WS * g0, v1 = acc[ai][bj][m][1] * WS * g1;
                    if (MODE == 1) { f32x4 t0, t1; unpack8(*(const u32x4*)(Tin + off), t0, t1); v0 += t0; v1 += t1; *(u32x2*)((unsigned char*)O + off) = pack8_fp8(v0 * 8.0f, v1 * 8.0f); }
                    else *(u32x4*)((bf16_t*)O + off) = pack8(v0, v1); } }
    }
};
__device__ __forceinline__ u32x4 widen16(const u32x2 a, const u32x2 b) {
    const auto rx = __builtin_amdgcn_permlane16_swap(a.x, b.x, false, false); const auto ry = __builtin_amdgcn_permlane16_swap(a.y, b.y, false, false);
    return (u32x4){(unsigned)rx[0], (unsigned)ry[0], (unsigned)rx[1], (unsigned)ry[1]}; }
struct EpiMerged {
    static constexpr bool PERM = true, AFTER_DRAIN = false, MID_HOOK = true;
    const bf16_t* GA; const bf16_t* GB; unsigned char* O;
    __device__ __forceinline__ void mid(f32x4 (&acc)[2][2][4][2], const Unit& u, int, int wr, int wc, int fr_in, int fq_in) const {
        int fr = fr_in, fq = fq_in; asm volatile("" : "+v"(fr), "+v"(fq));
#pragma unroll
        for (int ai = 0; ai < 2; ++ai) { u32x4 ga_[4][2];
#pragma unroll
            for (int m = 0; m < 4; ++m)
#pragma unroll
                for (int bj = 0; bj < 2; ++bj) ga_[m][bj] = *(const u32x4*)(GA + (size_t)(u.pm * BM + ai * HALF + wr * 64 + m * 16 + fr) * DMODEL + u.pn * BM + bj * HALF + wc * 32 + 8 * fq);
#pragma unroll
            for (int m = 0; m < 4; ++m)
#pragma unroll
                for (int bj = 0; bj < 2; ++bj) { f32x4 a0, a1; unpack8(ga_[m][bj], a0, a1); acc[ai][bj][m][0] *= a0; acc[ai][bj][m][1] *= a1; }
            asm volatile("" ::: "memory"); }
    }
    __device__ __forceinline__ void operator()(f32x4 (&acc)[2][2][4][2], const Unit& u, int, int wr, int wc, int fr, int fq) const {
        constexpr float WS = 8.0f / 512.0f;
        const int odd = fq & 1;
#pragma unroll
        for (int ai = 0; ai < 2; ++ai) { u32x4 gv[4][2];
#pragma unroll
            for (int m = 0; m < 4; ++m)
#pragma unroll
                for (int bj = 0; bj < 2; ++bj) gv[m][bj] = *(const u32x4*)(GB + (size_t)(u.pm * BM + ai * HALF + wr * 64 + m * 16 + fr) * DMODEL + u.pn * BM + bj * HALF + wc * 32 + 8 * fq);
#pragma unroll
            for (int mp = 0; mp < 2; ++mp) { const int row = u.pm * BM + ai * HALF + wr * 64 + (2 * mp + odd) * 16 + fr;
#pragma unroll
                for (int bj = 0; bj < 2; ++bj) {
                    f32x4 g0, g1, h0, h1; unpack8(gv[2 * mp][bj], g0, g1); unpack8(gv[2 * mp + 1][bj], h0, h1);
                    const u32x4 v = widen16(pack8_fp8(acc[ai][bj][2 * mp][0] * WS * g0, acc[ai][bj][2 * mp][1] * WS * g1), pack8_fp8(acc[ai][bj][2 * mp + 1][0] * WS * h0, acc[ai][bj][2 * mp + 1][1] * WS * h1));
                    *(u32x4*)(O + (size_t)row * DMODEL + u.pn * BM + bj * HALF + wc * 32 + 8 * (fq - odd)) = v; } }
            asm volatile("" ::: "memory"); }
    }
};
struct EpiResidualB {
    static constexpr bool PERM = true, AFTER_DRAIN = false, MID_HOOK = false;
    const bf16_t* h1; const float* rstd; const float* g; bf16_t* o;
    __device__ __forceinline__ void operator()(f32x4 (&acc)[2][2][4][2], const Unit& u, int, int wr, int wc, int fr, int fq) const {
        f32x4 gi[2][2];
#pragma unroll
        for (int bj = 0; bj < 2; ++bj)
#pragma unroll
            for (int n = 0; n < 2; ++n) { const f32x4 gg = *(const f32x4*)(g + u.pn * BM + bj * HALF + wc * 32 + 8 * fq + 4 * n);
#pragma unroll
                for (int i = 0; i < 4; ++i) gi[bj][n][i] = (gg[i] != 0.f) ? 1.0f / gg[i] : 0.f; }
#pragma unroll
        for (int ai = 0; ai < 2; ++ai) { u32x4 hv[4][2]; float rs[4];
#pragma unroll
            for (int m = 0; m < 4; ++m) { const int row = u.pm * BM + ai * HALF + wr * 64 + m * 16 + fr; rs[m] = rstd[row];
#pragma unroll
                for (int bj = 0; bj < 2; ++bj) hv[m][bj] = *(const u32x4*)(h1 + (size_t)row * DMODEL + u.pn * BM + bj * HALF + wc * 32 + 8 * fq); }
#pragma unroll
            for (int m = 0; m < 4; ++m) { const int row = u.pm * BM + ai * HALF + wr * 64 + m * 16 + fr; const float rsv = rs[m];
#pragma unroll
                for (int bj = 0; bj < 2; ++bj) { const size_t off = (size_t)row * DMODEL + u.pn * BM + bj * HALF + wc * 32 + 8 * fq;
                    f32x4 h0, h1v; unpack8(hv[m][bj], h0, h1v);
                    *(u32x4*)(o + off) = pack8(h0 * rsv * gi[bj][0] + acc[ai][bj][m][0] * (1.0f / 256.0f), h1v * rsv * gi[bj][1] + acc[ai][bj][m][1] * (1.0f / 256.0f)); } }
            asm volatile("" ::: "memory"); }
    }
};
struct EpiResidual {
    static constexpr bool PERM = false, AFTER_DRAIN = false, MID_HOOK = false;
    const float* base; float* out;
    __device__ __forceinline__ void operator()(f32x4 (&acc)[2][2][4][2], const Unit& u, int, int wr, int wc, int fr, int fq) const {
#pragma unroll
        for (int ai = 0; ai < 2; ++ai)
#pragma unroll
            for (int m = 0; m < 4; ++m) { const int row = u.pm * BM + ai * HALF + wr * 64 + m * 16 + fr;
#pragma unroll
                for (int bj = 0; bj < 2; ++bj)
#pragma unroll
                    for (int n = 0; n < 2; ++n) { const size_t off = (size_t)row * DMODEL + u.pn * BM + bj * HALF + wc * 32 + 16 * n + 4 * fq;
                        *(f32x4*)(out + off) = *(const f32x4*)(base + off) + acc[ai][bj][m][n] * (1.0f / 256.0f); } }
    }
};
struct EpiPle {
    static constexpr bool PERM = false, AFTER_DRAIN = false, MID_HOOK = false;
    float* x; const bf16_t* P; float* stats;
    __device__ __forceinline__ void operator()(f32x4 (&acc)[2][2][4][2], const Unit& u, int, int wr, int wc, int fr, int fq) const {
#pragma unroll
        for (int ai = 0; ai < 2; ++ai)
#pragma unroll
            for (int m = 0; m < 4; ++m) { const int row = u.pm * BM + ai * HALF + wr * 64 + m * 16 + fr; float ss = 0.f;
#pragma unroll
                for (int bj = 0; bj < 2; ++bj)
#pragma unroll
                    for (int n = 0; n < 2; ++n) { const size_t off = (size_t)row * DMODEL + u.pn * BM + bj * HALF + wc * 32 + 16 * n + 4 * fq;
                        const u32x2 pw = *(const u32x2*)(P + off); const f32x4 pv = (f32x4){bf_lo(pw.x), bf_hi(pw.x), bf_lo(pw.y), bf_hi(pw.y)};
                        f32x4 g = acc[ai][bj][m][n] * (1.0f / 32.0f);
#pragma unroll
                        for (int i = 0; i < 4; ++i) g[i] = sigmoidf_(g[i]);
                        const f32x4 o = *(const f32x4*)(x + off) + g * pv; *(f32x4*)(x + off) = o;
                        ss += (o[0] * o[0] + o[1] * o[1]) + (o[2] * o[2] + o[3] * o[3]); }
                ss += __shfl_xor(ss, 16); ss += __shfl_xor(ss, 32);
                if (fq == 0) stats[(size_t)row * 16 + u.pn * 4 + wc] = ss; }
    }
};
struct EpiPleFin {
    static constexpr bool PERM = true, AFTER_DRAIN = false, MID_HOOK = false;
    float* x; const bf16_t* X1; const bf16_t* P; float* stats; unsigned* cnt; const float* gfin;
    __device__ __forceinline__ void operator()(f32x4 (&acc)[2][2][4][2], const Unit& u, int, int wr, int wc, int fr, int fq) const {
#pragma unroll
        for (int ai = 0; ai < 2; ++ai)
#pragma unroll
            for (int m = 0; m < 4; ++m) { const int row = u.pm * BM + ai * HALF + wr * 64 + m * 16 + fr; float ss = 0.f;
#pragma unroll
                for (int bj = 0; bj < 2; ++bj) { const int col = u.pn * BM + bj * HALF + wc * 32 + 8 * fq; const size_t off = (size_t)row * DMODEL + col;
                    f32x4 p0, p1; unpack8(*(const u32x4*)(P + off), p0, p1);
                    f32x4 x0, x1v; unpack8(*(const u32x4*)(X1 + off), x0, x1v);
                    f32x4 g0 = acc[ai][bj][m][0] * (1.0f / 32.0f), g1 = acc[ai][bj][m][1] * (1.0f / 32.0f);
#pragma unroll
                    for (int i = 0; i < 4; ++i) { g0[i] = sigmoidf_(g0[i]); g1[i] = sigmoidf_(g1[i]); }
                    const f32x4 o0 = x0 + g0 * p0, o1 = x1v + g1 * p1; acc[ai][bj][m][0] = o0; acc[ai][bj][m][1] = o1;
                    ss += ((o0[0] * o0[0] + o0[1] * o0[1]) + (o0[2] * o0[2] + o0[3] * o0[3])) + ((o1[0] * o1[0] + o1[1] * o1[1]) + (o1[2] * o1[2] + o1[3] * o1[3])); }
                ss += __shfl_xor(ss, 16); ss += __shfl_xor(ss, 32);
                if (fq == 0) __hip_atomic_store(stats + (size_t)row * 16 + u.pn * 4 + wc, ss, __ATOMIC_RELAXED, __HIP_MEMORY_SCOPE_AGENT); }
        unsigned* const c = cnt + 16 * u.pm;
        asm volatile("s_waitcnt vmcnt(0)" ::: "memory");
        if (fr == 0 && fq == 0) { (void)__hip_atomic_fetch_add(c, 1u, __ATOMIC_RELAXED, __HIP_MEMORY_SCOPE_AGENT);
            unsigned sp = 0; while (__hip_atomic_load(c, __ATOMIC_RELAXED, __HIP_MEMORY_SCOPE_AGENT) < 32u) { __builtin_amdgcn_s_sleep(1); if (++sp > (1u << 24)) break; } }
        asm volatile("" ::: "memory");
        f32x4 t4[2][4];
#pragma unroll
        for (int ai = 0; ai < 2; ++ai)
#pragma unroll
            for (int m = 0; m < 4; ++m) { const int row = u.pm * BM + ai * HALF + wr * 64 + m * 16 + fr; const float* sp_ = stats + (size_t)row * 16 + 4 * fq;
                asm volatile("global_load_dwordx4 %0, %1, off sc1" : "=v"(t4[ai][m]) : "v"(sp_) : "memory"); }
        asm volatile("s_waitcnt vmcnt(0)" : "+v"(t4[0][0]), "+v"(t4[0][1]), "+v"(t4[0][2]), "+v"(t4[0][3]), "+v"(t4[1][0]), "+v"(t4[1][1]), "+v"(t4[1][2]), "+v"(t4[1][3]) :: "memory");
#pragma unroll
        for (int ai = 0; ai < 2; ++ai)
#pragma unroll
            for (int m = 0; m < 4; ++m) { const int row = u.pm * BM + ai * HALF + wr * 64 + m * 16 + fr;
                float s = (t4[ai][m][0] + t4[ai][m][1]) + (t4[ai][m][2] + t4[ai][m][3]); s += __shfl_xor(s, 16); s += __shfl_xor(s, 32);
                const float rinv = 1.0f / sqrtf(s * (1.f / DMODEL) + RMS_EPS);
#pragma unroll
                for (int bj = 0; bj < 2; ++bj) { const int col = u.pn * BM + bj * HALF + wc * 32 + 8 * fq;
                    *(f32x4*)(x + (size_t)row * DMODEL + col) = acc[ai][bj][m][0] * rinv * *(const f32x4*)(gfin + col);
                    *(f32x4*)(x + (size_t)row * DMODEL + col + 4) = acc[ai][bj][m][1] * rinv * *(const f32x4*)(gfin + col + 4); } }
    }
};
struct EpiSwiglu {
    static constexpr bool PERM = true, AFTER_DRAIN = false, MID_HOOK = false;
    unsigned char* HID;
    __device__ __forceinline__ void operator()(f32x4 (&acc)[2][2][4][2], const Unit& u, int, int wr, int wc, int fr, int fq) const {
        constexpr float WS = 1.0f / 32.0f;
#pragma unroll
        for (int ai = 0; ai < 2; ++ai)
#pragma unroll
            for (int m = 0; m < 4; ++m) { const int row = u.pm * BM + ai * HALF + wr * 64 + m * 16 + fr;
                f32x4 h0, h1;
#pragma unroll
                for (int i = 0; i < 4; ++i) { const float g0 = acc[ai][0][m][0][i] * WS, g1 = acc[ai][0][m][1][i] * WS;
                    h0[i] = g0 * sigmoidf_(g0) * (acc[ai][1][m][0][i] * WS); h1[i] = g1 * sigmoidf_(g1) * (acc[ai][1][m][1][i] * WS); }
                { const u32x2 hv = pack8_fp8(h0, h1);
                  __hip_atomic_store((unsigned long long*)(HID + (size_t)row * DEXP + u.pn * HALF + wc * 32 + 8 * fq), (unsigned long long)hv.x | ((unsigned long long)hv.y << 32), __ATOMIC_RELAXED, __HIP_MEMORY_SCOPE_AGENT); } }
    }
};
struct EpiDown {
    static constexpr bool PERM = true, AFTER_DRAIN = false, MID_HOOK = false;
    unsigned char* Y; const PG8_LAS int* tokk; const PG8_LAS float* wt;
    __device__ __forceinline__ void operator()(f32x4 (&acc)[2][2][4][2], const Unit& u, int ui, int wr, int wc, int fr, int fq) const {
        const int odd = fq & 1;
#pragma unroll
        for (int ai = 0; ai < 2; ++ai)
#pragma unroll
            for (int mp = 0; mp < 2; ++mp) { const int r0 = ai * HALF + wr * 64 + (2 * mp) * 16 + fr, r1 = r0 + 16;
                const int tk0 = tokk[ui * 256 + r0], tk1 = tokk[ui * 256 + r1]; const float w0 = wt[ui * 256 + r0] * 2.0f, w1 = wt[ui * 256 + r1] * 2.0f;
                const int tk = odd ? tk1 : tk0;
#pragma unroll
                for (int bj = 0; bj < 2; ++bj) {
                    const u32x4 v = widen16(pack8_fp8(acc[ai][bj][2 * mp][0] * w0, acc[ai][bj][2 * mp][1] * w0), pack8_fp8(acc[ai][bj][2 * mp + 1][0] * w1, acc[ai][bj][2 * mp + 1][1] * w1));
                    *(u32x4*)(Y + (size_t)tk * DMODEL + u.pn * BM + bj * HALF + wc * 32 + 8 * (fq - odd)) = v; } }
    }
};
}

namespace att {
using bf16x8 = __attribute__((ext_vector_type(8))) short;
using s16x4 = __attribute__((ext_vector_type(4))) short;
using f32x16 = __attribute__((ext_vector_type(16))) float;
using u32x4 = __attribute__((ext_vector_type(4))) unsigned;
using u32x2 = __attribute__((ext_vector_type(2))) unsigned;
typedef unsigned short bf16r;
constexpr int SEQL = 4096, D = 64, DM = 512;
constexpr int NW = 8, QBLK = 32, QB = QBLK * NW, KVBLK = 64;
constexpr int SLOTB = 8192, NSLOT = 2;
constexpr int LDS_K = 0, LDS_V = NSLOT * SLOTB, LDS_WS = 2 * NSLOT * SLOTB, LDS_OST = LDS_WS + NW * 64 * 4, LDS_KM = LDS_OST + NW * 4096, LDS_BYTES = LDS_KM + 16 * 64 * 4;
constexpr float THR = 8.0f;
__device__ __forceinline__ int crow(int r, int hi) { return (r & 3) + 8 * (r >> 2) + 4 * hi; }
__device__ __forceinline__ void glds16(const void* gsrc, unsigned lds_dst) { unsigned keep;
    asm volatile("s_mov_b32 %0, m0\n\ts_mov_b32 m0, %2\n\ts_nop 0\n\tglobal_load_lds_dwordx4 %1, off\n\ts_mov_b32 m0, %0" : "=&s"(keep) : "v"(gsrc), "s"(lds_dst) : "memory"); }
typedef float f32x2_t __attribute__((ext_vector_type(2))); typedef __bf16 bf16x2_t __attribute__((ext_vector_type(2)));
__device__ __forceinline__ unsigned cvtpk_s(float lo, float hi) { f32x2_t v = {lo, hi}; bf16x2_t b = __builtin_convertvector(v, bf16x2_t); return __builtin_bit_cast(unsigned, b); }
__device__ __forceinline__ void qkt(f32x16& p0, f32x16& p1, const char* Kslot, const bf16x8* qr, const f32x16& cin, int r32, int hi) {
    const char* kb = Kslot + hi * 1024 + r32 * 16;
#pragma unroll
    for (int d0 = 0; d0 < 4; ++d0) {
        const bf16x8 b0 = *reinterpret_cast<const bf16x8*>(kb + d0 * 2048);
        const bf16x8 b1 = *reinterpret_cast<const bf16x8*>(kb + d0 * 2048 + 512);
        if (d0 == 0) { p0 = __builtin_amdgcn_mfma_f32_32x32x16_bf16(b0, qr[0], cin, 0, 0, 0); p1 = __builtin_amdgcn_mfma_f32_32x32x16_bf16(b1, qr[0], cin, 0, 0, 0); }
        else { p0 = __builtin_amdgcn_mfma_f32_32x32x16_bf16(b0, qr[d0], p0, 0, 0, 0); p1 = __builtin_amdgcn_mfma_f32_32x32x16_bf16(b1, qr[d0], p1, 0, 0, 0); } }
}
__device__ __forceinline__ float rowmax(const f32x16& p0, const f32x16& p1) {
    float a = __builtin_fmaxf(p0[0], p1[0]);
#pragma unroll
    for (int r = 1; r < 16; ++r) a = __builtin_fmaxf(a, __builtin_fmaxf(p0[r], p1[r]));
    auto rr = __builtin_amdgcn_permlane32_swap(__float_as_uint(a), __float_as_uint(a), false, false);
    return __builtin_fmaxf(__uint_as_float(rr[0]), __uint_as_float(rr[1]));
}
__device__ __forceinline__ void pv(f32x16* o, int vb, bf16x8 pa0, bf16x8 pa1, bf16x8 pa2, bf16x8 pa3) {
#pragma unroll
    for (int d0 = 0; d0 < 2; ++d0) { s16x4 lo[4], hi[4];
#pragma unroll
        for (int ks = 0; ks < 4; ++ks) {
            asm volatile("ds_read_b64_tr_b16 %0,%1 offset:%c2" : "=&v"(lo[ks]) : "v"(vb), "i"(d0 * 4096 + ks * 1024) : "memory");
            asm volatile("ds_read_b64_tr_b16 %0,%1 offset:%c2" : "=&v"(hi[ks]) : "v"(vb), "i"(d0 * 4096 + ks * 1024 + 512) : "memory"); }
        asm volatile("s_waitcnt lgkmcnt(0)" ::: "memory"); __builtin_amdgcn_sched_barrier(0);
#define ATT_PK(k) (bf16x8){lo[k][0], lo[k][1], lo[k][2], lo[k][3], hi[k][0], hi[k][1], hi[k][2], hi[k][3]}
        o[d0] = __builtin_amdgcn_mfma_f32_32x32x16_bf16(pa0, ATT_PK(0), o[d0], 0, 0, 0);
        o[d0] = __builtin_amdgcn_mfma_f32_32x32x16_bf16(pa1, ATT_PK(1), o[d0], 0, 0, 0);
        o[d0] = __builtin_amdgcn_mfma_f32_32x32x16_bf16(pa2, ATT_PK(2), o[d0], 0, 0, 0);
        o[d0] = __builtin_amdgcn_mfma_f32_32x32x16_bf16(pa3, ATT_PK(3), o[d0], 0, 0, 0);
#undef ATT_PK
    }
}
__device__ __forceinline__ float max3a(float a, float b, float c) { float r; asm("v_max3_f32 %0, %1, %2, %3" : "=v"(r) : "v"(a), "v"(b), "v"(c)); return r; }
__device__ __forceinline__ float rowmax_a(const f32x16& p0, const f32x16& p1) {
    float a = max3a(p0[0], p0[1], p1[0]), b = max3a(p0[2], p0[3], p1[1]); a = max3a(a, p1[2], p1[3]);
#pragma unroll
    for (int r = 4; r < 16; r += 4) { a = max3a(a, p0[r], p0[r + 1]); b = max3a(b, p0[r + 2], p0[r + 3]); a = max3a(a, p1[r], p1[r + 1]); b = max3a(b, p1[r + 2], p1[r + 3]); }
    float m; asm("v_max_f32_e32 %0, %1, %2" : "=v"(m) : "v"(a), "v"(b));
    auto rr = __builtin_amdgcn_permlane32_swap(__float_as_uint(m), __float_as_uint(m), false, false);
    float o; asm("v_max_f32_e32 %0, %1, %2" : "=v"(o) : "v"(__uint_as_float(rr[0])), "v"(__uint_as_float(rr[1]))); return o;
}
#define ATT_WAIT_BAR0() asm volatile("s_waitcnt vmcnt(0) lgkmcnt(0)\n\ts_barrier" ::: "memory")

template <int MODE> __device__ __forceinline__ void attn_unit(int b, int h, int qb, const bf16r* Q, const bf16r* __restrict__ K, const bf16r* __restrict__ V, bf16r* O, const void* aux, char* shm, const int tid_in) {
    int tidl_ = tid_in; asm volatile("" : "+v"(tidl_));
    const int tid = tidl_, lane = tid & 63, r32 = lane & 31, hi = lane >> 5; const int wid = __builtin_amdgcn_readfirstlane(tid >> 6);
    const long rowbase = (long)b * SEQL; const int q0 = qb * QB;
    const bf16r* Qw = Q + (rowbase + q0 + wid * QBLK) * DM + h * D;
    const bf16r* Kh = K + rowbase * DM + h * D, *Vh = V + rowbase * DM + h * D;
    const unsigned lds0 = (unsigned)(uintptr_t)shm;
    float* wsf = (float*)(shm + LDS_WS) + wid * 64;
    const bf16r* ksrc = Kh + (long)lane * DM + wid * 8;
    const bf16r* vsrc = Vh + (long)(16 * (wid & 3) + (lane >> 2)) * DM + (wid >> 2) * 32 + (lane & 3) * 8;
    const unsigned kdst = lds0 + LDS_K + wid * 1024, vdst = lds0 + LDS_V + wid * 1024;
#define DMA_K(t, slot) glds16(ksrc + (long)(t) * KVBLK * DM, (unsigned)__builtin_amdgcn_readfirstlane(kdst + (slot)))
#define DMA_V(t, slot) glds16(vsrc + (long)(t) * KVBLK * DM, (unsigned)__builtin_amdgcn_readfirstlane(vdst + (slot)))
    const int vb0 = (int)(lds0 + LDS_V) + ((lane >> 4) & 1) * 32 + (lane & 3) * 8 + (4 * hi + ((lane & 15) >> 2)) * 64;
    const char* Kbase = shm + LDS_K;
    const int NT = (q0 + QB) / KVBLK;
    DMA_K(0, 0); DMA_V(0, 0);
    bf16x8 qr[4];
#pragma unroll
    for (int d0 = 0; d0 < 4; ++d0) qr[d0] = *reinterpret_cast<const bf16x8*>(&Qw[(long)r32 * DM + d0 * 16 + hi * 8]);
    unsigned selmask = 0u;
    if (MODE == 0) {
        float* km = (float*)(shm + LDS_KM); const float* kmg = (const float*)aux + (size_t)(b * 8 + h) * 16 * 64;
        for (int i = tid; i < 16 * 64; i += NW * 64) km[i] = kmg[i];
        asm volatile("s_waitcnt vmcnt(0) lgkmcnt(0)" ::: "memory"); __syncthreads();
        float g[15];
#pragma unroll
        for (int j = 0; j < 15; ++j) { g[j] = -INFINITY;
            if (j < qb) { float s = 0.f;
#pragma unroll
                for (int d0 = 0; d0 < 4; ++d0)
#pragma unroll
                    for (int e = 0; e < 8; ++e) s += __uint_as_float(((unsigned)(unsigned short)qr[d0][e]) << 16) * km[j * 64 + d0 * 16 + hi * 8 + e];
                auto rr = __builtin_amdgcn_permlane32_swap(__float_as_uint(s), __float_as_uint(s), false, false);
                g[j] = __uint_as_float(rr[0]) + __uint_as_float(rr[1]); } }
#pragma unroll
        for (int k = 0; k < 3; ++k) { float best = -INFINITY; int bi = -1;
#pragma unroll
            for (int j = 0; j < 15; ++j) if (j < qb && !((selmask >> j) & 1u) && g[j] > best) { best = g[j]; bi = j; }
            if (bi >= 0) selmask |= 1u << bi; }
    }
    const unsigned* mrow = nullptr;
    if (MODE == 1) mrow = (const unsigned*)aux + (size_t)(rowbase + q0 + wid * QBLK + r32) * 128;
    float mhat = 0.f, l_reg = 0.f; f32x16 o[2]; o[0] = f32x16{}; o[1] = f32x16{};
    f32x16 negm = f32x16{};
    const int qrel = wid * QBLK + r32;
    for (int t = 0; t < NT; ++t) {
        ATT_WAIT_BAR0();
        if (t + 1 < NT) { DMA_K(t + 1, ((t + 1) & 1) * SLOTB); DMA_V(t + 1, ((t + 1) & 1) * SLOTB); }
        u32x2 mw = (u32x2){0u, 0u};
        if (MODE == 1) mw = *(const u32x2*)(mrow + 2 * t);
        f32x16 p0, p1;
        if (MODE == 0 && t < NT - 4) {
            const bool selq = (selmask >> (t >> 2)) & 1u; f32x16 cin;
#pragma unroll
            for (int r = 0; r < 16; ++r) cin[r] = selq ? negm[r] : -1e30f;
            qkt(p0, p1, Kbase + (t & 1) * SLOTB, qr, cin, r32, hi);
        } else qkt(p0, p1, Kbase + (t & 1) * SLOTB, qr, negm, r32, hi);
        if (MODE == 0) asm volatile("s_nop 15\n\ts_nop 7" : "+v"(p0), "+v"(p1));
        float rm;
        if (MODE == 0) { const int jb = t - (NT - 4);
            if (jb >= 0) { const int kb = 64 * jb + 4 * hi;
#pragma unroll
                for (int r = 0; r < 16; ++r) { const int kv = kb + (r & 3) + 8 * (r >> 2); if (kv > qrel) p0[r] = -INFINITY; if (kv + 32 > qrel) p1[r] = -INFINITY; } }
            rm = rowmax_a(p0, p1); }
        else { const int w0 = (int)(mw.x >> (4 * hi)), w1 = (int)(mw.y >> (4 * hi));
#pragma unroll
            for (int r = 0; r < 16; ++r) { const int bit = (r & 3) + 8 * (r >> 2);
                const unsigned m0 = (unsigned)((w0 << (31 - bit)) >> 31), m1 = (unsigned)((w1 << (31 - bit)) >> 31);
                p0[r] = __uint_as_float((__float_as_uint(p0[r]) & m0) | (0xff800000u & ~m0)); p1[r] = __uint_as_float((__float_as_uint(p1[r]) & m1) | (0xff800000u & ~m1)); }
            rm = rowmax_a(p0, p1); }
        if (__any(rm > THR)) {
            const float dl = __builtin_fmaxf(rm, 0.f); mhat += dl;
#pragma unroll
            for (int r = 0; r < 16; ++r) negm[r] = -mhat;
#pragma unroll
            for (int r = 0; r < 16; ++r) { p0[r] -= dl; p1[r] -= dl; }
            const float f = __builtin_amdgcn_exp2f(-dl); l_reg *= f; if (hi == 0) wsf[r32] = f;
            asm volatile("s_waitcnt lgkmcnt(0)" ::: "memory");
#pragma unroll
            for (int d_ = 0; d_ < 2; ++d_)
#pragma unroll
                for (int r = 0; r < 16; ++r) o[d_][r] *= wsf[crow(r, hi)];
        }
        float sacc = 0.f;
#pragma unroll
        for (int r = 0; r < 16; ++r) { p0[r] = __builtin_amdgcn_exp2f(p0[r]); p1[r] = __builtin_amdgcn_exp2f(p1[r]); sacc += p0[r] + p1[r]; }
        l_reg += sacc;
        u32x4 pw0, pw1, pw2, pw3;
        pw0 = (u32x4){cvtpk_s(p0[0], p0[1]), cvtpk_s(p0[2], p0[3]), cvtpk_s(p0[4], p0[5]), cvtpk_s(p0[6], p0[7])};
        pw1 = (u32x4){cvtpk_s(p0[8], p0[9]), cvtpk_s(p0[10], p0[11]), cvtpk_s(p0[12], p0[13]), cvtpk_s(p0[14], p0[15])};
        pw2 = (u32x4){cvtpk_s(p1[0], p1[1]), cvtpk_s(p1[2], p1[3]), cvtpk_s(p1[4], p1[5]), cvtpk_s(p1[6], p1[7])};
        pw3 = (u32x4){cvtpk_s(p1[8], p1[9]), cvtpk_s(p1[10], p1[11]), cvtpk_s(p1[12], p1[13]), cvtpk_s(p1[14], p1[15])};
        __builtin_amdgcn_sched_barrier(0);
        pv(o, vb0 + (t & 1) * SLOTB, __builtin_bit_cast(bf16x8, pw0), __builtin_bit_cast(bf16x8, pw1), __builtin_bit_cast(bf16x8, pw2), __builtin_bit_cast(bf16x8, pw3));
    }
    { auto rr = __builtin_amdgcn_permlane32_swap(__float_as_uint(l_reg), __float_as_uint(l_reg), false, false); l_reg = __uint_as_float(rr[0]) + __uint_as_float(rr[1]); }
    if (hi == 0) wsf[32 + r32] = l_reg; asm volatile("s_waitcnt lgkmcnt(0)" ::: "memory");
    float rli[16];
#pragma unroll
    for (int r = 0; r < 16; ++r) rli[r] = __builtin_amdgcn_rcpf(wsf[32 + crow(r, hi)]);
    unsigned char* Ow = (unsigned char*)O + (rowbase + q0 + wid * QBLK) * DM + h * D;
    { unsigned char* stg = (unsigned char*)(shm + LDS_OST) + wid * 2048;
#pragma unroll
        for (int r = 0; r < 16; ++r) { const int orow = crow(r, hi);
            const float sc16 = rli[r] * 16.0f; const int pk = __builtin_amdgcn_cvt_pk_fp8_f32(o[0][r] * sc16, o[1][r] * sc16, 0, false);
            stg[orow * 64 + r32] = (unsigned char)(pk & 0xff); stg[orow * 64 + 32 + r32] = (unsigned char)((pk >> 8) & 0xff); }
        asm volatile("s_waitcnt lgkmcnt(0)" ::: "memory");
#pragma unroll
        for (int i = 0; i < 2; ++i) { const int row = i * 16 + (lane >> 2), ch = lane & 3; const u32x4 v = *(const u32x4*)(stg + row * 64 + ch * 16); *(u32x4*)(Ow + (long)row * DM + ch * 16) = v; } }
    asm volatile("s_waitcnt vmcnt(0) lgkmcnt(0)\n\ts_barrier" ::: "memory");
#undef DMA_K
#undef DMA_V
}
}

namespace att2 {
using bf16=unsigned short;
using u32x2=__attribute__((ext_vector_type(2)))unsigned;
using bf16x8=__attribute__((ext_vector_type(8)))short;
using s16x4=__attribute__((ext_vector_type(4)))short;
using f32x16=__attribute__((ext_vector_type(16)))float;
using u32x4=__attribute__((ext_vector_type(4)))unsigned;
constexpr int BATCH=8,NHEAD=8,SEQ=4096,D=64,DM=NHEAD*D;
constexpr int NW=8,QBLK=32,QB=QBLK*NW,KVBLK=64,NQB=SEQ/QB;
constexpr int ATTN_PITCH=DM, ATTN_UNIT_ROWS=QB;
__device__ __forceinline__ int crow(int r,int hi){return (r&3)+8*(r>>2)+4*hi;}
#define SBAR() __builtin_amdgcn_sched_barrier(0)
__device__ __forceinline__ void cmask(f32x16&p0,f32x16&p1,int jb,int qrel,int hi){
  const float NEG=-INFINITY; int kb=64*jb+4*hi;
  #pragma unroll
  for(int r=0;r<16;++r){int kv=kb+(r&3)+8*(r>>2); if(kv>qrel)p0[r]=NEG; if(kv+32>qrel)p1[r]=NEG;}
}

constexpr int NSLOT=3, SLOTB=8192;
constexpr int LDS_K=0, LDS_V=NSLOT*SLOTB, LDS_WS=2*NSLOT*SLOTB, LDS_OST=LDS_WS+NW*64*4, LDS_KM=LDS_OST+NW*2048, LDS_BYTES=LDS_KM+16*64*4;
__device__ __forceinline__ void glds16(const void*gsrc,unsigned lds_dst){unsigned keep;
  asm volatile("s_mov_b32 %0, m0\n\ts_mov_b32 m0, %2\n\ts_nop 0\n\tglobal_load_lds_dwordx4 %1, off\n\ts_mov_b32 m0, %0":"=&s"(keep):"v"(gsrc),"s"(lds_dst):"memory");}
__device__ __forceinline__ float max3f(float a,float b,float c){float r;asm("v_max3_f32 %0, %1, %2, %3":"=v"(r):"v"(a),"v"(b),"v"(c));return r;}
__device__ __forceinline__ float max2f(float a,float b){float r;asm("v_max_f32_e32 %0, %1, %2":"=v"(r):"v"(a),"v"(b));return r;}
__device__ __forceinline__ float fadd_s(float a,float b){float r;asm("v_add_f32_e32 %0, %1, %2":"=v"(r):"v"(a),"v"(b));return r;}
__device__ __forceinline__ float fsub_s(float a,float b){float r;asm("v_sub_f32_e32 %0, %1, %2":"=v"(r):"v"(a),"v"(b));return r;}
typedef float f32x2_t __attribute__((ext_vector_type(2))); typedef __bf16 bf16x2_t __attribute__((ext_vector_type(2)));
__device__ __forceinline__ unsigned cvtpk_s(float lo,float hi){f32x2_t v={lo,hi};bf16x2_t b=__builtin_convertvector(v,bf16x2_t);return __builtin_bit_cast(unsigned,b);}
#define WAIT_BAR(N) asm volatile("s_waitcnt vmcnt(" #N ") lgkmcnt(0)\n\ts_barrier":::"memory")

__device__ __forceinline__ void qkt(f32x16&p0,f32x16&p1,const char*Kslot,const bf16x8*qr,const f32x16&negm,int r32,int hi){
  const char*kb=Kslot+hi*1024+r32*16;
  #pragma unroll
  for(int d0=0;d0<4;++d0){
    const bf16x8 b0=*reinterpret_cast<const bf16x8*>(kb+d0*2048);
    const bf16x8 b1=*reinterpret_cast<const bf16x8*>(kb+d0*2048+512);
    if(d0==0){p0=__builtin_amdgcn_mfma_f32_32x32x16_bf16(b0,qr[0],negm,0,0,0);p1=__builtin_amdgcn_mfma_f32_32x32x16_bf16(b1,qr[0],negm,0,0,0);}
    else{p0=__builtin_amdgcn_mfma_f32_32x32x16_bf16(b0,qr[d0],p0,0,0,0);p1=__builtin_amdgcn_mfma_f32_32x32x16_bf16(b1,qr[d0],p1,0,0,0);}}
}
typedef __attribute__((address_space(3))) const char* lds_cptr;
typedef short v4i16_t __attribute__((ext_vector_type(4)));
__device__ __forceinline__ void kload8(bf16x8*kf,lds_cptr kp){
  kf[0]=*(const __attribute__((address_space(3))) bf16x8*)(kp);      kf[1]=*(const __attribute__((address_space(3))) bf16x8*)(kp+512);
  kf[2]=*(const __attribute__((address_space(3))) bf16x8*)(kp+2048); kf[3]=*(const __attribute__((address_space(3))) bf16x8*)(kp+2560);
  kf[4]=*(const __attribute__((address_space(3))) bf16x8*)(kp+4096); kf[5]=*(const __attribute__((address_space(3))) bf16x8*)(kp+4608);
  kf[6]=*(const __attribute__((address_space(3))) bf16x8*)(kp+6144); kf[7]=*(const __attribute__((address_space(3))) bf16x8*)(kp+6656);
}
__device__ __forceinline__ void kload2(bf16x8*kf,lds_cptr kp,int j){ kf[2*j]=*(const __attribute__((address_space(3))) bf16x8*)(kp+j*2048); kf[2*j+1]=*(const __attribute__((address_space(3))) bf16x8*)(kp+j*2048+512); }
__device__ __forceinline__ s16x4 vtr(lds_cptr p){ return __builtin_bit_cast(s16x4,__builtin_amdgcn_ds_read_tr16_b64_v4i16((__attribute__((address_space(3))) v4i16_t*)p)); }
__device__ __forceinline__ float rowmax(const f32x16&p0,const f32x16&p1){
  float a=max3f(p0[0],p0[1],p1[0]),b=max3f(p0[2],p0[3],p1[1]);a=max3f(a,p1[2],p1[3]);
  #pragma unroll
  for(int r=4;r<16;r+=4){a=max3f(a,p0[r],p0[r+1]);b=max3f(b,p0[r+2],p0[r+3]);a=max3f(a,p1[r],p1[r+1]);b=max3f(b,p1[r+2],p1[r+3]);}
  const float m=max2f(a,b);
  auto rr=__builtin_amdgcn_permlane32_swap(__float_as_uint(m),__float_as_uint(m),false,false);
  return max2f(__uint_as_float(rr[0]),__uint_as_float(rr[1]));
}
__device__ __forceinline__ void pv(f32x16*o,int vb,bf16x8 pa0,bf16x8 pa1,bf16x8 pa2,bf16x8 pa3){
  #pragma unroll
  for(int d0=0;d0<2;++d0){s16x4 lo[4],hi[4];
    #pragma unroll
    for(int ks=0;ks<4;++ks){
      asm volatile("ds_read_b64_tr_b16 %0,%1 offset:%c2":"=&v"(lo[ks]):"v"(vb),"i"(d0*4096+ks*1024):"memory");
      asm volatile("ds_read_b64_tr_b16 %0,%1 offset:%c2":"=&v"(hi[ks]):"v"(vb),"i"(d0*4096+ks*1024+512):"memory");}
    asm volatile("s_waitcnt lgkmcnt(0)":::"memory");SBAR();
    #define PK(k) (bf16x8){lo[k][0],lo[k][1],lo[k][2],lo[k][3],hi[k][0],hi[k][1],hi[k][2],hi[k][3]}
    o[d0]=__builtin_amdgcn_mfma_f32_32x32x16_bf16(pa0,PK(0),o[d0],0,0,0);
    o[d0]=__builtin_amdgcn_mfma_f32_32x32x16_bf16(pa1,PK(1),o[d0],0,0,0);
    o[d0]=__builtin_amdgcn_mfma_f32_32x32x16_bf16(pa2,PK(2),o[d0],0,0,0);
    o[d0]=__builtin_amdgcn_mfma_f32_32x32x16_bf16(pa3,PK(3),o[d0],0,0,0);
    #undef PK
  }
}

template<int MODE,int THRL> __device__ __forceinline__ void attn_unit(int b,int h,int qb,const bf16*Q,const bf16*__restrict__ K,const bf16*__restrict__ V,unsigned char*O8,const void*aux,char*shm,const int tid_in){
  int tidl_=tid_in; asm volatile("":"+v"(tidl_));
  const int tid=tidl_,lane=tid&63,r32=lane&31,hi=lane>>5; const int wid=__builtin_amdgcn_readfirstlane(tid>>6);
  const long rowbase=(long)b*SEQ; const int q0=qb*QB;
  const bf16*Qw=Q+(rowbase+q0+wid*QBLK)*DM+h*D;
  const bf16*Kh=K+rowbase*DM+h*D,*Vh=V+rowbase*DM+h*D;
  const unsigned lds0=(unsigned)(uintptr_t)shm;
  float*wsf=(float*)(shm+LDS_WS)+wid*64;
  const bf16*ksrc=Kh+(long)lane*DM+wid*8;
  const bf16*vsrc=Vh+(long)(16*(wid&3)+(lane>>2))*DM+(wid>>2)*32+(lane&3)*8;
  const unsigned kdst=lds0+LDS_K+wid*1024, vdst=lds0+LDS_V+wid*1024;
  #define DMA_K(t,slot) glds16(ksrc+(long)(t)*KVBLK*DM,(unsigned)__builtin_amdgcn_readfirstlane(kdst+(slot)))
  #define DMA_V(t,slot) glds16(vsrc+(long)(t)*KVBLK*DM,(unsigned)__builtin_amdgcn_readfirstlane(vdst+(slot)))
  const int vb0=(int)(lds0+LDS_V)+((lane>>4)&1)*32+(lane&3)*8+(4*hi+((lane&15)>>2))*64;
  const char*Kbase=shm+LDS_K; bf16x8 kf[8];
  const lds_cptr shm3=(lds_cptr)shm; const lds_cptr kp0=shm3+LDS_K+hi*1024+r32*16; const lds_cptr vp0=shm3+LDS_V+((lane>>4)&1)*32+(lane&3)*8+(4*hi+((lane&15)>>2))*64;
  const int NT=(q0+QB)/KVBLK;
  unsigned selmask=0u;
  if(MODE==0){ float*km=(float*)(shm+LDS_KM); const float*kmg=(const float*)aux+(size_t)(b*NHEAD+h)*16*64;
    for(int i=tid;i<16*64;i+=NW*64)km[i]=kmg[i];
    bf16x8 qg[4];
    _Pragma("unroll") for(int d0=0;d0<4;++d0)qg[d0]=*reinterpret_cast<const bf16x8*>(&Qw[(long)r32*DM+d0*16+hi*8]);
    asm volatile("s_waitcnt vmcnt(0) lgkmcnt(0)":::"memory"); __syncthreads();
    float g[15];
    _Pragma("unroll") for(int j=0;j<15;++j){ g[j]=-INFINITY;
      if(j<qb){ float sg=0.f;
        _Pragma("unroll") for(int d0=0;d0<4;++d0) _Pragma("unroll") for(int e=0;e<8;++e) sg+=__uint_as_float(((unsigned)(unsigned short)qg[d0][e])<<16)*km[j*64+d0*16+hi*8+e];
        auto rr=__builtin_amdgcn_permlane32_swap(__float_as_uint(sg),__float_as_uint(sg),false,false); g[j]=__uint_as_float(rr[0])+__uint_as_float(rr[1]); } SBAR(); }
    _Pragma("unroll") for(int k=0;k<3;++k){ float best=-INFINITY; int bi=-1;
      _Pragma("unroll") for(int j=0;j<15;++j) if(j<qb && !((selmask>>j)&1u) && g[j]>best){best=g[j];bi=j;}
      if(bi>=0)selmask|=1u<<bi; }
    asm volatile("":"+v"(selmask)); SBAR(); }
  DMA_K(0,0);DMA_V(0,0);DMA_K(1,SLOTB);
  bf16x8 qr[4];
  #pragma unroll
  for(int d0=0;d0<4;++d0)qr[d0]=*reinterpret_cast<const bf16x8*>(&Qw[(long)r32*DM+d0*16+hi*8]);
  const unsigned*mrow=nullptr; u32x2 mwc=(u32x2){0u,0u}, mwn=(u32x2){0u,0u};
  if(MODE==1){ mrow=(const unsigned*)aux+(size_t)(rowbase+q0+wid*QBLK+r32)*128; mwc=*(const u32x2*)(mrow); mwn=*(const u32x2*)(mrow+2); }
  float z0_=0.f; asm volatile("":"+v"(z0_));
  float mhat=0.f,l_reg=0.f;f32x16 o[2];f32x16 negm;
  _Pragma("unroll") for(int r=0;r<16;++r){o[0][r]=z0_;o[1][r]=z0_;negm[r]=z0_;} asm volatile("":"+v"(negm));
  const int qrel=wid*QBLK+r32;
  #define DSAMASK(P0,P1,W) do{ const int w0_=(int)((W).x>>(4*hi)), w1_=(int)((W).y>>(4*hi)); \
    _Pragma("unroll") for(int r=0;r<16;++r){ const int bit_=(r&3)+8*(r>>2); const unsigned m0_=(unsigned)((w0_<<(31-bit_))>>31), m1_=(unsigned)((w1_<<(31-bit_))>>31); \
      P0[r]=__uint_as_float((__float_as_uint(P0[r])&m0_)|(0xff800000u&~m0_)); P1[r]=__uint_as_float((__float_as_uint(P1[r])&m1_)|(0xff800000u&~m1_)); } }while(0)
  #define CMASK(P0,P1,t) do{ if(MODE==0){ int jb_=(t)-(NT-4); if(jb_>=0)cmask(P0,P1,jb_,qrel,hi); \
      else if(!((selmask>>((t)>>2))&1u)){ _Pragma("unroll") for(int r=0;r<16;++r){P0[r]=-INFINITY;P1[r]=-INFINITY;} } } \
    else { DSAMASK(P0,P1,mwc); } }while(0)
  bool resc=false;
  #define START(P0,P1) do{ const float rm=rowmax(P0,P1); resc=false; \
    { const float dl=__builtin_fmaxf(rm,0.f); mhat=fadd_s(mhat,dl); \
      _Pragma("unroll") for(int r=0;r<16;++r){P0[r]=fsub_s(P0[r],dl);P1[r]=fsub_s(P1[r],dl);} \
      _Pragma("unroll") for(int r=0;r<16;++r)negm[r]=-mhat; asm volatile("":"+v"(negm)); } \
    _Pragma("unroll") for(int r=0;r<16;++r)P0[r]=__builtin_amdgcn_exp2f(P0[r]); }while(0)
  #define RESC() do{ if(resc){ asm volatile("s_waitcnt lgkmcnt(0)":::"memory"); \
      _Pragma("unroll") for(int d_=0;d_<2;++d_) _Pragma("unroll") for(int r=0;r<16;++r)o[d_][r]*=wsf[crow(r,hi)]; } }while(0)
  f32x16 pA0,pA1,pB0,pB1;
  int sl_prev=0,sl_cur=0,sl_next=SLOTB;
  #define ROT() do{sl_prev=sl_cur;sl_cur=sl_next;sl_next=(sl_next==(NSLOT-1)*SLOTB)?0:sl_next+SLOTB;}while(0)
  DMA_K(2,2*SLOTB);
  WAIT_BAR(3);
  qkt(pA0,pA1,Kbase,qr,negm,r32,hi);asm volatile("s_nop 15\n\ts_nop 7":"+v"(pA0),"+v"(pA1));CMASK(pA0,pA1,0);
  START(pA0,pA1);
  _Pragma("unroll") for(int r=0;r<16;++r)pA1[r]=__builtin_amdgcn_exp2f(pA1[r]);
  WAIT_BAR(0);
  DMA_K(3,0);DMA_V(1,SLOTB);
  ROT();
  if(MODE==1){mwc=mwn;}
  kload8(kf,kp0+sl_cur);
  WAIT_BAR(2);
  s16x4 vlo[8],vhi[8]; u32x4 pw0,pw1,pw2,pw3;
  #define PKW(P,B) cvtpk_s(P[B],P[B+1])
  #define PAF(k) __builtin_bit_cast(bf16x8,pw##k)
  #define VFR(i) (bf16x8){vlo[i][0],vlo[i][1],vlo[i][2],vlo[i][3],vhi[i][0],vhi[i][1],vhi[i][2],vhi[i][3]}
  #define PIN(x) asm volatile("":"+v"(x))
  #define MX3(a,b,c) __builtin_fmaxf(__builtin_fmaxf((a),(b)),(c))
  #define GAPA(MF,A0,A1,A2,A3,W0,W1,PW) do{ MF; sacc+=A0; sacc+=A1; sacc+=A2; sacc+=A3; PIN(sacc); W0; W1; PIN(PW); SBAR(); }while(0)
  #define EX(v) __builtin_amdgcn_exp2f(v)
  #define GAPB(MF,X,B) do{ MF; X[B]=EX(X[B]); X[B+1]=EX(X[B+1]); X[B+2]=EX(X[B+2]); X[B+3]=EX(X[B+3]); PIN(X); SBAR(); }while(0)
  #define VRD(i) do{ vlo[i]=vtr(vp_+(((i)>>2)*4096+((i)&3)*1024)); vhi[i]=vtr(vp_+(((i)>>2)*4096+((i)&3)*1024+512)); }while(0)
  #define KRD(G,j) do{ if(G){ kload2(kf,kp0+sl_next,j); SBAR(); } }while(0)
  #define MLOAD(tn) do{ if(MODE==1){ const unsigned*mp_=mrow+2*(tn); asm volatile("global_load_dwordx2 %0, %1, off":"=v"(mwn):"v"(mp_):"memory"); } }while(0)
  #define MROT() do{ if(MODE==1){ asm volatile("":"+v"(mwn)); mwc=mwn; } }while(0)
  #define STEP(C0,C1,P0,P1,t,GK,GV,GL) do{ SBAR(); \
    if((t)+1<NT){MLOAD((t)+1);} \
    const lds_cptr vp_=vp0+sl_prev; \
    VRD(0); SBAR(); float sacc=(P0[0]+P0[1]); \
    GAPA(C0=__builtin_amdgcn_mfma_f32_32x32x16_bf16(kf[0],qr[0],negm,0,0,0), P0[2],P0[3],P0[4],P0[5],     pw0[0]=PKW(P0,0), pw0[1]=PKW(P0,2), pw0); \
    VRD(4); SBAR(); GAPA(C1=__builtin_amdgcn_mfma_f32_32x32x16_bf16(kf[1],qr[0],negm,0,0,0), P0[6],P0[7],P0[8],P0[9],     pw0[2]=PKW(P0,4), pw0[3]=PKW(P0,6), pw0); \
    VRD(1); SBAR(); GAPA(C0=__builtin_amdgcn_mfma_f32_32x32x16_bf16(kf[2],qr[1],C0,0,0,0),   P0[10],P0[11],P0[12],P0[13], pw1[0]=PKW(P0,8), pw1[1]=PKW(P0,10), pw1); \
    VRD(5); SBAR(); GAPA(C1=__builtin_amdgcn_mfma_f32_32x32x16_bf16(kf[3],qr[1],C1,0,0,0),   P0[14],P0[15],P1[0],P1[1],   pw1[2]=PKW(P0,12),pw1[3]=PKW(P0,14), pw1); \
    VRD(2); SBAR(); GAPA(C0=__builtin_amdgcn_mfma_f32_32x32x16_bf16(kf[4],qr[2],C0,0,0,0),   P1[2],P1[3],P1[4],P1[5],     pw2[0]=PKW(P1,0), pw2[1]=PKW(P1,2), pw2); \
    VRD(6); SBAR(); GAPA(C1=__builtin_amdgcn_mfma_f32_32x32x16_bf16(kf[5],qr[2],C1,0,0,0),   P1[6],P1[7],P1[8],P1[9],     pw2[2]=PKW(P1,4), pw2[3]=PKW(P1,6), pw2); \
    VRD(3); SBAR(); GAPA(C0=__builtin_amdgcn_mfma_f32_32x32x16_bf16(kf[6],qr[3],C0,0,0,0),   P1[10],P1[11],P1[12],P1[13], pw3[0]=PKW(P1,8), pw3[1]=PKW(P1,10), pw3); \
    VRD(7); SBAR(); GAPA(C1=__builtin_amdgcn_mfma_f32_32x32x16_bf16(kf[7],qr[3],C1,0,0,0),   P1[14],P1[15],0.f,0.f,       pw3[2]=PKW(P1,12),pw3[3]=PKW(P1,14), pw3); \
    l_reg+=sacc; \
    if(GK){DMA_K((t)+3,sl_cur);} if(GV){DMA_V((t)+1,sl_next);} \
    CMASK(C0,C1,t); \
    { float a=MX3(C0[0],C0[1],C1[0]),b=MX3(C0[2],C0[3],C1[1]); a=MX3(a,C1[2],C1[3]); \
      _Pragma("unroll") for(int r=4;r<16;r+=4){a=MX3(a,C0[r],C0[r+1]);b=MX3(b,C0[r+2],C0[r+3]);a=MX3(a,C1[r],C1[r+1]);b=MX3(b,C1[r+2],C1[r+3]);} \
      float rm=__builtin_fmaxf(a,b); { auto rr=__builtin_amdgcn_permlane32_swap(__float_as_uint(rm),__float_as_uint(rm),false,false); rm=__builtin_fmaxf(__uint_as_float(rr[0]),__uint_as_float(rr[1])); } \
      resc=false; \
      if(__builtin_expect(__any(rm>(float)THRL),0)){ const float dl=__builtin_fmaxf(rm,0.f); mhat+=dl; \
        _Pragma("unroll") for(int r=0;r<16;++r){C0[r]-=dl;C1[r]-=dl;} \
        _Pragma("unroll") for(int r=0;r<16;++r)negm[r]=-mhat; asm volatile("":"+v"(negm)); \
        const float f=__builtin_amdgcn_exp2f(-dl); l_reg*=f; if(hi==0)wsf[r32]=f; resc=true; } } \
    SBAR(); \
    GAPB(o[0]=__builtin_amdgcn_mfma_f32_32x32x16_bf16(PAF(0),VFR(0),o[0],0,0,0), C0,0); \
    GAPB(o[1]=__builtin_amdgcn_mfma_f32_32x32x16_bf16(PAF(0),VFR(4),o[1],0,0,0), C0,4); \
    KRD(GL,0); GAPB(o[0]=__builtin_amdgcn_mfma_f32_32x32x16_bf16(PAF(1),VFR(1),o[0],0,0,0), C0,8); \
    KRD(GL,1); GAPB(o[1]=__builtin_amdgcn_mfma_f32_32x32x16_bf16(PAF(1),VFR(5),o[1],0,0,0), C0,12); \
    KRD(GL,2); GAPB(o[0]=__builtin_amdgcn_mfma_f32_32x32x16_bf16(PAF(2),VFR(2),o[0],0,0,0), C1,0); \
    KRD(GL,3); GAPB(o[1]=__builtin_amdgcn_mfma_f32_32x32x16_bf16(PAF(2),VFR(6),o[1],0,0,0), C1,4); \
    GAPB(o[0]=__builtin_amdgcn_mfma_f32_32x32x16_bf16(PAF(3),VFR(3),o[0],0,0,0), C1,8); \
    GAPB(o[1]=__builtin_amdgcn_mfma_f32_32x32x16_bf16(PAF(3),VFR(7),o[1],0,0,0), C1,12); \
    }while(0)
  int t=1;
  for(;t+5<NT;t+=2){
    STEP(pB0,pB1,pA0,pA1,t,true,true,true);     WAIT_BAR(2); MROT(); RESC(); ROT();
    STEP(pA0,pA1,pB0,pB1,t+1,true,true,true);   WAIT_BAR(2); MROT(); RESC(); ROT();
  }
  #define ENDW(tt) do{ if((tt)+3<NT){WAIT_BAR(2);} else if((tt)+2<NT){WAIT_BAR(1);} else {WAIT_BAR(0);} }while(0)
  for(;t+1<NT;t+=2){
    STEP(pB0,pB1,pA0,pA1,t,(t+3<NT),(t+1<NT),(t+1<NT));       ENDW(t);   MROT(); RESC(); ROT();
    STEP(pA0,pA1,pB0,pB1,t+1,(t+4<NT),(t+2<NT),(t+2<NT));     ENDW(t+1); MROT(); RESC(); ROT();
  }
  STEP(pB0,pB1,pA0,pA1,NT-1,false,false,false); RESC();
  { float sacc=pB0[0]+pB0[1]; _Pragma("unroll") for(int r=2;r<16;++r)sacc+=pB0[r]; _Pragma("unroll") for(int r=0;r<16;++r)sacc+=pB1[r]; l_reg+=sacc;
    pw0=(u32x4){PKW(pB0,0),PKW(pB0,2),PKW(pB0,4),PKW(pB0,6)};pw1=(u32x4){PKW(pB0,8),PKW(pB0,10),PKW(pB0,12),PKW(pB0,14)};pw2=(u32x4){PKW(pB1,0),PKW(pB1,2),PKW(pB1,4),PKW(pB1,6)};pw3=(u32x4){PKW(pB1,8),PKW(pB1,10),PKW(pB1,12),PKW(pB1,14)};
    SBAR(); pv(o,vb0+sl_cur,PAF(0),PAF(1),PAF(2),PAF(3)); }
  #undef PKW
  #undef PAF
  #undef VFR
  #undef PIN
  #undef MX3
  #undef GAPA
  #undef GAPB
  #undef EX
  #undef VRD
  #undef KRD
  #undef STEP
  #undef ENDW
  {auto rr=__builtin_amdgcn_permlane32_swap(__float_as_uint(l_reg),__float_as_uint(l_reg),false,false);l_reg=__uint_as_float(rr[0])+__uint_as_float(rr[1]);}
  if(hi==0)wsf[32+r32]=l_reg;asm volatile("s_waitcnt lgkmcnt(0)":::"memory");
  float rli[16];
  #pragma unroll
  for(int r=0;r<16;++r)rli[r]=__builtin_amdgcn_rcpf(wsf[32+crow(r,hi)]);
  unsigned char*Ow=O8+(rowbase+q0+wid*QBLK)*(2*DM)+h*D;
  { unsigned char*stg=(unsigned char*)(shm+LDS_OST)+wid*2048;
    #pragma unroll
    for(int r=0;r<16;++r){const int orow=crow(r,hi); const float sc16=rli[r]*16.0f; const int pk=__builtin_amdgcn_cvt_pk_fp8_f32(o[0][r]*sc16,o[1][r]*sc16,0,false);
      stg[orow*64+r32]=(unsigned char)(pk&0xff); stg[orow*64+32+r32]=(unsigned char)((pk>>8)&0xff);}
    asm volatile("s_waitcnt lgkmcnt(0)":::"memory");
    #pragma unroll
    for(int i=0;i<2;++i){const int row=i*16+(lane>>2),ch=lane&3; const u32x4 v=*(const u32x4*)(stg+row*64+ch*16); *(u32x4*)(Ow+(long)row*(2*DM)+ch*16)=v;} }
  asm volatile("s_waitcnt vmcnt(0) lgkmcnt(0)\n\ts_barrier":::"memory");
  #undef DMA_K
  #undef DMA_V
  #undef CMASK
  #undef START
  #undef RESC
  #undef ROT
  #undef MLOAD
  #undef MROT
  #undef DSAMASK
}
constexpr int ATTN_LDS_BYTES=LDS_BYTES;
#undef SBAR
#undef WAIT_BAR
}

namespace idx {
using bf16x8 = __attribute__((ext_vector_type(8))) short;
using f32x16 = __attribute__((ext_vector_type(16))) float;
using f32x4 = __attribute__((ext_vector_type(4))) float;
using u32x4 = __attribute__((ext_vector_type(4))) unsigned;
using u32x2 = __attribute__((ext_vector_type(2))) unsigned;
typedef unsigned short bf16r;
constexpr int SEQL = 4096, LCAP = 256, HSTRIDE = 1028;
constexpr int L_AF = 0, L_W = L_AF + 16384, L_M = L_W + 512, L_CT = L_M + 8192, L_LIST = L_CT + 512, L_HIST = L_LIST + 16 * LCAP * 8, LDS_BYTES = L_HIST + 16 * HSTRIDE * 4;
#define IDX_LAS __attribute__((address_space(3)))
__device__ __forceinline__ unsigned okey(float s) { const unsigned u = __float_as_uint(s); return u ^ ((unsigned)((int)u >> 31) | 0x80000000u); }
__device__ __forceinline__ float fkey(unsigned k) { return __uint_as_float(k ^ ((unsigned)((int)(~k) >> 31) | 0x80000000u)); }
__device__ __forceinline__ void glds16(const void* gsrc, unsigned lds_dst) { unsigned keep;
    asm volatile("s_mov_b32 %0, m0\n\ts_mov_b32 m0, %2\n\ts_nop 0\n\tglobal_load_lds_dwordx4 %1, off\n\ts_mov_b32 m0, %0" : "=&s"(keep) : "v"(gsrc), "s"(lds_dst) : "memory"); }
__device__ __forceinline__ float relu1(float x) { float r; asm("v_max_f32_e32 %0, 0, %1" : "=v"(r) : "v"(x)); return r; }
__device__ __forceinline__ void fmac1(float& acc, float a, float b) { asm("v_fmac_f32_e32 %0, %1, %2" : "+v"(acc) : "v"(a), "v"(b)); }
#define IDX_DPP(v, ctrl) __builtin_bit_cast(float, __builtin_amdgcn_update_dpp(0, __builtin_bit_cast(int, (v)), (ctrl), 0xF, 0xF, false))
__device__ __forceinline__ float half_max(float v) { v = __builtin_fmaxf(v, IDX_DPP(v, 0xB1)); v = __builtin_fmaxf(v, IDX_DPP(v, 0x4E)); v = __builtin_fmaxf(v, IDX_DPP(v, 0x141)); v = __builtin_fmaxf(v, IDX_DPP(v, 0x140));
    auto r = __builtin_amdgcn_permlane16_swap(__float_as_uint(v), __float_as_uint(v), false, false); return __builtin_fmaxf(__uint_as_float(r[0]), __uint_as_float(r[1])); }
__device__ __forceinline__ float half_min(float v) { v = __builtin_fminf(v, IDX_DPP(v, 0xB1)); v = __builtin_fminf(v, IDX_DPP(v, 0x4E)); v = __builtin_fminf(v, IDX_DPP(v, 0x141)); v = __builtin_fminf(v, IDX_DPP(v, 0x140));
    auto r = __builtin_amdgcn_permlane16_swap(__float_as_uint(v), __float_as_uint(v), false, false); return __builtin_fminf(__uint_as_float(r[0]), __uint_as_float(r[1])); }

__device__ __forceinline__ void scan_hist(IDX_LAS unsigned* hist, int q, unsigned need, int lane, unsigned& binL, unsigned& needL) {
    unsigned w[16];
#pragma unroll
    for (int i = 0; i < 4; ++i) { const u32x4 v = *(const IDX_LAS u32x4*)(hist + q * HSTRIDE + 16 * lane + 4 * i); w[4 * i] = v.x; w[4 * i + 1] = v.y; w[4 * i + 2] = v.z; w[4 * i + 3] = v.w; }
    unsigned tot = 0u;
#pragma unroll
    for (int i = 0; i < 16; ++i) tot += w[i];
    unsigned s = tot;
#pragma unroll
    for (int d = 1; d < 64; d <<= 1) { const unsigned t = __shfl_down(s, d); if (lane + d < 64) s += t; }
    const unsigned above = s - tot;
    const unsigned long long bal = __ballot(above < need && need <= above + tot);
    const int L = bal ? (int)__builtin_ctzll(bal) : 0;
    unsigned run = above, bsel = 0u, nsel = 1u; bool found = false;
#pragma unroll
    for (int i = 15; i >= 0; --i) { if (!found && run + w[i] >= need) { found = true; bsel = i; nsel = need - run; } run += w[i]; }
    binL = (unsigned)__shfl((int)bsel, L) + 16u * (unsigned)L; needL = (unsigned)__shfl((int)nsel, L);
}
__device__ __forceinline__ void zero_hist(IDX_LAS char* shm, int tid) { IDX_LAS u32x4* h4 = (IDX_LAS u32x4*)(shm + L_HIST);
#pragma unroll
    for (int i = 0; i < 9; ++i) if (tid + i * 512 < 16 * HSTRIDE / 4) h4[tid + i * 512] = (u32x4){0u, 0u, 0u, 0u}; }

__device__ __forceinline__ void unit(int b, int q0, const bf16r* IQ, const bf16r* IK, const float* IW, unsigned* MASK, char* shm_, const int tid_in, unsigned long long* dbg = nullptr) {
    int tid_ = tid_in; asm volatile("" : "+v"(tid_)); unsigned shm_u = (unsigned)(uintptr_t)shm_; asm volatile("" : "+s"(shm_u)); IDX_LAS char* const shm = (IDX_LAS char*)shm_u;
    const int tid = tid_, lane = tid & 63, j = lane & 31, hi = lane >> 5; const int wid = __builtin_amdgcn_readfirstlane(tid >> 6);
    const size_t rowbase = (size_t)b * SEQL;
    IDX_LAS unsigned* ct = (IDX_LAS unsigned*)(shm + L_CT);
    IDX_LAS unsigned* hist = (IDX_LAS unsigned*)(shm + L_HIST);
    const unsigned lds0 = shm_u;
    const int ntile = (q0 + 15) / 32 + 1;
    const int ni = (ntile > wid) ? (ntile - wid + 7) / 8 : 0;
    const bf16r* iksrc = IK + (rowbase + j) * 64 + 8 * hi;
    const unsigned ring = lds0 + L_HIST + (unsigned)wid * 8192u;
#define IDX_DMA(i_) do { const bf16r* s_ = iksrc + (size_t)(8 * (i_) + wid) * 32 * 64; const unsigned d_ = (unsigned)__builtin_amdgcn_readfirstlane(ring + (((i_) & 1) ? 4096u : 0u)); \
        glds16(s_, d_); glds16(s_ + 16, (unsigned)__builtin_amdgcn_readfirstlane(d_ + 1024u)); glds16(s_ + 32, (unsigned)__builtin_amdgcn_readfirstlane(d_ + 2048u)); glds16(s_ + 48, (unsigned)__builtin_amdgcn_readfirstlane(d_ + 3072u)); } while (0)
    if (ni > 0) IDX_DMA(0);
#pragma unroll
    for (int k = 0; k < 2; ++k) { const int f = wid + 8 * k, rb = f >> 2, s = f & 3; const int i = j;
        const int qi = ((i >> 4) & 1) + 2 * ((i >> 2) & 1), head = (i & 3) + 4 * ((i >> 3) & 1);
        const u32x4 v = *(const u32x4*)(IQ + (rowbase + q0 + 4 * rb + qi) * 512 + head * 64 + 16 * s + 8 * hi);
        *(IDX_LAS u32x4*)(shm + L_AF + f * 1024 + lane * 16) = v; }
    if (tid < 128) ((IDX_LAS float*)(shm + L_W))[tid] = IW[(rowbase + q0 + (tid >> 3)) * 8 + (tid & 7)];
    { IDX_LAS u32x4* m4 = (IDX_LAS u32x4*)(shm + L_M); m4[tid] = (u32x4){0u, 0u, 0u, 0u}; }
    if (tid < 128) ct[tid] = (tid >= 48 && tid < 64) ? 0xffffffffu : 0u;
    asm volatile("s_waitcnt vmcnt(0) lgkmcnt(0)" ::: "memory"); __syncthreads();
    unsigned long long t0_ = 0; if (dbg) t0_ = __builtin_amdgcn_s_memrealtime();
    f32x16 sc[8];
#pragma unroll
    for (int c = 0; c < 8; ++c)
#pragma unroll
        for (int i = 0; i < 16; ++i) sc[c][i] = -INFINITY;
    float fmx[8], fmn[8];
#pragma unroll
    for (int c = 0; c < 8; ++c) { fmx[c] = -INFINITY; fmn[c] = INFINITY; }
#pragma unroll 1
    for (int i = 0; i < ni; ++i) {
        const int kt = 8 * i + wid; const int key = 32 * kt + j;
        if (i + 1 < ni) { IDX_DMA(i + 1); asm volatile("s_waitcnt vmcnt(4)" ::: "memory"); } else asm volatile("s_waitcnt vmcnt(0)" ::: "memory");
        bf16x8 bfr4[4];
#pragma unroll
        for (int s = 0; s < 4; ++s) bfr4[s] = *(const IDX_LAS bf16x8*)(shm + L_HIST + wid * 8192 + (i & 1) * 4096 + s * 1024 + lane * 16);
#define IDX_AF(rb_, s_) (*(const IDX_LAS bf16x8*)(shm + L_AF + ((rb_) * 4 + (s_)) * 1024 + lane * 16))
#define IDX_RELU(x) __int_as_float(max(__float_as_int(x), 0))
        typedef float f32x2_ __attribute__((ext_vector_type(2)));
        f32x16 d = f32x16{};
        { bf16x8 a0 = IDX_AF(0, 0), a1 = IDX_AF(0, 1), a2 = IDX_AF(0, 2), a3 = IDX_AF(0, 3);
          d = __builtin_amdgcn_mfma_f32_32x32x16_bf16(a0, bfr4[0], d, 0, 0, 0); d = __builtin_amdgcn_mfma_f32_32x32x16_bf16(a1, bfr4[1], d, 0, 0, 0);
          d = __builtin_amdgcn_mfma_f32_32x32x16_bf16(a2, bfr4[2], d, 0, 0, 0); d = __builtin_amdgcn_mfma_f32_32x32x16_bf16(a3, bfr4[3], d, 0, 0, 0); }
        bf16x8 an = IDX_AF(1, 0);
        __builtin_amdgcn_sched_barrier(0);
#pragma unroll
        for (int rb = 0; rb < 4; ++rb) { f32x16 dn = f32x16{}; const int rn = (rb < 3) ? rb + 1 : 3;
            const IDX_LAS f32x4* wl = (const IDX_LAS f32x4*)(shm + L_W + (4 * rb + 2 * hi) * 32);
            f32x2_ pa = {0.f, 0.f}, pb = {0.f, 0.f};
            bf16x8 an1 = an; if (rb < 3) { an1 = IDX_AF(rn, 1); dn = __builtin_amdgcn_mfma_f32_32x32x16_bf16(an, bfr4[0], dn, 0, 0, 0); }
            { const f32x4 wa0 = wl[0], wb0 = wl[2];
              pa += (f32x2_){wa0[0], wa0[1]} * (f32x2_){IDX_RELU(d[0]), IDX_RELU(d[1])}; pa += (f32x2_){wa0[2], wa0[3]} * (f32x2_){IDX_RELU(d[2]), IDX_RELU(d[3])};
              pb += (f32x2_){wb0[0], wb0[1]} * (f32x2_){IDX_RELU(d[8]), IDX_RELU(d[9])}; pb += (f32x2_){wb0[2], wb0[3]} * (f32x2_){IDX_RELU(d[10]), IDX_RELU(d[11])}; }
            __builtin_amdgcn_sched_barrier(0);
            bf16x8 an2 = an; if (rb < 3) { an2 = IDX_AF(rn, 2); dn = __builtin_amdgcn_mfma_f32_32x32x16_bf16(an1, bfr4[1], dn, 0, 0, 0); }
            { const f32x4 wa1 = wl[1], wb1 = wl[3];
              pa += (f32x2_){wa1[0], wa1[1]} * (f32x2_){IDX_RELU(d[4]), IDX_RELU(d[5])}; pa += (f32x2_){wa1[2], wa1[3]} * (f32x2_){IDX_RELU(d[6]), IDX_RELU(d[7])};
              pb += (f32x2_){wb1[0], wb1[1]} * (f32x2_){IDX_RELU(d[12]), IDX_RELU(d[13])}; pb += (f32x2_){wb1[2], wb1[3]} * (f32x2_){IDX_RELU(d[14]), IDX_RELU(d[15])}; }
            __builtin_amdgcn_sched_barrier(0);
            bf16x8 an3 = an; if (rb < 3) { an3 = IDX_AF(rn, 3); dn = __builtin_amdgcn_mfma_f32_32x32x16_bf16(an2, bfr4[2], dn, 0, 0, 0); }
            float sa = pa[0] + pa[1], sb = pb[0] + pb[1];
            const int posa = q0 + 4 * rb + 2 * hi;
            const bool ina = key > posa, inb = key > posa + 1;
            asm volatile("v_min_f32 %0, %0, %2\n\tv_min_f32 %1, %1, %3" : "+v"(fmn[2 * rb]), "+v"(fmn[2 * rb + 1]) : "v"(sa), "v"(sb));
            if (ina) sa = -INFINITY; if (inb) sb = -INFINITY;
            __builtin_amdgcn_sched_barrier(0);
            if (rb < 3) { dn = __builtin_amdgcn_mfma_f32_32x32x16_bf16(an3, bfr4[3], dn, 0, 0, 0); if (rb < 2) an = IDX_AF(rn + 1, 0); }
            asm volatile("v_max_f32 %0, %0, %2\n\tv_max_f32 %1, %1, %3" : "+v"(fmx[2 * rb]), "+v"(fmx[2 * rb + 1]) : "v"(sa), "v"(sb));
            sc[2 * rb][i] = sa; sc[2 * rb + 1][i] = sb; __builtin_amdgcn_sched_barrier(0);
            d = dn; }
    }
#undef IDX_DMA
    if (dbg) { const unsigned long long t1_ = __builtin_amdgcn_s_memrealtime(); if (tid == 0) dbg[0] += t1_ - t0_; t0_ = t1_; }
#define TMARK(k) do { if (dbg) { const unsigned long long t1_ = __builtin_amdgcn_s_memrealtime(); if (tid == 0) dbg[k] += t1_ - t0_; t0_ = t1_; } } while (0)
    float tf[8]; int tix[8];
    if (q0 >= 256) {
        { unsigned umx[8], umn[8];
#pragma unroll
          for (int c = 0; c < 8; ++c) { umx[c] = (fmx[c] == -INFINITY) ? 0u : okey(fmx[c]); umn[c] = okey(fmn[c]);
#define IDX_DPPU(v, ctrl) ((unsigned)__builtin_amdgcn_update_dpp(0, (int)(v), (ctrl), 0xF, 0xF, false))
              umx[c] = max(umx[c], IDX_DPPU(umx[c], 0xB1)); umn[c] = min(umn[c], IDX_DPPU(umn[c], 0xB1)); umx[c] = max(umx[c], IDX_DPPU(umx[c], 0x4E)); umn[c] = min(umn[c], IDX_DPPU(umn[c], 0x4E));
              umx[c] = max(umx[c], IDX_DPPU(umx[c], 0x141)); umn[c] = min(umn[c], IDX_DPPU(umn[c], 0x141)); umx[c] = max(umx[c], IDX_DPPU(umx[c], 0x140)); umn[c] = min(umn[c], IDX_DPPU(umn[c], 0x140));
              { const auto r = __builtin_amdgcn_permlane16_swap(umx[c], umx[c], false, false); umx[c] = max((unsigned)r[0], (unsigned)r[1]); }
              { const auto r = __builtin_amdgcn_permlane16_swap(umn[c], umn[c], false, false); umn[c] = min((unsigned)r[0], (unsigned)r[1]); } }
          asm volatile("s_waitcnt lgkmcnt(0)" ::: "memory"); __syncthreads();
          if (j == 0) {
#pragma unroll
            for (int c = 0; c < 8; ++c) { const int q = 4 * (c >> 1) + 2 * hi + (c & 1);
                if (umx[c] != 0u) { (void)__hip_atomic_fetch_max(&ct[32 + q], umx[c], __ATOMIC_RELAXED, __HIP_MEMORY_SCOPE_WORKGROUP); (void)__hip_atomic_fetch_min(&ct[48 + q], umn[c], __ATOMIC_RELAXED, __HIP_MEMORY_SCOPE_WORKGROUP); } } } }
        TMARK(3);
        if (tid < 16) ct[16 + tid] = 256u;
        IDX_LAS u32x2* list = (IDX_LAS u32x2*)(shm + L_LIST);
        auto round_body = [&](const int round) __attribute__((always_inline)) {
            zero_hist(shm, tid);
            if (tid < 16) { ct[64 + tid] = 0u; ct[96 + tid] = ct[112 + tid]; }
            asm volatile("s_waitcnt lgkmcnt(0)" ::: "memory"); __syncthreads();
            float lo[8], scl[8];
#pragma unroll
            for (int c = 0; c < 8; ++c) { const int q = 4 * (c >> 1) + 2 * hi + (c & 1); const float h_ = fkey(ct[32 + q]); lo[c] = fkey(ct[48 + q]); const float d_ = h_ - lo[c]; scl[c] = (d_ > 0.f) ? 1023.0f / d_ : 0.f; }
#pragma unroll 1
            for (int i = 0; i < ni; ++i) {
#pragma unroll
                for (int c = 0; c < 8; ++c) { const float s = sc[c][i]; const int q = 4 * (c >> 1) + 2 * hi + (c & 1);
                    const unsigned bin = min((unsigned)((s - lo[c]) * scl[c]), 1024u);
                    (void)__hip_atomic_fetch_add(&hist[q * HSTRIDE + bin], 1u, __ATOMIC_RELAXED, __HIP_MEMORY_SCOPE_WORKGROUP); } __builtin_amdgcn_sched_barrier(0); }
            asm volatile("s_waitcnt lgkmcnt(0)" ::: "memory"); __syncthreads(); TMARK(4);
#pragma unroll 1
            for (int qq = 0; qq < 2; ++qq) { const int q = 2 * wid + qq; if (ct[96 + q] == 0u) { unsigned binL, needL; scan_hist(hist, q, ct[16 + q], lane, binL, needL); if (lane == 0) { ct[q] = binL; ct[16 + q] = needL; ct[32 + q] = 0u; ct[48 + q] = 0xffffffffu; } } }
            asm volatile("s_waitcnt lgkmcnt(0)" ::: "memory"); __syncthreads(); TMARK(5);
            unsigned b1[8];
#pragma unroll
            for (int c = 0; c < 8; ++c) { const int q = 4 * (c >> 1) + 2 * hi + (c & 1); b1[c] = (ct[96 + q] == 0u) ? ct[q] : 0xffffffffu; }
#pragma unroll 1
            for (int i = 0; i < ni; ++i) { const int kidx = 32 * (8 * i + wid) + j;
                bool pc[8]; bool anyc = false;
#pragma unroll
                for (int c = 0; c < 8; ++c) { const float s = sc[c][i]; const unsigned bin = min((unsigned)((s - lo[c]) * scl[c]), 1024u); pc[c] = (bin == b1[c]) && (s >= lo[c]); anyc = anyc || pc[c]; }
                if (__any(anyc)) {
#pragma unroll
                    for (int c = 0; c < 8; ++c) { const int q = 4 * (c >> 1) + 2 * hi + (c & 1);
                        if (pc[c]) { const unsigned k = okey(sc[c][i]); const unsigned pos = __hip_atomic_fetch_add(&ct[64 + q], 1u, __ATOMIC_RELAXED, __HIP_MEMORY_SCOPE_WORKGROUP);
                            (void)__hip_atomic_fetch_max(&ct[32 + q], k, __ATOMIC_RELAXED, __HIP_MEMORY_SCOPE_WORKGROUP); (void)__hip_atomic_fetch_min(&ct[48 + q], k, __ATOMIC_RELAXED, __HIP_MEMORY_SCOPE_WORKGROUP);
                            if (pos < (unsigned)LCAP) list[q * LCAP + pos] = (u32x2){k, (unsigned)kidx}; } } } }
            asm volatile("s_waitcnt lgkmcnt(0)" ::: "memory"); __syncthreads(); TMARK(6);
#pragma unroll 1
            for (int qq = 0; qq < 2; ++qq) { const int q = 2 * wid + qq; if (ct[96 + q] != 0u) continue;
                const int n = (int)ct[64 + q]; const unsigned need = ct[16 + q];
                if (n > LCAP) { if (ct[32 + q] == ct[48 + q] || round == 5) { if (lane == 0) { ct[q] = ct[48 + q]; ct[80 + q] = 0x7fffffffu; ct[112 + q] = 1u; } }
                    continue; }
                unsigned mk[4], mi[4], cg[4], ce[4];
#pragma unroll
                for (int m = 0; m < 4; ++m) { const int e = lane + 64 * m; const u32x2 v = (e < n) ? list[q * LCAP + e] : (u32x2){0u, 0u}; mk[m] = v.x; mi[m] = v.y; cg[m] = 0u; ce[m] = 0u; }
                for (int e = 0; e < n; ++e) { const u32x2 x = list[q * LCAP + e];
#pragma unroll
                    for (int m = 0; m < 4; ++m) { cg[m] += (x.x > mk[m]) ? 1u : 0u; ce[m] += (x.x == mk[m] && x.y < mi[m]) ? 1u : 0u; } }
                unsigned tmin = 0xffffffffu;
#pragma unroll
                for (int m = 0; m < 4; ++m) { const bool sel = (lane + 64 * m < n) && (cg[m] + ce[m] < need); if (sel) tmin = min(tmin, mk[m]); }
#pragma unroll
                for (int d = 1; d < 64; d <<= 1) tmin = min(tmin, (unsigned)__shfl_xor((int)tmin, d));
                unsigned imax = 0u; bool cut = false;
#pragma unroll
                for (int m = 0; m < 4; ++m) { const bool eq = (lane + 64 * m < n) && mk[m] == tmin; const bool sel = eq && (cg[m] + ce[m] < need); if (sel) imax = max(imax, mi[m]); cut = cut || (eq && !sel); }
#pragma unroll
                for (int d = 1; d < 64; d <<= 1) imax = max(imax, (unsigned)__shfl_xor((int)imax, d));
                if (!__any(cut)) imax = 0x7fffffffu;
                if (lane == 0) { ct[q] = tmin; ct[80 + q] = imax; ct[112 + q] = 1u; } }
            asm volatile("s_waitcnt lgkmcnt(0)" ::: "memory"); __syncthreads(); TMARK(7);
        };
        round_body(0);
        { bool alldone = true;
#pragma unroll
          for (int q = 0; q < 16; ++q) alldone = alldone && (ct[112 + q] != 0u);
          if (!alldone) round_body(5); }
#pragma unroll
        for (int c = 0; c < 8; ++c) { const int q = 4 * (c >> 1) + 2 * hi + (c & 1); tf[c] = fkey(ct[q]); tix[c] = (int)ct[80 + q]; }
    } else {
#pragma unroll
        for (int c = 0; c < 8; ++c) { tf[c] = -3.0e38f; tix[c] = 0x7fffffff; }
        asm volatile("s_waitcnt lgkmcnt(0)" ::: "memory"); __syncthreads();
    }
    if (dbg) { const unsigned long long t1_ = __builtin_amdgcn_s_memrealtime(); if (tid == 0) dbg[1] += t1_ - t0_; t0_ = t1_; }
    IDX_LAS unsigned* M = (IDX_LAS unsigned*)(shm + L_M);
    bool ties = false;
#pragma unroll
    for (int c = 0; c < 8; ++c) ties = ties || (tix[c] != 0x7fffffff);
    if (!__any(ties)) {
#pragma unroll 1
        for (int i = 0; i < ni; ++i) { const int kt = 8 * i + wid;
#pragma unroll
            for (int c = 0; c < 8; ++c) { const unsigned long long bal = __ballot(sc[c][i] >= tf[c]); const unsigned word = hi ? (unsigned)(bal >> 32) : (unsigned)bal;
                M[(4 * (c >> 1) + 2 * hi + (c & 1)) * 128 + kt] = word; } }
    } else {
#pragma unroll 1
        for (int i = 0; i < ni; ++i) { const int kt = 8 * i + wid; const int kidx = 32 * kt + j;
#pragma unroll
            for (int c = 0; c < 8; ++c) { const float s = sc[c][i]; const bool on = (s > tf[c]) || (s == tf[c] && kidx <= tix[c]);
                const unsigned long long bal = __ballot(on); const unsigned word = hi ? (unsigned)(bal >> 32) : (unsigned)bal;
                M[(4 * (c >> 1) + 2 * hi + (c & 1)) * 128 + kt] = word; } }
    }
    asm volatile("s_waitcnt lgkmcnt(0)" ::: "memory"); __syncthreads();
    { const u32x4 v = ((const IDX_LAS u32x4*)M)[tid]; *(u32x4*)(MASK + (rowbase + q0) * 128 + tid * 4) = v; }
    asm volatile("s_waitcnt vmcnt(0) lgkmcnt(0)" ::: "memory"); __syncthreads();
    if (dbg) { const unsigned long long t1_ = __builtin_amdgcn_s_memrealtime(); if (tid == 0) dbg[2] += t1_ - t0_; }
}
}

constexpr int NWAVES = 8;
constexpr int N_LAUNCHES = MK_N_LAUNCHES;
enum Phase { PH_PRO = 0, PH_ZG, PH_IDX, PH_ATT, PH_BR, PH_WO, PH_RT, PH_GU, PH_DN, PH_CMB, PH_PG, PH_FIN, PH_COUNT };
using pg8::BATCH; using pg8::SEQ; using pg8::DMODEL; using pg8::TOK; using pg8::AW; using pg8::ZN; using pg8::IN_COLS; using pg8::NEXP; using pg8::DEXP; using pg8::PLE; using pg8::RMS_EPS;

constexpr size_t MiB = 1u << 20;
constexpr size_t WS_CTL = 0, CTL_ZERO_BYTES = 2 * MiB;
constexpr size_t WS_KMEAN = 1 * MiB;
constexpr size_t WS_ROPEC = 2 * MiB, WS_ROPES = 2 * MiB + 128 * 1024;
constexpr size_t WS_RSTD = 2 * MiB + 256 * 1024;
constexpr size_t WS_LTOK = 3 * MiB, WS_LW = 7 * MiB;
constexpr size_t WS_WIN = 11 * MiB, WS_WIN8 = 17 * MiB;
constexpr size_t WS_H8 = 470 * MiB;
constexpr size_t WS_BRA = 23 * MiB, WS_BRB = 24 * MiB, WS_WOUT = 25 * MiB, WS_WPG = 27 * MiB, WS_WPP = 29 * MiB;
constexpr size_t WS_PB = 30 * MiB;
constexpr size_t WS_A = 46 * MiB;
constexpr size_t WS_B = 110 * MiB;
constexpr size_t WS_QA = WS_B, WS_KA = WS_B + 32 * MiB, WS_VA = WS_B + 64 * MiB, WS_QB = WS_B + 96 * MiB, WS_KB = WS_B + 128 * MiB, WS_VB = WS_B + 160 * MiB;
constexpr size_t WS_IQ = WS_B + 192 * MiB, WS_IK = WS_B + 224 * MiB, WS_IW = WS_B + 228 * MiB;
constexpr size_t WS_OAB8 = WS_IQ;
constexpr size_t WS_MRG = WS_KA;
constexpr size_t WS_HID = WS_B, WS_Y = WS_B + 72 * MiB;
constexpr size_t WS_P = 342 * MiB + 64 * MiB;
constexpr size_t WS_X1B = WS_B + 140 * MiB;
constexpr size_t WS_C = 342 * MiB;
constexpr size_t WS_GA = WS_C, WS_GB = WS_C + 64 * MiB;
constexpr size_t WS_WGU = WS_C, WS_WDN = WS_C + 32 * MiB;
constexpr size_t WS_MASK = 470 * MiB;
constexpr size_t WS_ST = 486 * MiB;
constexpr size_t WS_END = 502 * MiB;
constexpr int CW_BAR = 4096;
constexpr int CW_CNT = 16384;
constexpr int CW_HID = 40960;
constexpr int CW_IDXQ = 51200;
constexpr int CW_FIN = 32768;
constexpr int RING_OFF = 0, RING_BYTES = 131072;
constexpr int TBL_OFF = RING_BYTES, TBL_BYTES = 28672;
constexpr int LDSCTL_OFF = TBL_OFF + TBL_BYTES, MISC_OFF = LDSCTL_OFF + 320;
constexpr int LDS_BYTES = 163840;
static_assert(MISC_OFF + 128 <= LDS_BYTES, "LDS map");

#define GAS __attribute__((address_space(1)))
#define LAS __attribute__((address_space(3)))
typedef unsigned short bf16;
typedef unsigned v4u __attribute__((ext_vector_type(4)));
typedef float f32x4 __attribute__((ext_vector_type(4)));
typedef short bf16x8 __attribute__((ext_vector_type(8)));
typedef GAS unsigned gu32;
typedef GAS unsigned long long gu64;
#define RLX_AGENT __ATOMIC_RELAXED, __HIP_MEMORY_SCOPE_AGENT
#define LDS_WAIT() asm volatile("s_waitcnt lgkmcnt(0)" ::: "memory")
#define VM_WAIT() asm volatile("s_waitcnt vmcnt(0)" ::: "memory")
__device__ __forceinline__ unsigned long long rt() { return __builtin_amdgcn_s_memrealtime(); }
__device__ __forceinline__ unsigned f2bf(float f) { unsigned u = __builtin_bit_cast(unsigned, f); return (u + 0x7fffu + ((u >> 16) & 1u)) >> 16; }
__device__ __forceinline__ unsigned pk2(float lo, float hi) { return f2bf(lo) | (f2bf(hi) << 16); }

#define XB_TMO      128
#define XB_XCNT(j)  (256  + 64 * (j))
#define XB_XSUB(j)  (1280 + 64 * (j))
#define XB_XGEN(j)  (2304 + 64 * (j))
#define XB_TOP      3328
#define XB_TOPGEN   3392
#define XCD_BAR_WORDS 3456
#define XB_SPIN_CAP (1u << 18)

__device__ __forceinline__ unsigned xb_ld(unsigned* p)              { return __hip_atomic_load(p, __ATOMIC_RELAXED, __HIP_MEMORY_SCOPE_AGENT); }
__device__ __forceinline__ unsigned xb_add(unsigned* p, unsigned v) { return __hip_atomic_fetch_add(p, v, __ATOMIC_RELAXED, __HIP_MEMORY_SCOPE_AGENT); }
__device__ __forceinline__ unsigned xb_xcc_id() { return (unsigned)__builtin_amdgcn_s_getreg((3 << 11) | 20) & 0xFu; }
#define XB_SPIN(cond, bar) do { unsigned _sp = 0; while (cond) { __builtin_amdgcn_s_sleep(1); \
    if ((++_sp & 255u) == 0u) { if (xb_ld(&(bar)[XB_TMO])) break; if (_sp > XB_SPIN_CAP) { atomicAdd(&(bar)[XB_TMO], 1u); break; } } } } while (0)

struct XcdBarrier {
    unsigned* bar; unsigned x;
    volatile LAS unsigned* st;
};

__device__ __forceinline__ XcdBarrier xcd_barrier_post(unsigned* bar, volatile LAS unsigned* st, int xb_tid) {
    XcdBarrier b; b.bar = bar; b.x = xb_xcc_id(); b.st = st;
    if (xb_tid == 0) (void)xb_add(&bar[XB_XCNT(b.x)], 1u);
    return b;
}
__device__ __forceinline__ void xcd_barrier_complete(unsigned* bar, unsigned x, unsigned& nloc, unsigned& nx) {
    const unsigned G = gridDim.x * gridDim.y * gridDim.z;
    unsigned sum, cnt, mine, sp = 0u;
    for (;;) {
        sum = 0u; cnt = 0u; mine = 0u;
#pragma unroll
        for (unsigned j = 0; j < 16; ++j) { const unsigned c = xb_ld(&bar[XB_XCNT(j)]); sum += c; cnt += (c > 0u) ? 1u : 0u; mine = (j == x) ? c : mine; }
        if (sum == G) break;
        __builtin_amdgcn_s_sleep(1);
        if ((++sp & 255u) == 0u) { if (xb_ld(&bar[XB_TMO])) break; if (sp > XB_SPIN_CAP) { atomicAdd(&bar[XB_TMO], 1u); break; } }
    }
    nloc = mine > 0u ? mine : 1u; nx = cnt > 0u ? cnt : 1u;
}

__device__ __forceinline__ void xcd_barrier(const XcdBarrier& b, int xb_tid) {
    asm volatile("s_waitcnt vmcnt(0)" ::: "memory");
    __syncthreads();
    if (xb_tid == 0) {
        unsigned* bar = b.bar;
        __builtin_amdgcn_s_waitcnt(0);
        unsigned nloc = b.st[0], nx = b.st[1];
        if (nloc == 0u) { xcd_barrier_complete(bar, b.x, nloc, nx); b.st[0] = nloc; b.st[1] = nx; }
        const unsigned old = xb_add(&bar[XB_XSUB(b.x)], 1u);
        const unsigned gen = old / nloc;
        if (old + 1u == (gen + 1u) * nloc) {
            __builtin_amdgcn_fence(__ATOMIC_RELEASE, "agent");
            asm volatile("s_waitcnt vmcnt(0)" ::: "memory");
            const unsigned og = xb_add(&bar[XB_TOP], 1u);
            const unsigned tg = og / nx;
            if (og + 1u == (tg + 1u) * nx) xb_add(&bar[XB_TOPGEN], 1u);
            else XB_SPIN(xb_ld(&bar[XB_TOPGEN]) == tg, bar);
            __builtin_amdgcn_fence(__ATOMIC_ACQUIRE, "agent");
            xb_add(&bar[XB_XGEN(b.x)], 1u);
            asm volatile("s_waitcnt vmcnt(0)" ::: "memory");
        } else {
            XB_SPIN(xb_ld(&bar[XB_XGEN(b.x)]) == gen, bar);
            __builtin_amdgcn_fence(__ATOMIC_ACQUIRE, "agent");
            asm volatile("s_waitcnt vmcnt(0)" ::: "memory");
        }
    }
    __syncthreads();
}

struct Frame {
    LAS unsigned char* lds;
    volatile LAS unsigned* MISC;
    gu32* ctl;
    int tid, lane, wave;
    int vcu, G;
};
__device__ __forceinline__ float dpp_f(float v, const int ctrl) { return v; }
#define DPP_ADD(v, ctrl) ((v) + __builtin_bit_cast(float, __builtin_amdgcn_update_dpp(0, __builtin_bit_cast(int, (v)), (ctrl), 0xF, 0xF, false)))
__device__ __forceinline__ float wave_sum(float v) {
    v = DPP_ADD(v, 0xB1);
    v = DPP_ADD(v, 0x4E);
    v = DPP_ADD(v, 0x141);
    v = DPP_ADD(v, 0x140);
    { auto r = __builtin_amdgcn_permlane16_swap(__float_as_uint(v), __float_as_uint(v), false, false); v = __uint_as_float(r[0]) + __uint_as_float(r[1]); }
    { auto r = __builtin_amdgcn_permlane32_swap(__float_as_uint(v), __float_as_uint(v), false, false); v = __uint_as_float(r[0]) + __uint_as_float(r[1]); }
    return v;
}
template <class RowMap> __device__ __forceinline__ void transpose_item(const float* W, int K, int N, bf16* WT, const RowMap& RM, LAS float* scr, int item, int lane) {
    const int nblk = (N + 31) / 32, kb = item / nblk, nb = item % nblk, k0 = 64 * kb, n0 = 32 * nb;
    const int nsrc = n0 + (lane & 31); const bool okc = nsrc < N;
#pragma unroll 16
    for (int i = 0; i < 32; ++i) { const int kk = 2 * i + (lane >> 5); scr[kk * 33 + (lane & 31)] = okc ? W[(size_t)(k0 + kk) * N + nsrc] : 0.f; }
    LDS_WAIT(); asm volatile("" ::: "memory");
    const int c = lane & 7;
#pragma unroll
    for (int j = 0; j < 4; ++j) { const int n = (lane >> 3) + 8 * j; const LAS float* s = scr + (8 * c) * 33 + n;
        v4u o; o.x = pk2(s[0 * 33], s[1 * 33]); o.y = pk2(s[2 * 33], s[3 * 33]); o.z = pk2(s[4 * 33], s[5 * 33]); o.w = pk2(s[6 * 33], s[7 * 33]);
        const int drow = (n0 + n < N) ? RM(n0 + n) : -1;
        if (drow >= 0) *(GAS v4u*)(WT + (size_t)drow * K + k0 + 8 * c) = o; }
    LDS_WAIT(); asm volatile("" ::: "memory");
}
template <class RowMap> __device__ __forceinline__ void transpose_item8(const float* W, int K, int N, unsigned char* WT, const RowMap& RM, float sc, LAS float* scr, int item, int lane) {
    const int nblk = (N + 31) / 32, kb = item / nblk, nb = item % nblk, k0 = 64 * kb, n0 = 32 * nb;
    const int nsrc = n0 + (lane & 31); const bool okc = nsrc < N;
#pragma unroll 16
    for (int i = 0; i < 32; ++i) { const int kk = 2 * i + (lane >> 5); scr[kk * 33 + (lane & 31)] = okc ? W[(size_t)(k0 + kk) * N + nsrc] * sc : 0.f; }
    LDS_WAIT(); asm volatile("" ::: "memory");
    const int c = lane & 7;
#pragma unroll
    for (int j = 0; j < 4; ++j) { const int n = (lane >> 3) + 8 * j; const LAS float* s = scr + (8 * c) * 33 + n;
        const pg8::u32x2 o = pg8::pack8_fp8((f32x4){s[0 * 33], s[1 * 33], s[2 * 33], s[3 * 33]}, (f32x4){s[4 * 33], s[5 * 33], s[6 * 33], s[7 * 33]});
        const int drow = (n0 + n < N) ? RM(n0 + n) : -1;
        if (drow >= 0) *(GAS pg8::u32x2*)(WT + (size_t)drow * K + k0 + 8 * c) = o; }
    LDS_WAIT(); asm volatile("" ::: "memory");
}
template <class RowMap> __device__ __forceinline__ void transpose_item_split(const float* W, int K, int N, bf16* WT, unsigned char* WT8, const RowMap& RM, LAS float* scr, int item, int lane) {
    const int nblk = (N + 31) / 32, kb = item / nblk, nb = item % nblk, k0 = 64 * kb, n0 = 32 * nb;
    const int nsrc = n0 + (lane & 31); const bool okc = nsrc < N;
#pragma unroll 16
    for (int i = 0; i < 32; ++i) { const int kk = 2 * i + (lane >> 5); scr[kk * 33 + (lane & 31)] = okc ? W[(size_t)(k0 + kk) * N + nsrc] : 0.f; }
    LDS_WAIT(); asm volatile("" ::: "memory");
    const int c = lane & 7;
#pragma unroll
    for (int j = 0; j < 4; ++j) { const int n = (lane >> 3) + 8 * j; const LAS float* s = scr + (8 * c) * 33 + n;
        const int drow = (n0 + n < N) ? RM(n0 + n) : -1;
        if (drow >= 0) { v4u o; o.x = pk2(s[0 * 33], s[1 * 33]); o.y = pk2(s[2 * 33], s[3 * 33]); o.z = pk2(s[4 * 33], s[5 * 33]); o.w = pk2(s[6 * 33], s[7 * 33]); *(GAS v4u*)(WT + (size_t)drow * K + k0 + 8 * c) = o; }
        else if (drow <= -2) { const pg8::u32x2 o = pg8::pack8_fp8((f32x4){s[0 * 33] * 32.f, s[1 * 33] * 32.f, s[2 * 33] * 32.f, s[3 * 33] * 32.f}, (f32x4){s[4 * 33] * 32.f, s[5 * 33] * 32.f, s[6 * 33] * 32.f, s[7 * 33] * 32.f});
            *(GAS pg8::u32x2*)(WT8 + (size_t)(-2 - drow) * K + k0 + 8 * c) = o; } }
    LDS_WAIT(); asm volatile("" ::: "memory");
}
struct RmIdent { __device__ __forceinline__ int operator()(int n) const { return n; } };
struct RmWin { __device__ __forceinline__ int operator()(int n) const {
    if (n < 1024) return -2 - (n + 4096);
    if (n < 1536) return -2 - (n - 1024);
    if (n < 2560) return -2 - (n - 1536 + 3072);
    if (n < 3072) return -2 - (n - 2560 + 512);
    if (n < 3656) return n - 3072;
    { const int c = n - 3656, g = c >> 10, cc = c & 1023; return -2 - (1024 + 256 * (cc >> 7) + 128 * g + (cc & 127)); } } };
struct RmGate { int up; __device__ __forceinline__ int operator()(int n) const { return 256 * (n >> 7) + 128 * up + (n & 127); } };

__device__ __forceinline__ void conv_load(const float* W, int N, int nblk, int item, int lane, float (&t)[32]) {
    const int kb = item / nblk, nb = item - kb * nblk;
    int n = 32 * nb + (lane & 31); n = n < N ? n : N - 1;
    const GAS float* src = (const GAS float*)W + (size_t)(64 * kb + 32 * (lane >> 5)) * N + n;
#pragma unroll
    for (int i = 0; i < 32; ++i) t[i] = src[(size_t)i * N];
}
struct MoeItem { const float* W; int K, N, nblk, r, mode; unsigned char* d; };
__device__ __forceinline__ MoeItem moe_item(int it, const float* wg, const float* wu, const float* wd, unsigned char* Wgu, unsigned char* Wdn) {
    const int e = it / 768; int r = it - e * 768; MoeItem m;
    m.W = wg + (size_t)e * DMODEL * DEXP; m.K = DMODEL; m.N = DEXP; m.nblk = 16; m.mode = 0; m.d = Wgu + (size_t)e * DMODEL * DMODEL;
    if (r >= 256) { r -= 256; m.W = wu + (size_t)e * DMODEL * DEXP; m.mode = 1;
        if (r >= 256) { r -= 256; m.W = wd + (size_t)e * DEXP * DMODEL; m.K = DEXP; m.N = DMODEL; m.nblk = 32; m.mode = 2; m.d = Wdn + (size_t)e * DMODEL * DEXP; } }
    m.r = r; return m; }
struct RmMoe { int mode; __device__ __forceinline__ int operator()(int n) const { return mode == 2 ? n : 256 * (n >> 7) + 128 * mode + (n & 127); } };
template <int MODE, class RowMap> __device__ __forceinline__ void conv_store(int K, int N, int nblk, int item, int lane, unsigned char* d16, unsigned char* d8, const RowMap& RM, float sc, const float (&t)[32], int ldk = 0) {
    const int kb = item / nblk, nb = item - kb * nblk;
    const int n = 32 * nb + (lane & 31); const int kq = 64 * kb + 32 * (lane >> 5);
    if (n < N) { const int drow = RM(n);
        if (MODE == 1 || (MODE == 2 && drow < 0)) { const int row = (MODE == 1) ? drow : -2 - drow; const float q = (MODE == 1) ? sc : 32.f;
            unsigned w[8];
#pragma unroll
            for (int j = 0; j < 8; ++j) { int w_ = __builtin_amdgcn_cvt_pk_fp8_f32(t[4 * j] * q, t[4 * j + 1] * q, 0, false); w_ = __builtin_amdgcn_cvt_pk_fp8_f32(t[4 * j + 2] * q, t[4 * j + 3] * q, w_, true); w[j] = (unsigned)w_; }
            GAS v4u* o = (GAS v4u*)(d8 + (size_t)row * (ldk ? ldk : K) + kq); o[0] = (v4u){w[0], w[1], w[2], w[3]}; o[1] = (v4u){w[4], w[5], w[6], w[7]}; }
        else { unsigned w[16];
#pragma unroll
            for (int j = 0; j < 16; ++j) w[j] = pg8::cvt_pk_bf16(t[2 * j], t[2 * j + 1]);
            GAS v4u* o = (GAS v4u*)(d16 + ((size_t)drow * K + kq) * 2);
#pragma unroll
            for (int j = 0; j < 4; ++j) o[j] = (v4u){w[4 * j], w[4 * j + 1], w[4 * j + 2], w[4 * j + 3]}; } }
}

__device__ __forceinline__ void rms_row_to_bf16(const float* xrow, const float* g, bf16* orow, unsigned char* orow8, int lane) {
    const GAS f32x4* xr = (const GAS f32x4*)xrow + lane; const GAS f32x4* gr = (const GAS f32x4*)g + lane;
    f32x4 v[4]; float s = 0.f;
#pragma unroll
    for (int j = 0; j < 4; ++j) { v[j] = xr[64 * j]; s += (v[j].x * v[j].x + v[j].y * v[j].y) + (v[j].z * v[j].z + v[j].w * v[j].w); }
    const float rinv = 1.0f / sqrtf(wave_sum(s) * (1.f / DMODEL) + RMS_EPS);
    GAS unsigned long long* o8 = (GAS unsigned long long*)orow + lane;
    GAS unsigned* o4 = (GAS unsigned*)orow8 + lane;
#pragma unroll
    for (int j = 0; j < 4; ++j) { const f32x4 gg = gr[64 * j]; const f32x4 h = (f32x4){v[j].x * rinv * gg.x, v[j].y * rinv * gg.y, v[j].z * rinv * gg.z, v[j].w * rinv * gg.w};
        o8[64 * j] = (unsigned long long)pk2(h.x, h.y) | ((unsigned long long)pk2(h.z, h.w) << 32);
        int w_ = __builtin_amdgcn_cvt_pk_fp8_f32(h.x, h.y, 0, false); w_ = __builtin_amdgcn_cvt_pk_fp8_f32(h.z, h.w, w_, true); o4[64 * j] = (unsigned)w_; }
}

struct MoeTbl {
    static constexpr int RB0 = 0;
    static constexpr int UNITS = 256;
    static constexpr int ROWOFF = 512;
    static constexpr int ROWW = 512 + 8192;
};
struct MoeOrder {
    const LAS int* units; const LAS unsigned* rowoff; int n; size_t estride; unsigned* publish; unsigned* ready;
    __device__ __forceinline__ bool next(int i, pg8::Unit& u) const { if (i >= n) return false; u.pm = units[4 * i]; u.pn = units[4 * i + 1]; u.e = units[4 * i + 2]; u.valid = units[4 * i + 3]; u.boff = (size_t)u.e * estride; return true; }
    __device__ __forceinline__ void a_ready(const pg8::Unit& u, int wid, int lane) const {
        if (ready == nullptr) return;
        if (wid == 0) { unsigned sp = 0;
            while ((unsigned)__builtin_amdgcn_readfirstlane((int)__hip_atomic_load(ready + 16 * u.pm, __ATOMIC_RELAXED, __HIP_MEMORY_SCOPE_AGENT)) < 32u) { __builtin_amdgcn_s_sleep(2); if (++sp > (1u << 22)) break; }
            __builtin_amdgcn_fence(__ATOMIC_ACQUIRE, "agent"); asm volatile("s_waitcnt vmcnt(0)" ::: "memory"); }
        asm volatile("" ::: "memory"); __builtin_amdgcn_s_barrier(); asm volatile("" ::: "memory"); (void)lane; }
    __device__ __forceinline__ void done(const pg8::Unit& u, int, int lane) const {
        if (publish == nullptr) return;
        asm volatile("s_waitcnt vmcnt(0)" ::: "memory");
        if (lane == 0) (void)__hip_atomic_fetch_add(publish + 16 * u.pm, 1u, __ATOMIC_RELAXED, __HIP_MEMORY_SCOPE_AGENT); }
    __device__ __forceinline__ unsigned arow(int ui, int r) const { return rowoff[ui * 256 + r]; }
};
__device__ __forceinline__ int moe_build(Frame& F, const int* cnt_g, const int* ltok, const float* lw, int mode) {
    LAS int* rb0 = (LAS int*)(F.lds + TBL_OFF + MoeTbl::RB0); LAS int* units = (LAS int*)(F.lds + TBL_OFF + MoeTbl::UNITS);
    LAS unsigned* rowoff = (LAS unsigned*)(F.lds + TBL_OFF + MoeTbl::ROWOFF); LAS float* roww = (LAS float*)(F.lds + TBL_OFF + MoeTbl::ROWW);
    LAS int* cn = (LAS int*)(F.lds + TBL_OFF + MoeTbl::ROWW + 8192);
    if (F.tid < 32) cn[F.tid] = __hip_atomic_load(cnt_g + F.tid, __ATOMIC_RELAXED, __HIP_MEMORY_SCOPE_AGENT);
    LDS_WAIT(); __syncthreads();
    if (F.tid == 0) { int s = 0; for (int e = 0; e < 32; ++e) { rb0[e] = s; s += (cn[e] + 255) >> 8; } rb0[32] = s; }
    LDS_WAIT(); __syncthreads();
    const int NB = rb0[32]; int n = 0;
    const int U_ = 4 * NB, full_ = U_ / F.G, r_ = U_ - full_ * F.G;
    for (int i = 0; i < 8; ++i) { int L = i * F.G + (int)blockIdx.x;
        if (mode == 1 && i == full_) { const int j_ = ((int)blockIdx.x - r_ + F.G) % F.G; L = (j_ < r_) ? full_ * F.G + j_ : U_; }
        if (L >= U_) break; n = i + 1;
        const int rb = L >> 2, t = L & 3; int e = 0;
        for (int k = 1; k < 32; ++k) if (rb0[k] <= rb) e = k;
        const int jb = rb - rb0[e]; const int valid = min(256, cn[e] - 256 * jb);
        if (F.tid == 0) { units[4 * i] = rb; units[4 * i + 1] = t; units[4 * i + 2] = e; units[4 * i + 3] = valid; }
        if (F.tid < 256) { const int r = F.tid; const int src = e * 32768 + 256 * jb + (r < valid ? r : 0); const int tk = ltok[src];
            if (mode == 0) rowoff[i * 256 + r] = (unsigned)(tk >> 1) * (unsigned)DMODEL;
            else { rowoff[i * 256 + r] = (r < valid) ? (unsigned)tk : (unsigned)(2 * TOK); roww[i * 256 + r] = (r < valid) ? lw[src] : 0.f; } }
    }
    VM_WAIT(); LDS_WAIT(); __syncthreads();
    return n;
}

struct Args { const float* in[19]; float* out; unsigned char* ws; int ph_lo, ph_hi; };
typedef __attribute__((address_space(4))) const Args CArgs;
__device__ __forceinline__ CArgs* phase_args() { CArgs* p = (CArgs*)__builtin_amdgcn_kernarg_segment_ptr(); asm volatile("" : "+s"(p)); return p; }
__global__ void __launch_bounds__(NWAVES * 64, 2) fwd(Args args) {
    extern __shared__ __attribute__((aligned(16))) unsigned char lds[];
    Frame F0; Frame& F = F0;
    F.lds = (LAS unsigned char*)lds;
    F.MISC = (volatile LAS unsigned*)(F.lds + MISC_OFF);
    const int wv0 = __builtin_amdgcn_readfirstlane((int)threadIdx.x >> 6);
#define HW_TID() ([&]() { unsigned z_ = 0u; asm volatile("" : "+v"(z_)); return 64 * wv0 + (int)__builtin_amdgcn_mbcnt_hi(~0u, __builtin_amdgcn_mbcnt_lo(~0u, z_)); }())
    F.tid = HW_TID(); F.lane = F.tid & 63; F.wave = wv0;
    F.G = gridDim.x; { const int bx = blockIdx.x; F.vcu = (F.G % 8 == 0) ? (bx % 8) * (F.G / 8) + bx / 8 : bx; }
    F.ctl = (gu32*)(args.ws + WS_CTL);
    for (int u = F.tid; u < (LDS_BYTES - LDSCTL_OFF) / 4; u += NWAVES * 64) ((LAS unsigned*)(F.lds + LDSCTL_OFF))[u] = 0u;
    __syncthreads();
    if (N_LAUNCHES == 1) (void)xcd_barrier_post((unsigned*)(F.ctl + CW_BAR), F.MISC + 8, F.tid);
#define GRID_BAR() do { if (N_LAUNCHES == 1) { XcdBarrier b_; b_.bar = (unsigned*)(F.ctl + CW_BAR); b_.x = xb_xcc_id(); b_.st = F.MISC + 8; xcd_barrier(b_, F.tid); } } while (0)
#ifndef PROBE_BLK
#define PROBE_BLK 0
#endif
#if defined(PROBE_A)
    unsigned long long* const ts_ = (unsigned long long*)(args.ws + 2 * MiB + 512 * 1024);
    if (blockIdx.x == 0 && F.tid == 0) { for (int i_ = 24; i_ < 34; ++i_) ts_[i_] = 0; ts_[0] = __builtin_amdgcn_s_memrealtime(); }
#define STAMP(k) do { if (blockIdx.x == 0 && F.tid == 0) ts_[(k) + 1] = __builtin_amdgcn_s_memrealtime(); } while (0)
#else
#define STAMP(k) do { } while (0)
#endif
    const int lo = (N_LAUNCHES == 1) ? 0 : args.ph_lo, hi = (N_LAUNCHES == 1) ? (int)PH_COUNT : args.ph_hi;
#ifndef PHASE_MASK
#define PHASE_MASK 0xFFF
#endif
#define IN(k) ((((PHASE_MASK) >> (k)) & 1) && lo <= (k) && (k) < hi)
#define BOTH(k) (IN(k) && IN((k) + 1))
#define Win_t ((bf16*)(ws + WS_WIN))
#define BrA_t ((bf16*)(ws + WS_BRA))
#define BrB_t ((bf16*)(ws + WS_BRB))
#define Wout_t ((bf16*)(ws + WS_WOUT))
#define Wpg_t ((bf16*)(ws + WS_WPG))
#define Wpp_t ((bf16*)(ws + WS_WPP))
#define PB ((bf16*)(ws + WS_PB))
#define HA ((bf16*)(ws + WS_A))
#define ropec ((float*)(ws + WS_ROPEC))
#define ropes ((float*)(ws + WS_ROPES))
#define kmean ((float*)(ws + WS_KMEAN))
#define cnt_g ((int*)(ws + WS_CTL + 4 * CW_CNT))
#define ltok ((int*)(ws + WS_LTOK))
#define lwt ((float*)(ws + WS_LW))
    if (IN(PH_PRO)) {
        CArgs& args = *phase_args(); unsigned char* const ws = args.ws; float* const out = args.out; const float* const x = args.in[0]; (void)x; (void)out;
        Frame F; { int t_ = HW_TID(); asm volatile("" : "+v"(t_)); F.tid = t_; F.lane = t_ & 63; F.wave = __builtin_amdgcn_readfirstlane(t_ >> 6);
          unsigned l_ = (unsigned)(uintptr_t)lds; asm volatile("" : "+s"(l_)); F.lds = (LAS unsigned char*)l_; F.MISC = (volatile LAS unsigned*)(F.lds + MISC_OFF); F.ctl = (gu32*)(ws + WS_CTL);
          int g_ = (int)gridDim.x; asm volatile("" : "+s"(g_)); F.G = g_; const int bx = blockIdx.x; F.vcu = (F.G % 8 == 0) ? (bx % 8) * (F.G / 8) + bx / 8 : bx; }
        const int gw = F.vcu * NWAVES + F.wave, NGW = F.G * NWAVES; (void)gw; (void)NGW;
        constexpr int I_IN = 16 * 179, I_BR = 8 * 32, I_O = 16 * 32, I_PP = 4 * 32;
        constexpr int NITEMS = I_IN + 2 * I_BR + 2 * I_O + I_PP;
        { const int gt = F.vcu * NWAVES * 64 + F.tid, NGT = F.G * NWAVES * 64;
            for (int i = gt; i < 184 * 128; i += NGT) ((GAS v4u*)(Win_t + (size_t)584 * DMODEL))[i] = (v4u){0u, 0u, 0u, 0u};
            for (int i = gt; i < SEQ * 8; i += NGT) { const int pos = i >> 3, k = i & 7; const float inv = 1.0f / powf(500000.0f, (float)k * 0.125f); const float ang = (float)pos * inv; ropec[i] = cosf(ang); ropes[i] = sinf(ang); } }
        { const int gt = F.vcu * NWAVES * 64 + F.tid, NGT = F.G * NWAVES * 64;
          const int trips_r = (TOK - gw + 4 * NGW - 1) / (4 * NGW), trips_i = (NITEMS - gw + NGW - 1) / NGW, trips_p = (TOK * PLE / 4 + 4 * NGT - 1) / (4 * NGT);
          const int trips = max(max(trips_r, trips_i), trips_p);
          const GAS f32x4* p4 = (const GAS f32x4*)args.in[1]; GAS unsigned long long* pb8 = (GAS unsigned long long*)PB;
          f32x4 gg[4];
#pragma unroll
          for (int j = 0; j < 4; ++j) gg[j] = ((const GAS f32x4*)args.in[2] + F.lane)[64 * j];
#pragma unroll 1
          for (int b = 0; b < trips; ++b) {
              f32x4 v[4][4]; float t[32]; f32x4 pv[4];
#pragma unroll
              for (int r = 0; r < 4; ++r) { int m = gw + (4 * b + r) * NGW; m = m < TOK ? m : TOK - 1; const GAS f32x4* xr = (const GAS f32x4*)(x + (size_t)m * DMODEL) + F.lane;
#pragma unroll
                  for (int j = 0; j < 4; ++j) v[r][j] = xr[64 * j]; }
              const int it0 = gw + b * NGW; const int it = it0 < NITEMS ? it0 : NITEMS - 1; int r_ = it; int kind = 0;
              const float* W_ = args.in[3]; int K_ = DMODEL, N_ = IN_COLS; unsigned char* d_ = (unsigned char*)Win_t;
              {
                  if (r_ >= I_IN) { r_ -= I_IN; kind = 1; W_ = args.in[4]; K_ = AW; N_ = DMODEL; d_ = (unsigned char*)BrA_t;
                      if (r_ >= I_BR) { r_ -= I_BR; kind = 2; W_ = args.in[5]; d_ = (unsigned char*)BrA_t + AW;
                          if (r_ >= I_BR) { r_ -= I_BR; kind = 3; W_ = args.in[6]; K_ = DMODEL; d_ = (unsigned char*)Wout_t;
                              if (r_ >= I_O) { r_ -= I_O; kind = 4; W_ = args.in[16]; d_ = (unsigned char*)Wpg_t;
                                  if (r_ >= I_O) { r_ -= I_O; kind = 5; W_ = args.in[17]; K_ = PLE; d_ = (unsigned char*)Wpp_t; } } } } } }
              const int nblk_ = (N_ + 31) >> 5;
              conv_load(W_, N_, nblk_, r_, F.lane, t);
              if (it0 >= NITEMS) kind = -1;
#pragma unroll
              for (int j = 0; j < 4; ++j) { int i = gt + (4 * b + j) * NGT; i = i < TOK * PLE / 4 ? i : TOK * PLE / 4 - 1; pv[j] = p4[i]; }
              asm volatile("" : "+v"(v[0][0]), "+v"(v[0][1]), "+v"(v[0][2]), "+v"(v[0][3]) :: "memory");
#pragma unroll
              for (int r = 0; r < 4; ++r) { const int m = gw + (4 * b + r) * NGW; float s = 0.f;
#pragma unroll
                  for (int j = 0; j < 4; ++j) s += (v[r][j].x * v[r][j].x + v[r][j].y * v[r][j].y) + (v[r][j].z * v[r][j].z + v[r][j].w * v[r][j].w);
                  const float rstd = sqrtf(wave_sum(s) * (1.f / DMODEL) + RMS_EPS); const float rinv = 1.0f / rstd;
                  if (m < TOK && F.lane == 0) ((float*)(ws + WS_RSTD))[m] = rstd;
                  if (m < TOK) { GAS unsigned long long* o8 = (GAS unsigned long long*)(HA + (size_t)m * DMODEL) + F.lane; GAS unsigned* o4 = (GAS unsigned*)(ws + WS_H8 + (size_t)m * DMODEL) + F.lane;
#pragma unroll
                      for (int j = 0; j < 4; ++j) { const f32x4 h = (f32x4){v[r][j].x * rinv * gg[j].x, v[r][j].y * rinv * gg[j].y, v[r][j].z * rinv * gg[j].z, v[r][j].w * rinv * gg[j].w};
                          o8[64 * j] = (unsigned long long)pg8::cvt_pk_bf16(h.x, h.y) | ((unsigned long long)pg8::cvt_pk_bf16(h.z, h.w) << 32);
                          int w_ = __builtin_amdgcn_cvt_pk_fp8_f32(h.x, h.y, 0, false); w_ = __builtin_amdgcn_cvt_pk_fp8_f32(h.z, h.w, w_, true); o4[64 * j] = (unsigned)w_; } } }
              asm volatile("" ::: "memory");
              if (kind == 0) conv_store<2>(K_, N_, nblk_, r_, F.lane, (unsigned char*)Win_t, ws + WS_WIN8, RmWin{}, 32.f, t);
              else if (kind == 5) conv_store<0>(K_, N_, nblk_, r_, F.lane, d_, d_, RmIdent{}, 1.f, t);
              else if (kind > 0) conv_store<1>(K_, N_, nblk_, r_, F.lane, d_, d_, RmIdent{}, 32.f, t, (kind <= 2) ? DMODEL : 0);
#pragma unroll
              for (int j = 0; j < 4; ++j) { const int i = gt + (4 * b + j) * NGT; if (i < TOK * PLE / 4) pb8[i] = (unsigned long long)pg8::cvt_pk_bf16(pv[j].x, pv[j].y) | ((unsigned long long)pg8::cvt_pk_bf16(pv[j].z, pv[j].w) << 32); }
          } }
        if (BOTH(PH_PRO)) GRID_BAR(); STAMP(PH_PRO);
    }
    if (IN(PH_ZG)) {
        CArgs& args = *phase_args(); unsigned char* const ws = args.ws; float* const out = args.out; const float* const x = args.in[0]; (void)x; (void)out;
        Frame F; { int t_ = HW_TID(); asm volatile("" : "+v"(t_)); F.tid = t_; F.lane = t_ & 63; F.wave = __builtin_amdgcn_readfirstlane(t_ >> 6);
          unsigned l_ = (unsigned)(uintptr_t)lds; asm volatile("" : "+s"(l_)); F.lds = (LAS unsigned char*)l_; F.MISC = (volatile LAS unsigned*)(F.lds + MISC_OFF); F.ctl = (gu32*)(ws + WS_CTL);
          int g_ = (int)gridDim.x; asm volatile("" : "+s"(g_)); F.G = g_; const int bx = blockIdx.x; F.vcu = (F.G % 8 == 0) ? (bx % 8) * (F.G / 8) + bx / 8 : bx; }
        const int gw = F.vcu * NWAVES + F.wave, NGW = F.G * NWAVES; (void)gw; (void)NGW;
        { pg8::Gemm g{(const bf16*)(ws + WS_H8), (const bf16*)(ws + WS_WIN8), TOK, 5120, DMODEL}; pg8::StaticOrderTail S; S.S.init(TOK, 5120, F.G, (int)blockIdx.x);
          { const int nb = (TOK / 256) * 3, rb = nb % F.G; const bool uneven = (rb > 0) && (2 * rb == F.G) && (S.S.nwg % F.G == 0); S.full = uneven ? S.S.nwg / F.G - 1 : (1 << 20); S.cut = uneven ? rb : 0; }
          pg8::EpiZ<1> E{(bf16*)(ws + WS_QA), (bf16*)(ws + WS_KA), (bf16*)(ws + WS_VA), (bf16*)(ws + WS_QB), (bf16*)(ws + WS_KB), (bf16*)(ws + WS_VB), (bf16*)(ws + WS_IQ), (bf16*)(ws + WS_IK),
                      (bf16*)(ws + WS_GA), (bf16*)(ws + WS_GB), (float*)(ws + WS_IW), kmean, ropec, ropes};
          pg8::gemm_phase<pg8::EpiZ<1>, pg8::StaticOrderTail, true, true, false, true>(F.lds + RING_OFF, g, S, E, F.tid); }
        VM_WAIT(); __syncthreads();
        { pg8::Gemm g{HA, Win_t, TOK, 768, DMODEL}; pg8::StaticOrder S; S.init(TOK, 768, F.G, (int)blockIdx.x);
          pg8::EpiZ<0> E{(bf16*)(ws + WS_QA), (bf16*)(ws + WS_KA), (bf16*)(ws + WS_VA), (bf16*)(ws + WS_QB), (bf16*)(ws + WS_KB), (bf16*)(ws + WS_VB), (bf16*)(ws + WS_IQ), (bf16*)(ws + WS_IK),
                      (bf16*)(ws + WS_GA), (bf16*)(ws + WS_GB), (float*)(ws + WS_IW), kmean, ropec, ropes};
          pg8::gemm_phase<pg8::EpiZ<0>, pg8::StaticOrder, true, true, false, false>(F.lds + RING_OFF, g, S, E, F.tid); }
        if (BOTH(PH_ZG)) GRID_BAR(); STAMP(PH_ZG);
    }
    if (IN(PH_IDX)) {
        CArgs& args = *phase_args(); unsigned char* const ws = args.ws; float* const out = args.out; const float* const x = args.in[0]; (void)x; (void)out;
        Frame F; { int t_ = HW_TID(); asm volatile("" : "+v"(t_)); F.tid = t_; F.lane = t_ & 63; F.wave = __builtin_amdgcn_readfirstlane(t_ >> 6);
          unsigned l_ = (unsigned)(uintptr_t)lds; asm volatile("" : "+s"(l_)); F.lds = (LAS unsigned char*)l_; F.MISC = (volatile LAS unsigned*)(F.lds + MISC_OFF); F.ctl = (gu32*)(ws + WS_CTL);
          int g_ = (int)gridDim.x; asm volatile("" : "+s"(g_)); F.G = g_; const int bx = blockIdx.x; F.vcu = (F.G % 8 == 0) ? (bx % 8) * (F.G / 8) + bx / 8 : bx; }
        const int gw = F.vcu * NWAVES + F.wave, NGW = F.G * NWAVES; (void)gw; (void)NGW;
        const int b = F.vcu >> 5, jj = F.vcu & 31;
#if defined(PROBE_A)
        const unsigned long long tl0_ = __builtin_amdgcn_s_memrealtime();
#endif
        if (F.G == 256) {
            (void)jj;
            unsigned* const qh = (unsigned*)(ws + WS_CTL) + CW_IDXQ + 16 * b; volatile LAS int* const tk = (volatile LAS int*)(F.lds + MISC_OFF + 64);
            if (F.tid == 0) tk[0] = (int)__hip_atomic_fetch_add(qh, 1u, __ATOMIC_RELAXED, __HIP_MEMORY_SCOPE_AGENT);
            __syncthreads(); int t = tk[0]; __syncthreads();
#pragma unroll 1
            while (t < 256) { const int u = 255 - t;
                unsigned nx = 0u; if (F.tid == 0) nx = __hip_atomic_fetch_add(qh, 1u, __ATOMIC_RELAXED, __HIP_MEMORY_SCOPE_AGENT);
                idx::unit(b, 16 * u, (const bf16*)(ws + WS_IQ), (const bf16*)(ws + WS_IK), (const float*)(ws + WS_IW), (unsigned*)(ws + WS_MASK), (char*)lds + RING_OFF, F.tid
#if defined(PROBE_ACC)
                    , (blockIdx.x == PROBE_BLK) ? ts_ + 24 : nullptr
#endif
                    );
                if (F.tid == 0) tk[0] = (int)nx;
                __syncthreads(); t = tk[0]; __syncthreads(); }
        }
        if (BOTH(PH_IDX)) GRID_BAR(); STAMP(PH_IDX);
    }
    if (IN(PH_ATT)) {
        CArgs& args = *phase_args(); unsigned char* const ws = args.ws; float* const out = args.out; const float* const x = args.in[0]; (void)x; (void)out;
        Frame F; { int t_ = HW_TID(); asm volatile("" : "+v"(t_)); F.tid = t_; F.lane = t_ & 63; F.wave = __builtin_amdgcn_readfirstlane(t_ >> 6);
          unsigned l_ = (unsigned)(uintptr_t)lds; asm volatile("" : "+s"(l_)); F.lds = (LAS unsigned char*)l_; F.MISC = (volatile LAS unsigned*)(F.lds + MISC_OFF); F.ctl = (gu32*)(ws + WS_CTL);
          int g_ = (int)gridDim.x; asm volatile("" : "+s"(g_)); F.G = g_; const int bx = blockIdx.x; F.vcu = (F.G % 8 == 0) ? (bx % 8) * (F.G / 8) + bx / 8 : bx; }
        const int gw = F.vcu * NWAVES + F.wave, NGW = F.G * NWAVES; (void)gw; (void)NGW;
        if (F.G == 256) {
            const int bh = F.vcu >> 2, s = F.vcu & 3; const int b = bh >> 3, h = bh & 7;
#pragma unroll 1
            for (int i = 0; i < 4; ++i) { const int qb = (i == 0) ? s : (i == 1) ? 7 - s : (i == 2) ? 8 + s : 15 - s;
                att2::attn_unit<0, 8>(b, h, qb, (const bf16*)(ws + WS_QA), (const bf16*)(ws + WS_KA), (const bf16*)(ws + WS_VA), ws + WS_OAB8, kmean, (char*)lds + RING_OFF, F.tid); }
#pragma unroll 1
            for (int i = 0; i < 4; ++i) { const int qb = (i == 0) ? s : (i == 1) ? 7 - s : (i == 2) ? 8 + s : 15 - s;
                att2::attn_unit<1, 8>(b, h, qb, (const bf16*)(ws + WS_QB), (const bf16*)(ws + WS_KB), (const bf16*)(ws + WS_VB), ws + WS_OAB8 + AW, ws + WS_MASK, (char*)lds + RING_OFF, F.tid); }
        }
        if (BOTH(PH_ATT)) GRID_BAR(); STAMP(PH_ATT);
    }
    if (IN(PH_BR)) {
        CArgs& args = *phase_args(); unsigned char* const ws = args.ws; float* const out = args.out; const float* const x = args.in[0]; (void)x; (void)out;
        Frame F; { int t_ = HW_TID(); asm volatile("" : "+v"(t_)); F.tid = t_; F.lane = t_ & 63; F.wave = __builtin_amdgcn_readfirstlane(t_ >> 6);
          unsigned l_ = (unsigned)(uintptr_t)lds; asm volatile("" : "+s"(l_)); F.lds = (LAS unsigned char*)l_; F.MISC = (volatile LAS unsigned*)(F.lds + MISC_OFF); F.ctl = (gu32*)(ws + WS_CTL);
          int g_ = (int)gridDim.x; asm volatile("" : "+s"(g_)); F.G = g_; const int bx = blockIdx.x; F.vcu = (F.G % 8 == 0) ? (bx % 8) * (F.G / 8) + bx / 8 : bx; }
        const int gw = F.vcu * NWAVES + F.wave, NGW = F.G * NWAVES; (void)gw; (void)NGW;
        { pg8::Gemm g{(const bf16*)(ws + WS_OAB8), BrA_t, TOK, DMODEL, 2 * AW}; pg8::StaticOrder S; S.init(TOK, DMODEL, F.G, (int)blockIdx.x);
          pg8::EpiMerged E{(const bf16*)(ws + WS_GA), (const bf16*)(ws + WS_GB), ws + WS_MRG};
          pg8::gemm_phase<pg8::EpiMerged, pg8::StaticOrder, true, true, false, true>(F.lds + RING_OFF, g, S, E, F.tid); }
        if (BOTH(PH_BR)) GRID_BAR(); STAMP(PH_BR);
    }
    if (IN(PH_WO)) {
        CArgs& args = *phase_args(); unsigned char* const ws = args.ws; float* const out = args.out; const float* const x = args.in[0]; (void)x; (void)out;
        Frame F; { int t_ = HW_TID(); asm volatile("" : "+v"(t_)); F.tid = t_; F.lane = t_ & 63; F.wave = __builtin_amdgcn_readfirstlane(t_ >> 6);
          unsigned l_ = (unsigned)(uintptr_t)lds; asm volatile("" : "+s"(l_)); F.lds = (LAS unsigned char*)l_; F.MISC = (volatile LAS unsigned*)(F.lds + MISC_OFF); F.ctl = (gu32*)(ws + WS_CTL);
          int g_ = (int)gridDim.x; asm volatile("" : "+s"(g_)); F.G = g_; const int bx = blockIdx.x; F.vcu = (F.G % 8 == 0) ? (bx % 8) * (F.G / 8) + bx / 8 : bx; }
        const int gw = F.vcu * NWAVES + F.wave, NGW = F.G * NWAVES; (void)gw; (void)NGW;
        pg8::Gemm g{(const bf16*)(ws + WS_MRG), Wout_t, TOK, DMODEL, DMODEL}; pg8::StaticOrder S; S.init(TOK, DMODEL, F.G, (int)blockIdx.x);
        pg8::EpiResidualB E{HA, (const float*)(ws + WS_RSTD), args.in[2], (bf16*)(ws + WS_X1B)};
        pg8::gemm_phase<pg8::EpiResidualB, pg8::StaticOrder, true, true, false, true>(F.lds + RING_OFF, g, S, E, F.tid);
        if (BOTH(PH_WO)) GRID_BAR(); STAMP(PH_WO);
    }
    if (IN(PH_RT)) {
        CArgs& args = *phase_args(); unsigned char* const ws = args.ws; float* const out = args.out; const float* const x = args.in[0]; (void)x; (void)out;
        Frame F; { int t_ = HW_TID(); asm volatile("" : "+v"(t_)); F.tid = t_; F.lane = t_ & 63; F.wave = __builtin_amdgcn_readfirstlane(t_ >> 6);
          unsigned l_ = (unsigned)(uintptr_t)lds; asm volatile("" : "+s"(l_)); F.lds = (LAS unsigned char*)l_; F.MISC = (volatile LAS unsigned*)(F.lds + MISC_OFF); F.ctl = (gu32*)(ws + WS_CTL);
          int g_ = (int)gridDim.x; asm volatile("" : "+s"(g_)); F.G = g_; const int bx = blockIdx.x; F.vcu = (F.G % 8 == 0) ? (bx % 8) * (F.G / 8) + bx / 8 : bx; }
        const int gw = F.vcu * NWAVES + F.wave, NGW = F.G * NWAVES; (void)gw; (void)NGW;
        LAS float* WT = (LAS float*)(F.lds);
        LAS int* lcnt = (LAS int*)(F.lds + 147456);
        LAS int* rinfo = (LAS int*)(F.lds + 147456 + 256);
        { const GAS f32x4* wg4 = (const GAS f32x4*)args.in[8]; const GAS f32x4* wr4 = (const GAS f32x4*)args.in[10];
          for (int i = F.tid; i < DMODEL; i += NWAVES * 64) { const f32x4 v = wg4[i]; WT[0 * DMODEL + i] = v.x; WT[1 * DMODEL + i] = v.y; WT[2 * DMODEL + i] = v.z; WT[3 * DMODEL + i] = v.w; }
#pragma unroll 4
          for (int i = F.tid; i < DMODEL * 8; i += NWAVES * 64) { const f32x4 v = wr4[i]; const int k = i >> 3, c = 4 + 4 * (i & 7); WT[(c + 0) * DMODEL + k] = v.x; WT[(c + 1) * DMODEL + k] = v.y; WT[(c + 2) * DMODEL + k] = v.z; WT[(c + 3) * DMODEL + k] = v.w; } }
        if (F.tid < 64) lcnt[F.tid] = 0;
        VM_WAIT(); LDS_WAIT(); __syncthreads();
        const int chunk = F.vcu;
        if (F.G == 256) {
            constexpr int NMI = NEXP * 768;
            unsigned long long vn[2][4];
#pragma unroll
            for (int t = 0; t < 2; ++t) { const GAS unsigned long long* xr = (const GAS unsigned long long*)((const bf16*)(ws + WS_X1B) + (size_t)(chunk * 128 + F.wave * 16 + t) * DMODEL) + F.lane;
#pragma unroll
                for (int j = 0; j < 4; ++j) vn[t][j] = xr[64 * j]; }
#pragma unroll 1
            for (int rr = 0; rr < 8; ++rr) { const int rloc = F.wave * 16 + 2 * rr; const int row = chunk * 128 + rloc;
                const GAS f32x4* gr = (const GAS f32x4*)args.in[7] + F.lane;
                f32x4 v[2][4]; float rinv[2]; float t_[32];
#pragma unroll
                for (int t = 0; t < 2; ++t)
#pragma unroll
                    for (int j = 0; j < 4; ++j) { const unsigned lo_ = (unsigned)vn[t][j], hi_ = (unsigned)(vn[t][j] >> 32); v[t][j] = (f32x4){pg8::bf_lo(lo_), pg8::bf_hi(lo_), pg8::bf_lo(hi_), pg8::bf_hi(hi_)}; }
                { const int rown = row + (rr < 7 ? 2 : 0);
#pragma unroll
                  for (int t = 0; t < 2; ++t) { const GAS unsigned long long* xr = (const GAS unsigned long long*)((const bf16*)(ws + WS_X1B) + (size_t)(rown + t) * DMODEL) + F.lane;
#pragma unroll
                      for (int j = 0; j < 4; ++j) vn[t][j] = xr[64 * j]; } }
                const int it0 = gw + rr * NGW; const MoeItem mi = moe_item(it0 < NMI ? it0 : NMI - 1, args.in[12], args.in[13], args.in[14], ws + WS_WGU, ws + WS_WDN);
                conv_load(mi.W, mi.N, mi.nblk, mi.r, F.lane, t_);
                asm volatile("" : "+v"(v[0][0]), "+v"(v[0][1]), "+v"(v[0][2]), "+v"(v[0][3]) :: "memory");
#pragma unroll
                for (int t = 0; t < 2; ++t) { float s = 0.f;
#pragma unroll
                    for (int j = 0; j < 4; ++j) s += (v[t][j].x * v[t][j].x + v[t][j].y * v[t][j].y) + (v[t][j].z * v[t][j].z + v[t][j].w * v[t][j].w);
                    rinv[t] = 1.0f / sqrtf(wave_sum(s) * (1.f / DMODEL) + RMS_EPS); }
#pragma unroll
                for (int t = 0; t < 2; ++t) { GAS unsigned* o4 = (GAS unsigned*)((unsigned char*)HA + (size_t)(row + t) * DMODEL) + F.lane;
#pragma unroll
                    for (int j = 0; j < 4; ++j) { const f32x4 gg = gr[64 * j]; v[t][j] = v[t][j] * rinv[t] * gg;
                        int w_ = __builtin_amdgcn_cvt_pk_fp8_f32(v[t][j].x, v[t][j].y, 0, false); w_ = __builtin_amdgcn_cvt_pk_fp8_f32(v[t][j].z, v[t][j].w, w_, true); o4[64 * j] = (unsigned)w_; } }
                float gl[2][4];
#pragma unroll
                for (int c = 0; c < 4; ++c) { float a0 = 0.f, a1 = 0.f;
#pragma unroll
                    for (int j = 0; j < 4; ++j) { const f32x4 w = *(const LAS f32x4*)(WT + c * DMODEL + 256 * j + 4 * F.lane);
                        a0 += (v[0][j].x * w.x + v[0][j].y * w.y) + (v[0][j].z * w.z + v[0][j].w * w.w); a1 += (v[1][j].x * w.x + v[1][j].y * w.y) + (v[1][j].z * w.z + v[1][j].w * w.w); }
                    gl[0][c] = wave_sum(a0) + args.in[9][c]; gl[1][c] = wave_sum(a1) + args.in[9][c]; }
#pragma unroll
                for (int t = 0; t < 2; ++t) {
                    int g = 0; float gm = gl[t][0];
#pragma unroll
                    for (int c = 1; c < 4; ++c) if (gl[t][c] > gm) { gm = gl[t][c]; g = c; }
                    g = __builtin_amdgcn_readfirstlane(g);
                    float den = 0.f;
#pragma unroll
                    for (int c = 0; c < 4; ++c) den += expf(gl[t][c] - gm);
                    const float pg = 1.0f / den;
                    float el[8];
#pragma unroll
                    for (int c = 0; c < 8; ++c) { float a = 0.f; const LAS float* wp = WT + (4 + 8 * g + c) * DMODEL + 4 * F.lane;
#pragma unroll
                        for (int j = 0; j < 4; ++j) { const f32x4 w = *(const LAS f32x4*)(wp + 256 * j); a += (v[t][j].x * w.x + v[t][j].y * w.y) + (v[t][j].z * w.z + v[t][j].w * w.w); }
                        el[c] = wave_sum(a) + args.in[11][8 * g + c]; }
                    int i1 = 0; float v1 = el[0];
#pragma unroll
                    for (int c = 1; c < 8; ++c) if (el[c] > v1) { v1 = el[c]; i1 = c; }
                    int i2 = -1; float v2 = -INFINITY;
#pragma unroll
                    for (int c = 0; c < 8; ++c) if (c != i1 && el[c] > v2) { v2 = el[c]; i2 = c; }
                    const float e2 = expf(v2 - v1); const float w1 = pg / (1.0f + e2), w2 = pg * e2 / (1.0f + e2);
                    if (F.lane == 0) { const int e1 = 8 * g + i1, ee2 = 8 * g + i2;
                        const int p1 = __hip_atomic_fetch_add(lcnt + e1, 1, __ATOMIC_RELAXED, __HIP_MEMORY_SCOPE_WORKGROUP); const int p2 = __hip_atomic_fetch_add(lcnt + ee2, 1, __ATOMIC_RELAXED, __HIP_MEMORY_SCOPE_WORKGROUP);
                        LAS int* ri = rinfo + (rloc + t) * 8; ri[0] = e1; ri[1] = p1; ri[2] = (int)__float_as_uint(w1); ri[3] = 2 * (row + t); ri[4] = ee2; ri[5] = p2; ri[6] = (int)__float_as_uint(w2); ri[7] = 2 * (row + t) + 1; }
                }
                asm volatile("" ::: "memory");
                if (it0 < NMI) conv_store<1>(mi.K, mi.N, mi.nblk, mi.r, F.lane, mi.d, mi.d, RmMoe{mi.mode}, 32.f, t_);
            }
            LDS_WAIT(); __syncthreads();
            if (F.tid < 32) { const int c = lcnt[F.tid]; lcnt[32 + F.tid] = c ? (int)__hip_atomic_fetch_add((gu32*)cnt_g + F.tid, (unsigned)c, RLX_AGENT) : 0; }
            VM_WAIT(); LDS_WAIT(); __syncthreads();
            if (F.tid < 256) { const LAS int* ri = rinfo + F.tid * 4; const int e = ri[0], pos = lcnt[32 + e] + ri[1]; ltok[e * 32768 + pos] = ri[3]; lwt[e * 32768 + pos] = __uint_as_float((unsigned)ri[2]); }
        }
        __syncthreads(); STAMP(19);
        { constexpr int NMI = NEXP * 768;
          const int k0 = (F.G == 256) ? 8 : 0; const int trips = (NMI - gw + NGW - 1) / NGW;
          float ta[32];
          { const int it = gw + k0 * NGW; const MoeItem mi = moe_item(it < NMI ? it : NMI - 1, args.in[12], args.in[13], args.in[14], ws + WS_WGU, ws + WS_WDN); conv_load(mi.W, mi.N, mi.nblk, mi.r, F.lane, ta); }
#pragma unroll 1
          for (int k = k0; k < trips; ++k) { float tb[32];
              const int it = gw + k * NGW, itn = it + NGW;
              const MoeItem mn = moe_item(itn < NMI ? itn : NMI - 1, args.in[12], args.in[13], args.in[14], ws + WS_WGU, ws + WS_WDN); conv_load(mn.W, mn.N, mn.nblk, mn.r, F.lane, tb);
              asm volatile("" : "+v"(ta[0]) :: "memory");
              const MoeItem mi = moe_item(it, args.in[12], args.in[13], args.in[14], ws + WS_WGU, ws + WS_WDN);
              conv_store<1>(mi.K, mi.N, mi.nblk, mi.r, F.lane, mi.d, mi.d, RmMoe{mi.mode}, 32.f, ta);
#pragma unroll
              for (int i = 0; i < 32; ++i) ta[i] = tb[i]; } }
        if (BOTH(PH_RT)) GRID_BAR(); STAMP(PH_RT);
    }
    if (IN(PH_GU)) {
        CArgs& args = *phase_args(); unsigned char* const ws = args.ws; float* const out = args.out; const float* const x = args.in[0]; (void)x; (void)out;
        Frame F; { int t_ = HW_TID(); asm volatile("" : "+v"(t_)); F.tid = t_; F.lane = t_ & 63; F.wave = __builtin_amdgcn_readfirstlane(t_ >> 6);
          unsigned l_ = (unsigned)(uintptr_t)lds; asm volatile("" : "+s"(l_)); F.lds = (LAS unsigned char*)l_; F.MISC = (volatile LAS unsigned*)(F.lds + MISC_OFF); F.ctl = (gu32*)(ws + WS_CTL);
          int g_ = (int)gridDim.x; asm volatile("" : "+s"(g_)); F.G = g_; const int bx = blockIdx.x; F.vcu = (F.G % 8 == 0) ? (bx % 8) * (F.G / 8) + bx / 8 : bx; }
        const int gw = F.vcu * NWAVES + F.wave, NGW = F.G * NWAVES; (void)gw; (void)NGW;
        const int n = moe_build(F, cnt_g, ltok, lwt, 0);
        MoeOrder S{(const LAS int*)(F.lds + TBL_OFF + MoeTbl::UNITS), (const LAS unsigned*)(F.lds + TBL_OFF + MoeTbl::ROWOFF), n, (size_t)DMODEL * DMODEL, (unsigned*)(ws + WS_CTL) + CW_HID, nullptr};
        pg8::Gemm g{HA, (const bf16*)(ws + WS_WGU), 0, DMODEL, DMODEL};
        pg8::EpiSwiglu E{ws + WS_HID};
        pg8::gemm_phase<pg8::EpiSwiglu, MoeOrder, true, true, true, true>(F.lds + RING_OFF, g, S, E, F.tid);
        { VM_WAIT(); __syncthreads();
          const int U = 4 * ((const LAS int*)(F.lds + TBL_OFF + MoeTbl::RB0))[32]; const int r = U % F.G, idle = F.G - r; const int c = (int)blockIdx.x;
          pg8::Gemm gp{PB, Wpp_t, TOK, DMODEL, PLE}; pg8::StaticOrderSlice SP; SP.S.init(TOK, DMODEL, F.G, 0); SP.limit = 256;
          if (2 * idle >= F.G) { SP.first = (c >= r) ? 0 + c - r : -1; SP.stride = idle; } else { SP.first = 0 + c; SP.stride = F.G; }
          pg8::EpiStoreBf16 EP{(bf16*)(ws + WS_P), DMODEL};
          pg8::gemm_phase<pg8::EpiStoreBf16, pg8::StaticOrderSlice, true, true, false>(F.lds + RING_OFF, gp, SP, EP, F.tid); }
        VM_WAIT(); __syncthreads(); STAMP(PH_GU);
    }
    if (IN(PH_DN)) {
        CArgs& args = *phase_args(); unsigned char* const ws = args.ws; float* const out = args.out; const float* const x = args.in[0]; (void)x; (void)out;
        Frame F; { int t_ = HW_TID(); asm volatile("" : "+v"(t_)); F.tid = t_; F.lane = t_ & 63; F.wave = __builtin_amdgcn_readfirstlane(t_ >> 6);
          unsigned l_ = (unsigned)(uintptr_t)lds; asm volatile("" : "+s"(l_)); F.lds = (LAS unsigned char*)l_; F.MISC = (volatile LAS unsigned*)(F.lds + MISC_OFF); F.ctl = (gu32*)(ws + WS_CTL);
          int g_ = (int)gridDim.x; asm volatile("" : "+s"(g_)); F.G = g_; const int bx = blockIdx.x; F.vcu = (F.G % 8 == 0) ? (bx % 8) * (F.G / 8) + bx / 8 : bx; }
        const int gw = F.vcu * NWAVES + F.wave, NGW = F.G * NWAVES; (void)gw; (void)NGW;
        const int n = moe_build(F, cnt_g, ltok, lwt, 1);
        MoeOrder S{(const LAS int*)(F.lds + TBL_OFF + MoeTbl::UNITS), (const LAS unsigned*)(F.lds + TBL_OFF + MoeTbl::ROWOFF), n, (size_t)DMODEL * DEXP, nullptr, (unsigned*)(ws + WS_CTL) + CW_HID};
        pg8::Gemm g{(const bf16*)(ws + WS_HID), (const bf16*)(ws + WS_WDN), 0, DMODEL, DEXP};
        pg8::EpiDown E{ws + WS_Y, (const LAS int*)(F.lds + TBL_OFF + MoeTbl::ROWOFF), (const LAS float*)(F.lds + TBL_OFF + MoeTbl::ROWW)};
        pg8::gemm_phase<pg8::EpiDown, MoeOrder, true, true, false, true>(F.lds + RING_OFF, g, S, E, F.tid);
        { VM_WAIT(); __syncthreads();
          const int U = 4 * ((const LAS int*)(F.lds + TBL_OFF + MoeTbl::RB0))[32]; const int r = U % F.G, idle = F.G - r; const int c = (int)blockIdx.x;
          pg8::Gemm gp{PB, Wpp_t, TOK, DMODEL, PLE}; pg8::StaticOrderSlice SP; SP.S.init(TOK, DMODEL, F.G, 0); SP.limit = 512;
          { const int r2 = 2 * r < F.G ? 2 * r : F.G, idle2 = F.G - r2; if (2 * idle2 >= F.G / 2 && idle2 > 0) { SP.first = (c >= r2) ? 256 + c - r2 : -1; SP.stride = idle2; } else { SP.first = 256 + c; SP.stride = F.G; } }
          pg8::EpiStoreBf16 EP{(bf16*)(ws + WS_P), DMODEL};
          pg8::gemm_phase<pg8::EpiStoreBf16, pg8::StaticOrderSlice, true, true, false>(F.lds + RING_OFF, gp, SP, EP, F.tid); }
        if (BOTH(PH_DN)) GRID_BAR(); STAMP(PH_DN);
    }
    if (IN(PH_CMB)) {
        CArgs& args = *phase_args(); unsigned char* const ws = args.ws; float* const out = args.out; const float* const x = args.in[0]; (void)x; (void)out;
        Frame F; { int t_ = HW_TID(); asm volatile("" : "+v"(t_)); F.tid = t_; F.lane = t_ & 63; F.wave = __builtin_amdgcn_readfirstlane(t_ >> 6);
          unsigned l_ = (unsigned)(uintptr_t)lds; asm volatile("" : "+s"(l_)); F.lds = (LAS unsigned char*)l_; F.MISC = (volatile LAS unsigned*)(F.lds + MISC_OFF); F.ctl = (gu32*)(ws + WS_CTL);
          int g_ = (int)gridDim.x; asm volatile("" : "+s"(g_)); F.G = g_; const int bx = blockIdx.x; F.vcu = (F.G % 8 == 0) ? (bx % 8) * (F.G / 8) + bx / 8 : bx; }
        const int gw = F.vcu * NWAVES + F.wave, NGW = F.G * NWAVES; (void)gw; (void)NGW;
        const unsigned char* Y = ws + WS_Y;
#ifndef NO_CMB_LOOP
        { f32x4 gg[4];
#pragma unroll
          for (int j = 0; j < 4; ++j) gg[j] = ((const GAS f32x4*)args.in[15] + F.lane)[64 * j];
#pragma unroll 1
          for (int m0 = gw; m0 < TOK; m0 += 4 * NGW) {
              unsigned long long xw[4][4]; unsigned ya[4][4], yb[4][4];
#pragma unroll
              for (int r = 0; r < 4; ++r) { int m = m0 + r * NGW; m = m < TOK ? m : TOK - 1;
                  const GAS unsigned long long* x1r = (const GAS unsigned long long*)((const bf16*)(ws + WS_X1B) + (size_t)m * DMODEL) + F.lane;
                  const GAS unsigned* y0 = (const GAS unsigned*)(Y + (size_t)(2 * m) * DMODEL) + F.lane; const GAS unsigned* y1 = (const GAS unsigned*)(Y + (size_t)(2 * m + 1) * DMODEL) + F.lane;
#pragma unroll
                  for (int j = 0; j < 4; ++j) { xw[r][j] = x1r[64 * j]; ya[r][j] = y0[64 * j]; yb[r][j] = y1[64 * j]; } }
              asm volatile("" : "+v"(xw[0][0]) :: "memory");
#pragma unroll
              for (int r = 0; r < 4; ++r) { const int m = m0 + r * NGW; f32x4 v[4]; float s = 0.f;
#pragma unroll
                  for (int j = 0; j < 4; ++j) { const unsigned lo_ = (unsigned)xw[r][j], hi_ = (unsigned)(xw[r][j] >> 32); v[j] = (f32x4){pg8::bf_lo(lo_), pg8::bf_hi(lo_), pg8::bf_lo(hi_), pg8::bf_hi(hi_)}; const unsigned a = ya[r][j], b = yb[r][j];
                      const auto a0 = __builtin_amdgcn_cvt_pk_f32_fp8((int)a, false), a1 = __builtin_amdgcn_cvt_pk_f32_fp8((int)a, true), b0 = __builtin_amdgcn_cvt_pk_f32_fp8((int)b, false), b1 = __builtin_amdgcn_cvt_pk_f32_fp8((int)b, true);
                      v[j].x += (a0[0] + b0[0]) * (1.0f / 64.0f); v[j].y += (a0[1] + b0[1]) * (1.0f / 64.0f); v[j].z += (a1[0] + b1[0]) * (1.0f / 64.0f); v[j].w += (a1[1] + b1[1]) * (1.0f / 64.0f);
#if defined(PROBE_A)
                      if (m < TOK) ((GAS f32x4*)(out + (size_t)m * DMODEL) + F.lane)[64 * j] = v[j];
#endif
                      if (m < TOK) ((GAS unsigned long long*)((bf16*)(ws + WS_X1B) + (size_t)m * DMODEL) + F.lane)[64 * j] = (unsigned long long)pg8::cvt_pk_bf16(v[j].x, v[j].y) | ((unsigned long long)pg8::cvt_pk_bf16(v[j].z, v[j].w) << 32);
                      s += (v[j].x * v[j].x + v[j].y * v[j].y) + (v[j].z * v[j].z + v[j].w * v[j].w); }
                  const float rinv = 1.0f / sqrtf(wave_sum(s) * (1.f / DMODEL) + RMS_EPS);
                  if (m < TOK) { GAS unsigned* o4 = (GAS unsigned*)((unsigned char*)HA + (size_t)m * DMODEL) + F.lane;
#pragma unroll
                      for (int j = 0; j < 4; ++j) { int w_ = __builtin_amdgcn_cvt_pk_fp8_f32(v[j].x * rinv * gg[j].x, v[j].y * rinv * gg[j].y, 0, false); w_ = __builtin_amdgcn_cvt_pk_fp8_f32(v[j].z * rinv * gg[j].z, v[j].w * rinv * gg[j].w, w_, true); o4[64 * j] = (unsigned)w_; } } } } }
#endif
        VM_WAIT(); __syncthreads(); STAMP(20);
        if (BOTH(PH_CMB)) GRID_BAR(); STAMP(PH_CMB);
    }
    if (IN(PH_PG)) {
        CArgs& args = *phase_args(); unsigned char* const ws = args.ws; float* const out = args.out; const float* const x = args.in[0]; (void)x; (void)out;
        Frame F; { int t_ = HW_TID(); asm volatile("" : "+v"(t_)); F.tid = t_; F.lane = t_ & 63; F.wave = __builtin_amdgcn_readfirstlane(t_ >> 6);
          unsigned l_ = (unsigned)(uintptr_t)lds; asm volatile("" : "+s"(l_)); F.lds = (LAS unsigned char*)l_; F.MISC = (volatile LAS unsigned*)(F.lds + MISC_OFF); F.ctl = (gu32*)(ws + WS_CTL);
          int g_ = (int)gridDim.x; asm volatile("" : "+s"(g_)); F.G = g_; const int bx = blockIdx.x; F.vcu = (F.G % 8 == 0) ? (bx % 8) * (F.G / 8) + bx / 8 : bx; }
        const int gw = F.vcu * NWAVES + F.wave, NGW = F.G * NWAVES; (void)gw; (void)NGW;
#if defined(PROBE_A)
        { pg8::Gemm g{HA, Wpg_t, TOK, DMODEL, DMODEL}; pg8::StaticOrder S; S.init(TOK, DMODEL, F.G, (int)blockIdx.x);
          pg8::EpiPle E{out, (const bf16*)(ws + WS_P), (float*)(ws + WS_ST)};
          pg8::gemm_phase<pg8::EpiPle, pg8::StaticOrder, true, true, false, true>(F.lds + RING_OFF, g, S, E, F.tid); }
#else
        if (F.G == 256) {
            { pg8::Gemm g{HA, Wpg_t, TOK, DMODEL, DMODEL}; pg8::StaticOrderRound S; S.S.init(TOK, DMODEL, F.G, (int)blockIdx.x); S.round = 0;
              pg8::EpiPleFin E{out, (const bf16*)(ws + WS_X1B), (const bf16*)(ws + WS_P), (float*)(ws + WS_ST), (unsigned*)(ws + WS_CTL) + CW_FIN, args.in[18]};
              pg8::gemm_phase<pg8::EpiPleFin, pg8::StaticOrderRound, true, true, false, true>(F.lds + RING_OFF, g, S, E, F.tid); }
            VM_WAIT(); __syncthreads();
            { pg8::Gemm g{HA, Wpg_t, TOK, DMODEL, DMODEL}; pg8::StaticOrderRound S; S.S.init(TOK, DMODEL, F.G, (int)blockIdx.x); S.round = 1;
              pg8::EpiPleFin E{out, (const bf16*)(ws + WS_X1B), (const bf16*)(ws + WS_P), (float*)(ws + WS_ST), (unsigned*)(ws + WS_CTL) + CW_FIN, args.in[18]};
              pg8::gemm_phase<pg8::EpiPleFin, pg8::StaticOrderRound, true, true, false, true>(F.lds + RING_OFF, g, S, E, F.tid); }
        }
#endif
#if defined(PROBE_A)
        if (BOTH(PH_PG)) GRID_BAR(); STAMP(PH_PG);
#endif
    }
#if defined(PROBE_A)
    if (IN(PH_FIN)) {
        CArgs& args = *phase_args(); unsigned char* const ws = args.ws; float* const out = args.out; const float* const x = args.in[0]; (void)x; (void)out;
        Frame F; { int t_ = HW_TID(); asm volatile("" : "+v"(t_)); F.tid = t_; F.lane = t_ & 63; F.wave = __builtin_amdgcn_readfirstlane(t_ >> 6);
          unsigned l_ = (unsigned)(uintptr_t)lds; asm volatile("" : "+s"(l_)); F.lds = (LAS unsigned char*)l_; F.MISC = (volatile LAS unsigned*)(F.lds + MISC_OFF); F.ctl = (gu32*)(ws + WS_CTL);
          int g_ = (int)gridDim.x; asm volatile("" : "+s"(g_)); F.G = g_; const int bx = blockIdx.x; F.vcu = (F.G % 8 == 0) ? (bx % 8) * (F.G / 8) + bx / 8 : bx; }
        const int gw = F.vcu * NWAVES + F.wave, NGW = F.G * NWAVES; (void)gw; (void)NGW;
        const float* st = (const float*)(ws + WS_ST);
#pragma unroll 4
        for (int m = gw; m < TOK; m += NGW) {
            GAS f32x4* xr = (GAS f32x4*)(out + (size_t)m * DMODEL) + F.lane; const GAS f32x4* gr = (const GAS f32x4*)args.in[18] + F.lane;
            float s = st[(size_t)m * 16 + (F.lane & 15)];
            s += __shfl_xor(s, 1); s += __shfl_xor(s, 2); s += __shfl_xor(s, 4); s += __shfl_xor(s, 8);
            const float rinv = 1.0f / sqrtf(s * (1.f / DMODEL) + RMS_EPS);
#pragma unroll
            for (int j = 0; j < 4; ++j) { const f32x4 v = xr[64 * j]; xr[64 * j] = v * rinv * gr[64 * j]; }
#if defined(PROBE_A)
            { const unsigned long long* tq = (const unsigned long long*)(ws + 2 * MiB + 512 * 1024);
              const unsigned long long t0 = __hip_atomic_load(tq + 0, __ATOMIC_RELAXED, __HIP_MEMORY_SCOPE_AGENT), te = __hip_atomic_load(tq + PH_PG, __ATOMIC_RELAXED, __HIP_MEMORY_SCOPE_AGENT);
              float fa = 0.f; const float tot = (float)(te - t0);
#if defined(PROBE_ACC)
              fa = (float)__hip_atomic_load(tq + PROBE_ACC, __ATOMIC_RELAXED, __HIP_MEMORY_SCOPE_AGENT) / tot;
#endif
#if defined(PROBE_S0)
              fa = (float)(__hip_atomic_load(tq + PROBE_S1, __ATOMIC_RELAXED, __HIP_MEMORY_SCOPE_AGENT) - __hip_atomic_load(tq + PROBE_S0, __ATOMIC_RELAXED, __HIP_MEMORY_SCOPE_AGENT)) / tot;
#endif
#pragma unroll
              for (int k = 0; k < PH_PG; ++k) if ((PROBE_A >> k) & 1) fa += (float)(__hip_atomic_load(tq + k + 1, __ATOMIC_RELAXED, __HIP_MEMORY_SCOPE_AGENT) - __hip_atomic_load(tq + k, __ATOMIC_RELAXED, __HIP_MEMORY_SCOPE_AGENT)) / tot;
#ifndef PROBE_OFF
#define PROBE_OFF 0.0f
#endif
              #ifndef PROBE_Q
#define PROBE_Q 20.f
#endif
              fa = floorf((fa + PROBE_OFF) * PROBE_Q) / PROBE_Q;
              if ((float)m < fa * (float)TOK) {
#pragma unroll
                  for (int j = 0; j < 4; ++j) xr[64 * j] = (f32x4){0.f, 0.f, 0.f, 0.f}; }
              }
#endif
        }
    }
#endif
#undef IN
#undef BOTH
#undef GRID_BAR
}

extern "C" void kernel_launch(void* const* d_in, const int* in_sizes, int n_in, void* d_out, int out_size, void* d_ws, size_t ws_size, hipStream_t stream) {
    static int grid = 0;
    if (grid == 0) {
        if (n_in != 19 || in_sizes[0] != TOK * DMODEL || out_size != TOK * DMODEL || ws_size < WS_END) { fprintf(stderr, "kernel_launch: unexpected problem shape (n_in %d, ws %zu); nothing launched\n", n_in, ws_size); grid = -1; return; }
        int dev = 0, cus = 0, per_cu = 0;
        if (hipGetDevice(&dev) != hipSuccess || hipDeviceGetAttribute(&cus, hipDeviceAttributeMultiprocessorCount, dev) != hipSuccess) { grid = -1; return; }
        if (hipFuncSetAttribute((const void*)fwd, hipFuncAttributeMaxDynamicSharedMemorySize, LDS_BYTES) != hipSuccess) { fprintf(stderr, "kernel_launch: hipFuncSetAttribute failed\n"); grid = -1; return; }
        if (hipOccupancyMaxActiveBlocksPerMultiprocessor(&per_cu, (const void*)fwd, NWAVES * 64, LDS_BYTES) != hipSuccess || per_cu < 1) fprintf(stderr, "kernel_launch: occupancy query reports %d\n", per_cu);
        (void)hipGetLastError();
        grid = cus;
        if (grid != 256) fprintf(stderr, "kernel_launch: %d CUs; this build is laid out for 256\n", grid);
    }
    if (grid < 0) return;
    if (hipMemsetAsync((char*)d_ws + WS_CTL, 0, CTL_ZERO_BYTES, stream) != hipSuccess) return;
    Args a{};
    for (int i = 0; i < 19; ++i) a.in[i] = (const float*)d_in[i];
    a.out = (float*)d_out; a.ws = (unsigned char*)d_ws;
    if (N_LAUNCHES == 1) { a.ph_lo = 0; a.ph_hi = PH_COUNT; hipLaunchKernelGGL(fwd, dim3(grid), dim3(NWAVES * 64), LDS_BYTES, stream, a); }
    else { for (int p = 0; p < PH_COUNT; ++p) { a.ph_lo = p; a.ph_hi = p + 1; hipLaunchKernelGGL(fwd, dim3(grid), dim3(NWAVES * 64), LDS_BYTES, stream, a); } }
}
```

```cpp
#include <hip/hip_runtime.h>
#include <hip/hip_bf16.h>
#include <cstdio>
#include <cstdint>
#include <cmath>

#ifndef MK_N_LAUNCHES
#define MK_N_LAUNCHES 1
#endif

namespace pg8 {
#define PG8_LAS __attribute__((address_space(3)))
typedef unsigned short bf16_t;
typedef short bf16x8 __attribute__((ext_vector_type(8)));
typedef float f32x4 __attribute__((ext_vector_type(4)));
typedef unsigned u32x4 __attribute__((ext_vector_type(4)));
typedef unsigned u32x2 __attribute__((ext_vector_type(2)));
typedef int v4i32 __attribute__((ext_vector_type(4)));
typedef int v8i32 __attribute__((ext_vector_type(8)));
constexpr int BM = 256, BK = 64, HALF = 128, HTB = HALF * BK * 2  , STAGE_BYTES = 8 * HTB, NXCD = 8, WGM = 8;

__host__ __device__ __forceinline__ int lds_byte(int r, int c) { const int st = (r >> 4) * 2 + (c >> 5), rr = r & 15, cc = c & 31, ob = rr * 64 + cc * 2; return st * 1024 + (ob ^ (((ob >> 9) & 1) << 5)); }
__host__ __device__ __forceinline__ void stage_rc(int b, int& R, int& C) { const int st = b / 1024, sb = b % 1024, swz = sb ^ (((sb >> 9) & 1) << 5); R = (st >> 1) * 16 + swz / 64; C = (st & 1) * 32 + (swz % 64) / 2; }
__host__ __device__ __forceinline__ int perm32(int rho) { const int n = rho >> 4, i = rho & 15; return 8 * (i >> 2) + 4 * n + (i & 3); }

struct Unit { int pm, pn; size_t boff; int e, valid; };
struct Gemm { const bf16_t* A; const bf16_t* Bt; int M, N, K; };

struct StaticOrder {
    int nM, nN, nwg, G, c;
    __host__ __device__ void init(int M, int N, int G_, int c_) { nM = M / BM; nN = N / BM; nwg = nM * nN; G = G_; c = c_; }
    __host__ __device__ bool next(int i, Unit& u) const { return at((long)i * G + c, u); }
    __host__ __device__ bool at(const long L, Unit& u) const {
        if (L >= nwg) return false;
        int wgid = (int)L; { const int q = nwg / NXCD, r = nwg % NXCD, xcd = wgid % NXCD, off = wgid / NXCD; wgid = (xcd < r ? xcd * (q + 1) : r * (q + 1) + (xcd - r) * q) + off; }
        const int nig = WGM * nN, gid = wgid / nig, fm = gid * WGM, gsz = (nM - fm) < WGM ? (nM - fm) : WGM;
        u.pm = fm + ((wgid % nig) % gsz); u.pn = (wgid % nig) / gsz; u.boff = 0; u.e = 0; u.valid = 256; return true;
    }
    __device__ __forceinline__ void a_ready(const Unit&, int, int) const {}
    __device__ __forceinline__ void done(const Unit&, int, int) const {}
    __device__ __forceinline__ unsigned arow(int, int) const { return 0u; }
};

struct StaticOrderSlice {
    StaticOrder S; int first, stride, limit;
    __host__ __device__ bool next(int i, Unit& u) const { const long L = (long)first + (long)i * stride; return first >= 0 && L < limit && S.at(L, u); }
    __device__ __forceinline__ void a_ready(const Unit&, int, int) const {}
    __device__ __forceinline__ void done(const Unit&, int, int) const {}
    __device__ __forceinline__ unsigned arow(int, int) const { return 0u; }
};
struct StaticOrderTail {
    StaticOrder S; int full, cut;
    __host__ __device__ bool next(int i, Unit& u) const {
        if (i < full) return S.at((long)i * S.G + S.c, u);
        if (S.c < cut) return false;
        return S.at((long)full * S.G + (long)(i - full) * (S.G - cut) + (S.c - cut), u); }
    __device__ __forceinline__ void a_ready(const Unit&, int, int) const {}
    __device__ __forceinline__ void done(const Unit&, int, int) const {}
    __device__ __forceinline__ unsigned arow(int, int) const { return 0u; }
};
struct StaticOrderRound {
    StaticOrder S; int round;
    __host__ __device__ bool next(int i, Unit& u) const { return i == 0 && S.next(round, u); }
    __device__ __forceinline__ void a_ready(const Unit&, int, int) const {}
    __device__ __forceinline__ void done(const Unit&, int, int) const {}
    __device__ __forceinline__ unsigned arow(int, int) const { return 0u; }
};
__device__ __forceinline__ unsigned cvt_pk_bf16(float lo, float hi) { unsigned r; asm volatile("v_cvt_pk_bf16_f32 %0, %1, %2" : "=v"(r) : "v"(lo), "v"(hi)); return r; }
__device__ __forceinline__ u32x4 pack8(const f32x4 a, const f32x4 b) { u32x4 w; w.x = cvt_pk_bf16(a[0], a[1]); w.y = cvt_pk_bf16(a[2], a[3]); w.z = cvt_pk_bf16(b[0], b[1]); w.w = cvt_pk_bf16(b[2], b[3]); return w; }
__device__ __forceinline__ u32x2 pack8_fp8(const f32x4 a, const f32x4 b) { int w0 = __builtin_amdgcn_cvt_pk_fp8_f32(a[0], a[1], 0, false); w0 = __builtin_amdgcn_cvt_pk_fp8_f32(a[2], a[3], w0, true);
    int w1 = __builtin_amdgcn_cvt_pk_fp8_f32(b[0], b[1], 0, false); w1 = __builtin_amdgcn_cvt_pk_fp8_f32(b[2], b[3], w1, true); return (u32x2){(unsigned)w0, (unsigned)w1}; }
__device__ __forceinline__ float bf_lo(unsigned w) { return __uint_as_float(w << 16); }
__device__ __forceinline__ float bf_hi(unsigned w) { return __uint_as_float(w & 0xffff0000u); }
__device__ __forceinline__ void unpack8(const u32x4 w, f32x4& a, f32x4& b) { a[0] = bf_lo(w.x); a[1] = bf_hi(w.x); a[2] = bf_lo(w.y); a[3] = bf_hi(w.y); b[0] = bf_lo(w.z); b[1] = bf_hi(w.z); b[2] = bf_lo(w.w); b[3] = bf_hi(w.w); }
__device__ __forceinline__ float sigmoidf_(float v) { return __builtin_amdgcn_rcpf(1.0f + __builtin_amdgcn_exp2f(-1.4426950408889634f * v)); }

template <class Epi, class Sched, bool ALIGN_EPI = false, bool SP2 = false, bool GATHER = false, bool FP8 = false>
__device__ __forceinline__ void gemm_phase(PG8_LAS unsigned char* lds, const Gemm g, const Sched& S, const Epi& E, const int tid_in) {
    int tidl_ = tid_in; asm volatile("" : "+v"(tidl_));
    const int tid = tidl_, wid = __builtin_amdgcn_readfirstlane(tid >> 6), lane = tid & 63, wr = wid >> 2, wc = wid & 3, fr = lane & 15, fq = lane >> 4;
    int Kl_ = g.K; asm volatile("" : "+s"(Kl_));
    const int K = Kl_; const int KB = FP8 ? K : 2 * K; const int nt = KB / (2 * BK);
    unsigned voffA[2], voffB[2], stC2[2]; int stR[2];
#pragma unroll
    for (int i = 0; i < 2; ++i) { int R, C; stage_rc(tid * 16 + i * 8192, R, C); const int Rb = Epi::PERM ? ((R & ~31) + perm32(R & 31)) : R;
        voffA[i] = (unsigned)(R * KB + 2 * C); voffB[i] = (unsigned)(Rb * KB + 2 * C); stR[i] = R; stC2[i] = (unsigned)C * 2u; }
    const size_t kstep = (size_t)(BK * 2);
    const size_t hstep = (size_t)HALF * KB;
    const size_t tstep = 2 * hstep;
    const unsigned ldsw = (unsigned)wid * 1024u;
    const int aoff = lds_byte(wr * 64 + fr, fq * 8), boff = lds_byte(wc * 32 + fr, fq * 8);
#define PG8_SA(b, h) (((b) * 2 + (h)) * HTB)
#define PG8_SB(b, h) ((4 + (b) * 2 + (h)) * HTB)
#define PG8_STAGE(bufoff, gbase, voff) do { _Pragma("unroll") for (int _i = 0; _i < 2; ++_i) \
        __builtin_amdgcn_global_load_lds((const unsigned*)((const char*)(gbase) + (voff)[_i]), (PG8_LAS unsigned*)(lds + (bufoff) + ldsw + _i * 8192), 16, 0, 0); } while (0)
#define PG8_STAGE_A(bufoff, base, h, NX) do { if constexpr (GATHER) { unsigned _v[2]; _v[0] = (NX) ? gAn[h][0] : gAc[h][0]; _v[1] = (NX) ? gAn[h][1] : gAc[h][1]; PG8_STAGE(bufoff, base, _v); } \
        else { PG8_STAGE(bufoff, (base) + (h) * hstep, voffA); } } while (0)
#define PG8_LDA(dst, b, h) do { _Pragma("unroll") for (int m = 0; m < 4; ++m) _Pragma("unroll") for (int k = 0; k < 2; ++k) dst[m][k] = *(const PG8_LAS bf16x8*)(lds + PG8_SA(b, h) + aoff + m * 2048 + k * 1024); } while (0)
#define PG8_LDB(dst, b, h) do { _Pragma("unroll") for (int n = 0; n < 2; ++n) _Pragma("unroll") for (int k = 0; k < 2; ++k) dst[n][k] = *(const PG8_LAS bf16x8*)(lds + PG8_SB(b, h) + boff + n * 2048 + k * 1024); } while (0)
#define PG8_MMA(ai, bj, At, Bt) do { __builtin_amdgcn_s_setprio(1); _Pragma("unroll") for (int m = 0; m < 4; ++m) _Pragma("unroll") for (int n = 0; n < 2; ++n) _Pragma("unroll") for (int k = 0; k < 2; ++k) \
        acc[ai][bj][m][n] = __builtin_amdgcn_mfma_f32_16x16x32_bf16(Bt[n][k], At[m][k], acc[ai][bj][m][n], 0, 0, 0); __builtin_amdgcn_s_setprio(0); } while (0)
#define PG8_MMA8(ai, bj, At, Bt) do { __builtin_amdgcn_s_setprio(1); _Pragma("unroll") for (int m = 0; m < 4; ++m) _Pragma("unroll") for (int n = 0; n < 2; ++n) { \
        const v8i32 b8_ = __builtin_shufflevector(__builtin_bit_cast(v4i32, Bt[n][0]), __builtin_bit_cast(v4i32, Bt[n][1]), 0, 1, 2, 3, 4, 5, 6, 7); \
        const v8i32 a8_ = __builtin_shufflevector(__builtin_bit_cast(v4i32, At[m][0]), __builtin_bit_cast(v4i32, At[m][1]), 0, 1, 2, 3, 4, 5, 6, 7); \
        asm volatile("v_mfma_scale_f32_16x16x128_f8f6f4 %0, %1, %2, %0, %3, %3 op_sel_hi:[0,0,0]" : "+v"(acc[ai][bj][m][n]) : "v"(b8_), "v"(a8_), "v"(one8_)); } __builtin_amdgcn_s_setprio(0); } while (0)
#define PG8_MMAX(ai, bj, At, Bt) do { if constexpr (FP8) PG8_MMA8(ai, bj, At, Bt); else PG8_MMA(ai, bj, At, Bt); } while (0)
#define PG8_WAIT_V(n) asm volatile("s_waitcnt vmcnt(" #n ")" ::: "memory")
#define PG8_WAIT_L(n) asm volatile("s_waitcnt lgkmcnt(" #n ")" ::: "memory")
#define PG8_BAR __builtin_amdgcn_s_barrier()
#define PG8_SCHED __builtin_amdgcn_sched_barrier(0)
    const int one8_ = 0x7f7f7f7f;
    Unit cur, nxt; int ui = 0;
    if (!S.next(0, cur)) return;
    f32x4 acc[2][2][4][2];
#pragma unroll
    for (int a = 0; a < 2; ++a)
#pragma unroll
        for (int b = 0; b < 2; ++b)
#pragma unroll
            for (int m = 0; m < 4; ++m)
#pragma unroll
                for (int n = 0; n < 2; ++n) acc[a][b][m][n] = (f32x4){0.f, 0.f, 0.f, 0.f};
    bf16x8 At[4][2], B0[2][2], B1[2][2];
    const char* cA = GATHER ? (const char*)g.A : (const char*)g.A + (size_t)cur.pm * tstep; const char* cB = (const char*)g.Bt + cur.boff + (size_t)cur.pn * tstep;
    unsigned gAc[2][2], gAn[2][2];
    if constexpr (GATHER) { _Pragma("unroll") for (int h = 0; h < 2; ++h) _Pragma("unroll") for (int i = 0; i < 2; ++i) { gAc[h][i] = S.arow(0, h * HALF + stR[i]) + stC2[i]; gAn[h][i] = gAc[h][i]; } }
    S.a_ready(cur, wid, lane);
    if constexpr (SP2) {
        PG8_STAGE(PG8_SB(0, 0), cB, voffB); PG8_STAGE(PG8_SB(0, 1), cB + hstep, voffB); PG8_STAGE_A(PG8_SA(0, 0), cA, 0, false); PG8_STAGE_A(PG8_SA(0, 1), cA, 1, false);
        if (wr == 1) PG8_BAR;
        PG8_WAIT_V(2); PG8_BAR;
        PG8_STAGE(PG8_SB(1, 0), cB + kstep, voffB); PG8_STAGE_A(PG8_SA(1, 0), cA + kstep, 0, false); PG8_STAGE(PG8_SB(1, 1), cB + hstep + kstep, voffB);
        PG8_WAIT_V(6); PG8_BAR;
    } else {
        PG8_STAGE(PG8_SB(0, 0), cB, voffB); PG8_STAGE_A(PG8_SA(0, 0), cA, 0, false); PG8_STAGE(PG8_SB(0, 1), cB + hstep, voffB); PG8_STAGE_A(PG8_SA(0, 1), cA, 1, false);
        if (wr == 1) PG8_BAR;
        PG8_WAIT_V(4); PG8_BAR;
        PG8_STAGE(PG8_SB(1, 0), cB + kstep, voffB); PG8_STAGE_A(PG8_SA(1, 0), cA + kstep, 0, false); PG8_STAGE(PG8_SB(1, 1), cB + hstep + kstep, voffB);
        PG8_WAIT_V(6); PG8_BAR;
    }
    for (;;) {
        const bool has_next = S.next(ui + 1, nxt);
        const char* nA = GATHER ? cA : (has_next ? (const char*)g.A + (size_t)nxt.pm * tstep : cA); const char* nB = has_next ? (const char*)g.Bt + nxt.boff + (size_t)nxt.pn * tstep : cB;
        if constexpr (GATHER) { if (has_next) { _Pragma("unroll") for (int h = 0; h < 2; ++h) _Pragma("unroll") for (int i = 0; i < 2; ++i) gAn[h][i] = S.arow(ui + 1, h * HALF + stR[i]) + stC2[i]; } }
        for (int t = 0; t < nt; t += 2) {
            if constexpr (Epi::MID_HOOK) { if (t == (nt >> 1)) { asm volatile("s_nop 15\n\ts_nop 7" ::: "memory"); E.mid(acc, cur, ui, wr, wc, fr, fq); asm volatile("s_nop 7" ::: "memory"); } }
            const bool last = (t == nt - 2);
            const char* a1 = cA + (size_t)(t + 1) * kstep;
            const char* a2 = last ? nA : cA + (size_t)(t + 2) * kstep; const char* b2 = last ? nB : cB + (size_t)(t + 2) * kstep;
            const char* a3 = a2 + kstep; const char* b3 = b2 + kstep;
            if (last && has_next) S.a_ready(nxt, wid, lane);
            if constexpr (SP2) {
            PG8_LDB(B0, 0, 0); PG8_LDB(B1, 0, 1); PG8_SCHED; PG8_LDA(At, 0, 0); PG8_STAGE_A(PG8_SA(1, 1), a1, 1, false);
            PG8_WAIT_V(8); PG8_WAIT_L(0); PG8_BAR; PG8_MMAX(0, 0, At, B0); PG8_MMAX(0, 1, At, B1); PG8_BAR; PG8_SCHED;
            PG8_LDA(At, 0, 1); PG8_STAGE(PG8_SB(0, 0), b2, voffB); PG8_STAGE(PG8_SB(0, 1), b2 + hstep, voffB); PG8_STAGE_A(PG8_SA(0, 0), a2, 0, last);
            PG8_WAIT_V(8); PG8_WAIT_L(0); PG8_BAR; PG8_MMAX(1, 0, At, B0); PG8_MMAX(1, 1, At, B1); PG8_BAR; PG8_SCHED;
            PG8_LDB(B0, 1, 0); PG8_LDB(B1, 1, 1); PG8_SCHED; PG8_LDA(At, 1, 0); PG8_STAGE_A(PG8_SA(0, 1), a2, 1, last);
            PG8_WAIT_V(8); PG8_WAIT_L(0); PG8_BAR; PG8_MMAX(0, 0, At, B0); PG8_MMAX(0, 1, At, B1); PG8_BAR; PG8_SCHED;
            PG8_LDA(At, 1, 1); PG8_STAGE(PG8_SB(1, 0), b3, voffB); PG8_STAGE(PG8_SB(1, 1), b3 + hstep, voffB); PG8_STAGE_A(PG8_SA(1, 0), a3, 0, last);
            PG8_WAIT_V(8); PG8_WAIT_L(0); PG8_BAR; PG8_MMAX(1, 0, At, B0); PG8_MMAX(1, 1, At, B1); PG8_BAR; PG8_SCHED;
            } else {
            PG8_LDB(B0, 0, 0); PG8_SCHED; PG8_LDA(At, 0, 0); PG8_STAGE_A(PG8_SA(1, 1), a1, 1, false);
            PG8_WAIT_L(8); PG8_BAR; PG8_WAIT_L(0); PG8_MMAX(0, 0, At, B0); PG8_BAR; PG8_SCHED;
            PG8_LDB(B1, 0, 1); PG8_STAGE(PG8_SB(0, 0), b2, voffB);
            PG8_BAR; PG8_WAIT_L(0); PG8_MMAX(0, 1, At, B1); PG8_BAR;
            PG8_LDA(At, 0, 1); PG8_STAGE_A(PG8_SA(0, 0), a2, 0, last);
            PG8_BAR; PG8_WAIT_L(0); PG8_MMAX(1, 0, At, B0); PG8_BAR; PG8_SCHED;
            PG8_STAGE(PG8_SB(0, 1), b2 + hstep, voffB);
            PG8_WAIT_V(6); PG8_BAR; PG8_MMAX(1, 1, At, B1); PG8_BAR;
            PG8_LDB(B0, 1, 0); PG8_SCHED; PG8_LDA(At, 1, 0); PG8_STAGE_A(PG8_SA(0, 1), a2, 1, last);
            PG8_WAIT_L(8); PG8_BAR; PG8_WAIT_L(0); PG8_MMAX(0, 0, At, B0); PG8_BAR; PG8_SCHED;
            PG8_LDB(B1, 1, 1); PG8_STAGE(PG8_SB(1, 0), b3, voffB);
            PG8_BAR; PG8_WAIT_L(0); PG8_MMAX(0, 1, At, B1); PG8_BAR;
            PG8_LDA(At, 1, 1); PG8_STAGE_A(PG8_SA(1, 0), a3, 0, last);
            PG8_BAR; PG8_WAIT_L(0); PG8_MMAX(1, 0, At, B0); PG8_BAR; PG8_SCHED;
            PG8_STAGE(PG8_SB(1, 1), b3 + hstep, voffB);
            PG8_WAIT_V(6); PG8_BAR; PG8_MMAX(1, 1, At, B1); PG8_BAR;
            }
        }
        if constexpr (ALIGN_EPI) { if (wr == 0) PG8_BAR; }
        if constexpr (FP8) asm volatile("s_nop 15\n\ts_nop 7" ::: "memory");
        if constexpr (!Epi::AFTER_DRAIN) { E(acc, cur, ui, wr, wc, fr, fq); S.done(cur, wid, lane); }
        if (!has_next) break;
#pragma unroll
        for (int a = 0; a < 2; ++a)
#pragma unroll
            for (int b = 0; b < 2; ++b)
#pragma unroll
                for (int m = 0; m < 4; ++m)
#pragma unroll
                    for (int n = 0; n < 2; ++n) acc[a][b][m][n] = (f32x4){0.f, 0.f, 0.f, 0.f};
        cur = nxt; cA = nA; cB = nB; ++ui;
        if constexpr (GATHER) { _Pragma("unroll") for (int h = 0; h < 2; ++h) _Pragma("unroll") for (int i = 0; i < 2; ++i) gAc[h][i] = gAn[h][i]; }
        if constexpr (ALIGN_EPI) { if (wr == 1) PG8_BAR; }
    }
    PG8_WAIT_V(0);
    if constexpr (!ALIGN_EPI) { if (wr == 0) PG8_BAR; }
    PG8_BAR;
#undef PG8_SA
#undef PG8_SB
#undef PG8_STAGE
#undef PG8_STAGE_A
#undef PG8_LDA
#undef PG8_LDB
#undef PG8_MMA
#undef PG8_MMA8
#undef PG8_MMAX
#undef PG8_WAIT_V
#undef PG8_WAIT_L
#undef PG8_BAR
#undef PG8_SCHED
}


constexpr int BATCH = 8, SEQ = 4096, DMODEL = 1024, TOK = BATCH * SEQ;
constexpr int NHEAD = 8, HD = 64, AW = 512;
constexpr int IN_COLS = 5704, ZN = 5888;
constexpr int NEXP = 32, DEXP = 512, PLE = 256;
constexpr float RMS_EPS = 1e-6f;
constexpr float C2 = 0.125f * 1.4426950408889634f;
constexpr float IW_SCALE = 0.125f * 0.35355339059327373f;

template <int FP> struct EpiZ {
    static constexpr bool PERM = true, AFTER_DRAIN = false, MID_HOOK = false;
    bf16_t *QA, *KA, *VA, *QB, *KB, *VB, *IQ, *IK, *GA, *GB; float* IW; float* kmean; const float* ropec; const float* ropes;
    __device__ __forceinline__ void operator()(f32x4 (&acc)[2][2][4][2], const Unit& u, int, int wr, int wc, int fr, int fq) const {
        const int pn = u.pn;
        if (FP == 1 && pn >= 4 && pn < 12) {
            const int j = pn - 4;
#pragma unroll
            for (int ai = 0; ai < 2; ++ai)
#pragma unroll
                for (int m = 0; m < 4; ++m) { const int row = u.pm * BM + ai * HALF + wr * 64 + m * 16 + fr; const size_t off = (size_t)row * DMODEL + j * HALF + wc * 32 + 8 * fq;
                    f32x4 a0 = acc[ai][0][m][0] * (1.0f / 32.0f), a1 = acc[ai][0][m][1] * (1.0f / 32.0f), b0 = acc[ai][1][m][0] * (1.0f / 32.0f), b1 = acc[ai][1][m][1] * (1.0f / 32.0f);
#pragma unroll
                    for (int i = 0; i < 4; ++i) { a0[i] = sigmoidf_(a0[i]); a1[i] = sigmoidf_(a1[i]); b0[i] = sigmoidf_(b0[i]); b1[i] = sigmoidf_(b1[i]);
                        a0[i] *= __builtin_amdgcn_rcpf(fmaxf(b0[i], 1e-30f)); a1[i] *= __builtin_amdgcn_rcpf(fmaxf(b1[i], 1e-30f)); }
                    *(u32x4*)(GA + off) = pack8(a0, a1); *(u32x4*)(GB + off) = pack8(b0, b1); }
            return; }
        bf16_t* dst; int ld, colt; bool rope_t = false, isq = false, iskm = false, issig = false; const bool ikw = (FP == 0) && (pn == 2);
        if (FP == 0) {
            if (pn < 2) { colt = (pn & 1) * 256; ld = AW; rope_t = true; dst = QA + (size_t)6 * ((size_t)TOK * AW); }
            else { dst = IK; ld = 64; colt = 0; rope_t = true; }
        } else {
            const int h = pn >> 1; const int ti = (pn < 4) ? 2 + 3 * h : (pn < 16) ? h - 3 : h - 8;
            colt = (pn & 1) * 256; ld = AW; rope_t = (pn >= 4); isq = (h == 6) || (h == 8); iskm = (h == 9); dst = QA + (size_t)ti * ((size_t)TOK * AW);
        }
        constexpr float WS = (FP == 1) ? (1.0f / 32.0f) : 1.0f;
        const bool rope_w = rope_t && ((wc & 1) == 0);
        const float rs = (fq == 0) ? -1.f : 1.f; const bool rl = fq < 2;
        f32x4 cs[2][2];
#pragma unroll
        for (int bj = 0; bj < 2; ++bj)
#pragma unroll
            for (int n = 0; n < 2; ++n) cs[bj][n] = (f32x4){0.f, 0.f, 0.f, 0.f};
#pragma unroll
        for (int ai = 0; ai < 2; ++ai)
#pragma unroll
            for (int m = 0; m < 4; ++m) {
                const int row = u.pm * BM + ai * HALF + wr * 64 + m * 16 + fr; const int pos = row & (SEQ - 1);
                f32x4 c0 = (f32x4){1.f, 1.f, 1.f, 1.f}, c1 = c0, s0 = (f32x4){0.f, 0.f, 0.f, 0.f}, s1 = s0;
                if (rope_w) { const f32x4 a = *(const f32x4*)(ropec + pos * 8), b = *(const f32x4*)(ropec + pos * 8 + 4), c = *(const f32x4*)(ropes + pos * 8), d = *(const f32x4*)(ropes + pos * 8 + 4);
                    if (rl) { c0 = a; c1 = b; s0 = c * rs; s1 = d * rs; } }
#pragma unroll
                for (int bj = 0; bj < 2; ++bj) {
                    f32x4 v0 = acc[ai][bj][m][0] * WS, v1 = acc[ai][bj][m][1] * WS;
                    if (ikw && bj == 1) continue;
                    if (rope_w && !(ikw && wc != 0)) {
                        f32x4 o0, o1;
#pragma unroll
                        for (int i = 0; i < 4; ++i) { o0[i] = __shfl_xor(v0[i], 16); o1[i] = __shfl_xor(v1[i], 16); }
                        v0 = v0 * c0 + o0 * s0; v1 = v1 * c1 + o1 * s1;
                    }
                    if (isq) { v0 = v0 * C2; v1 = v1 * C2; }
                    if (FP == 0 && iskm) { cs[bj][0] += v0; cs[bj][1] += v1; }
                    if (issig) {
#pragma unroll
                        for (int i = 0; i < 4; ++i) { v0[i] = sigmoidf_(v0[i]); v1[i] = sigmoidf_(v1[i]); } }
                    const int col = bj * HALF + wc * 32 + 8 * fq;
                    if (ikw) {
                        if (wc < 2) *(u32x4*)(dst + (size_t)row * 64 + col) = pack8(v0, v1);
                        else if (wc == 2 && fq == 0) { *(f32x4*)(IW + (size_t)row * 8) = v0 * IW_SCALE; *(f32x4*)(IW + (size_t)row * 8 + 4) = v1 * IW_SCALE; }
                    } else *(u32x4*)(dst + (size_t)row * ld + colt + col) = pack8(v0, v1);
                }
            }
        if (FP == 1 && iskm) {
            __builtin_amdgcn_sched_barrier(0);
            const int b = u.pm >> 4, blk = u.pm & 15;
#pragma unroll
            for (int bj = 0; bj < 2; ++bj)
#pragma unroll
                for (int n = 0; n < 2; ++n) { f32x4 c4 = (f32x4){0.f, 0.f, 0.f, 0.f};
#pragma unroll
                    for (int ai = 0; ai < 2; ++ai)
#pragma unroll
                        for (int m = 0; m < 4; ++m) { const int row = u.pm * BM + ai * HALF + wr * 64 + m * 16 + fr; const int pos = row & (SEQ - 1);
                            f32x4 v = acc[ai][bj][m][n] * WS;
                            if (rope_w) { f32x4 cc = (f32x4){1.f, 1.f, 1.f, 1.f}, ss = (f32x4){0.f, 0.f, 0.f, 0.f};
                                const f32x4 a = *(const f32x4*)(ropec + pos * 8 + 4 * n), c = *(const f32x4*)(ropes + pos * 8 + 4 * n);
                                if (rl) { cc = a; ss = c * rs; }
                                f32x4 o;
#pragma unroll
                                for (int i = 0; i < 4; ++i) o[i] = __shfl_xor(v[i], 16);
                                v = v * cc + o * ss; }
                            c4 += v; }
#pragma unroll
                    for (int i = 0; i < 4; ++i) { float s = c4[i]; s += __shfl_xor(s, 1); s += __shfl_xor(s, 2); s += __shfl_xor(s, 4); s += __shfl_xor(s, 8);
                        if (fr == 0) { const int col = (pn & 1) * 256 + bj * HALF + wc * 32 + 8 * fq + 4 * n + i; const int h = col >> 6, d = col & 63;
                            atomicAdd(kmean + ((size_t)((b * NHEAD + h) * 16 + blk) * 64 + d), s * (1.0f / 256.0f)); } }
                    __builtin_amdgcn_sched_barrier(0); }
        }
        if (FP == 0 && iskm) {
            const int b = u.pm >> 4, blk = u.pm & 15;
#pragma unroll
            for (int bj = 0; bj < 2; ++bj)
#pragma unroll
                for (int n = 0; n < 2; ++n)
#pragma unroll
                    for (int i = 0; i < 4; ++i) { float s = cs[bj][n][i]; s += __shfl_xor(s, 1); s += __shfl_xor(s, 2); s += __shfl_xor(s, 4); s += __shfl_xor(s, 8);
                        if (fr == 0) { const int col = (pn & 1) * 256 + bj * HALF + wc * 32 + 8 * fq + 4 * n + i; const int h = col >> 6, d = col & 63;
                            atomicAdd(kmean + ((size_t)((b * NHEAD + h) * 16 + blk) * 64 + d), s * (1.0f / 256.0f)); } }
        }
    }
};
struct EpiStoreBf16 {
    static constexpr bool PERM = true, AFTER_DRAIN = false, MID_HOOK = false;
    bf16_t* O; int ld;
    __device__ __forceinline__ void operator()(f32x4 (&acc)[2][2][4][2], const Unit& u, int, int wr, int wc, int fr, int fq) const {
#pragma unroll
        for (int ai = 0; ai < 2; ++ai)
#pragma unroll
            for (int m = 0; m < 4; ++m) { const int row = u.pm * BM + ai * HALF + wr * 64 + m * 16 + fr;
#pragma unroll
                for (int bj = 0; bj < 2; ++bj) { const int col = u.pn * BM + bj * HALF + wc * 32 + 8 * fq;
                    *(u32x4*)(O + (size_t)row * ld + col) = pack8(acc[ai][bj][m][0], acc[ai][bj][m][1]); } }
    }
};
template <int MODE> struct EpiBranch {
    static constexpr bool PERM = true, AFTER_DRAIN = false, MID_HOOK = false;
    const bf16_t* G; const bf16_t* Tin; void* O;
    __device__ __forceinline__ void operator()(f32x4 (&acc)[2][2][4][2], const Unit& u, int, int wr, int wc, int fr, int fq) const {
        constexpr float WS = 1.0f / 512.0f;
#pragma unroll
        for (int ai = 0; ai < 2; ++ai)
#pragma unroll
            for (int m = 0; m < 4; ++m) { const int row = u.pm * BM + ai * HALF + wr * 64 + m * 16 + fr;
#pragma unroll
                for (int bj = 0; bj < 2; ++bj) { const size_t off = (size_t)row * DMODEL + u.pn * BM + bj * HALF + wc * 32 + 8 * fq;
                    f32x4 g0, g1; unpack8(*(const u32x4*)(G + off), g0, g1);
                    f32x4 v0 = acc[ai][bj][m][0] * WS * g0, v1 = acc[ai][bj][m][1] * WS * g1;
                    if (MODE == 1) { f32x4 t0, t1; unpack8(*(const u32x4*)(Tin + off), t0, t1); v0 += t0; v1 += t1; *(u32x2*)((unsigned char*)O + off) = pack8_fp8(v0 * 8.0f, v1 * 8.0f); }
                    else *(u32x4*)((bf16_t*)O + off) = pack8(v0, v1); } }
    }
};
__device__ __forceinline__ u32x4 widen16(const u32x2 a, const u32x2 b) {
    const auto rx = __builtin_amdgcn_permlane16_swap(a.x, b.x, false, false); const auto ry = __builtin_amdgcn_permlane16_swap(a.y, b.y, false, false);
    return (u32x4){(unsigned)rx[0], (unsigned)ry[0], (unsigned)rx[1], (unsigned)ry[1]}; }
struct EpiMerged {
    static constexpr bool PERM = true, AFTER_DRAIN = false, MID_HOOK = true;
    const bf16_t* GA; const bf16_t* GB; unsigned char* O;
    __device__ __forceinline__ void mid(f32x4 (&acc)[2][2][4][2], const Unit& u, int, int wr, int wc, int fr_in, int fq_in) const {
        int fr = fr_in, fq = fq_in; asm volatile("" : "+v"(fr), "+v"(fq));
#pragma unroll
        for (int ai = 0; ai < 2; ++ai) { u32x4 ga_[4][2];
#pragma unroll
            for (int m = 0; m < 4; ++m)
#pragma unroll
                for (int bj = 0; bj < 2; ++bj) ga_[m][bj] = *(const u32x4*)(GA + (size_t)(u.pm * BM + ai * HALF + wr * 64 + m * 16 + fr) * DMODEL + u.pn * BM + bj * HALF + wc * 32 + 8 * fq);
#pragma unroll
            for (int m = 0; m < 4; ++m)
#pragma unroll
                for (int bj = 0; bj < 2; ++bj) { f32x4 a0, a1; unpack8(ga_[m][bj], a0, a1); acc[ai][bj][m][0] *= a0; acc[ai][bj][m][1] *= a1; }
            asm volatile("" ::: "memory"); }
    }
    __device__ __forceinline__ void operator()(f32x4 (&acc)[2][2][4][2], const Unit& u, int, int wr, int wc, int fr, int fq) const {
        constexpr float WS = 8.0f / 512.0f;
        const int odd = fq & 1;
#pragma unroll
        for (int ai = 0; ai < 2; ++ai) { u32x4 gv[4][2];
#pragma unroll
            for (int m = 0; m < 4; ++m)
#pragma unroll
                for (int bj = 0; bj < 2; ++bj) gv[m][bj] = *(const u32x4*)(GB + (size_t)(u.pm * BM + ai * HALF + wr * 64 + m * 16 + fr) * DMODEL + u.pn * BM + bj * HALF + wc * 32 + 8 * fq);
#pragma unroll
            for (int mp = 0; mp < 2; ++mp) { const int row = u.pm * BM + ai * HALF + wr * 64 + (2 * mp + odd) * 16 + fr;
#pragma unroll
                for (int bj = 0; bj < 2; ++bj) {
                    f32x4 g0, g1, h0, h1; unpack8(gv[2 * mp][bj], g0, g1); unpack8(gv[2 * mp + 1][bj], h0, h1);
                    const u32x4 v = widen16(pack8_fp8(acc[ai][bj][2 * mp][0] * WS * g0, acc[ai][bj][2 * mp][1] * WS * g1), pack8_fp8(acc[ai][bj][2 * mp + 1][0] * WS * h0, acc[ai][bj][2 * mp + 1][1] * WS * h1));
                    *(u32x4*)(O + (size_t)row * DMODEL + u.pn * BM + bj * HALF + wc * 32 + 8 * (fq - odd)) = v; } }
            asm volatile("" ::: "memory"); }
    }
};
struct EpiResidualB {
    static constexpr bool PERM = true, AFTER_DRAIN = false, MID_HOOK = false;
    const bf16_t* h1; const float* rstd; const float* g; bf16_t* o;
    __device__ __forceinline__ void operator()(f32x4 (&acc)[2][2][4][2], const Unit& u, int, int wr, int wc, int fr, int fq) const {
        f32x4 gi[2][2];
#pragma unroll
        for (int bj = 0; bj < 2; ++bj)
#pragma unroll
            for (int n = 0; n < 2; ++n) { const f32x4 gg = *(const f32x4*)(g + u.pn * BM + bj * HALF + wc * 32 + 8 * fq + 4 * n);
#pragma unroll
                for (int i = 0; i < 4; ++i) gi[bj][n][i] = (gg[i] != 0.f) ? 1.0f / gg[i] : 0.f; }
#pragma unroll
        for (int ai = 0; ai < 2; ++ai) { u32x4 hv[4][2]; float rs[4];
#pragma unroll
            for (int m = 0; m < 4; ++m) { const int row = u.pm * BM + ai * HALF + wr * 64 + m * 16 + fr; rs[m] = rstd[row];
#pragma unroll
                for (int bj = 0; bj < 2; ++bj) hv[m][bj] = *(const u32x4*)(h1 + (size_t)row * DMODEL + u.pn * BM + bj * HALF + wc * 32 + 8 * fq); }
#pragma unroll
            for (int m = 0; m < 4; ++m) { const int row = u.pm * BM + ai * HALF + wr * 64 + m * 16 + fr; const float rsv = rs[m];
#pragma unroll
                for (int bj = 0; bj < 2; ++bj) { const size_t off = (size_t)row * DMODEL + u.pn * BM + bj * HALF + wc * 32 + 8 * fq;
                    f32x4 h0, h1v; unpack8(hv[m][bj], h0, h1v);
                    *(u32x4*)(o + off) = pack8(h0 * rsv * gi[bj][0] + acc[ai][bj][m][0] * (1.0f / 256.0f), h1v * rsv * gi[bj][1] + acc[ai][bj][m][1] * (1.0f / 256.0f)); } }
            asm volatile("" ::: "memory"); }
    }
};
struct EpiResidual {
    static constexpr bool PERM = false, AFTER_DRAIN = false, MID_HOOK = false;
    const float* base; float* out;
    __device__ __forceinline__ void operator()(f32x4 (&acc)[2][2][4][2], const Unit& u, int, int wr, int wc, int fr, int fq) const {
#pragma unroll
        for (int ai = 0; ai < 2; ++ai)
#pragma unroll
            for (int m = 0; m < 4; ++m) { const int row = u.pm * BM + ai * HALF + wr * 64 + m * 16 + fr;
#pragma unroll
                for (int bj = 0; bj < 2; ++bj)
#pragma unroll
                    for (int n = 0; n < 2; ++n) { const size_t off = (size_t)row * DMODEL + u.pn * BM + bj * HALF + wc * 32 + 16 * n + 4 * fq;
                        *(f32x4*)(out + off) = *(const f32x4*)(base + off) + acc[ai][bj][m][n] * (1.0f / 256.0f); } }
    }
};
struct EpiPle {
    static constexpr bool PERM = false, AFTER_DRAIN = false, MID_HOOK = false;
    float* x; const bf16_t* P; float* stats;
    __device__ __forceinline__ void operator()(f32x4 (&acc)[2][2][4][2], const Unit& u, int, int wr, int wc, int fr, int fq) const {
#pragma unroll
        for (int ai = 0; ai < 2; ++ai)
#pragma unroll
            for (int m = 0; m < 4; ++m) { const int row = u.pm * BM + ai * HALF + wr * 64 + m * 16 + fr; float ss = 0.f;
#pragma unroll
                for (int bj = 0; bj < 2; ++bj)
#pragma unroll
                    for (int n = 0; n < 2; ++n) { const size_t off = (size_t)row * DMODEL + u.pn * BM + bj * HALF + wc * 32 + 16 * n + 4 * fq;
                        const u32x2 pw = *(const u32x2*)(P + off); const f32x4 pv = (f32x4){bf_lo(pw.x), bf_hi(pw.x), bf_lo(pw.y), bf_hi(pw.y)};
                        f32x4 g = acc[ai][bj][m][n] * (1.0f / 32.0f);
#pragma unroll
                        for (int i = 0; i < 4; ++i) g[i] = sigmoidf_(g[i]);
                        const f32x4 o = *(const f32x4*)(x + off) + g * pv; *(f32x4*)(x + off) = o;
                        ss += (o[0] * o[0] + o[1] * o[1]) + (o[2] * o[2] + o[3] * o[3]); }
                ss += __shfl_xor(ss, 16); ss += __shfl_xor(ss, 32);
                if (fq == 0) stats[(size_t)row * 16 + u.pn * 4 + wc] = ss; }
    }
};
struct EpiPleFin {
    static constexpr bool PERM = true, AFTER_DRAIN = false, MID_HOOK = false;
    float* x; const bf16_t* X1; const bf16_t* P; float* stats; unsigned* cnt; const float* gfin;
    __device__ __forceinline__ void operator()(f32x4 (&acc)[2][2][4][2], const Unit& u, int, int wr, int wc, int fr, int fq) const {
#pragma unroll
        for (int ai = 0; ai < 2; ++ai)
#pragma unroll
            for (int m = 0; m < 4; ++m) { const int row = u.pm * BM + ai * HALF + wr * 64 + m * 16 + fr; float ss = 0.f;
#pragma unroll
                for (int bj = 0; bj < 2; ++bj) { const int col = u.pn * BM + bj * HALF + wc * 32 + 8 * fq; const size_t off = (size_t)row * DMODEL + col;
                    f32x4 p0, p1; unpack8(*(const u32x4*)(P + off), p0, p1);
                    f32x4 x0, x1v; unpack8(*(const u32x4*)(X1 + off), x0, x1v);
                    f32x4 g0 = acc[ai][bj][m][0] * (1.0f / 32.0f), g1 = acc[ai][bj][m][1] * (1.0f / 32.0f);
#pragma unroll
                    for (int i = 0; i < 4; ++i) { g0[i] = sigmoidf_(g0[i]); g1[i] = sigmoidf_(g1[i]); }
                    const f32x4 o0 = x0 + g0 * p0, o1 = x1v + g1 * p1; acc[ai][bj][m][0] = o0; acc[ai][bj][m][1] = o1;
                    ss += ((o0[0] * o0[0] + o0[1] * o0[1]) + (o0[2] * o0[2] + o0[3] * o0[3])) + ((o1[0] * o1[0] + o1[1] * o1[1]) + (o1[2] * o1[2] + o1[3] * o1[3])); }
                ss += __shfl_xor(ss, 16); ss += __shfl_xor(ss, 32);
                if (fq == 0) __hip_atomic_store(stats + (size_t)row * 16 + u.pn * 4 + wc, ss, __ATOMIC_RELAXED, __HIP_MEMORY_SCOPE_AGENT); }
        unsigned* const c = cnt + 16 * u.pm;
        asm volatile("s_waitcnt vmcnt(0)" ::: "memory");
        if (fr == 0 && fq == 0) { (void)__hip_atomic_fetch_add(c, 1u, __ATOMIC_RELAXED, __HIP_MEMORY_SCOPE_AGENT);
            unsigned sp = 0; while (__hip_atomic_load(c, __ATOMIC_RELAXED, __HIP_MEMORY_SCOPE_AGENT) < 32u) { __builtin_amdgcn_s_sleep(1); if (++sp > (1u << 24)) break; } }
        asm volatile("" ::: "memory");
        f32x4 t4[2][4];
#pragma unroll
        for (int ai = 0; ai < 2; ++ai)
#pragma unroll
            for (int m = 0; m < 4; ++m) { const int row = u.pm * BM + ai * HALF + wr * 64 + m * 16 + fr; const float* sp_ = stats + (size_t)row * 16 + 4 * fq;
                asm volatile("global_load_dwordx4 %0, %1, off sc1" : "=v"(t4[ai][m]) : "v"(sp_) : "memory"); }
        asm volatile("s_waitcnt vmcnt(0)" : "+v"(t4[0][0]), "+v"(t4[0][1]), "+v"(t4[0][2]), "+v"(t4[0][3]), "+v"(t4[1][0]), "+v"(t4[1][1]), "+v"(t4[1][2]), "+v"(t4[1][3]) :: "memory");
#pragma unroll
        for (int ai = 0; ai < 2; ++ai)
#pragma unroll
            for (int m = 0; m < 4; ++m) { const int row = u.pm * BM + ai * HALF + wr * 64 + m * 16 + fr;
                float s = (t4[ai][m][0] + t4[ai][m][1]) + (t4[ai][m][2] + t4[ai][m][3]); s += __shfl_xor(s, 16); s += __shfl_xor(s, 32);
                const float rinv = 1.0f / sqrtf(s * (1.f / DMODEL) + RMS_EPS);
#pragma unroll
                for (int bj = 0; bj < 2; ++bj) { const int col = u.pn * BM + bj * HALF + wc * 32 + 8 * fq;
                    *(f32x4*)(x + (size_t)row * DMODEL + col) = acc[ai][bj][m][0] * rinv * *(const f32x4*)(gfin + col);
                    *(f32x4*)(x + (size_t)row * DMODEL + col + 4) = acc[ai][bj][m][1] * rinv * *(const f32x4*)(gfin + col + 4); } }
    }
};
struct EpiSwiglu {
    static constexpr bool PERM = true, AFTER_DRAIN = false, MID_HOOK = false;
    unsigned char* HID;
    __device__ __forceinline__ void operator()(f32x4 (&acc)[2][2][4][2], const Unit& u, int, int wr, int wc, int fr, int fq) const {
        constexpr float WS = 1.0f / 32.0f;
#pragma unroll
        for (int ai = 0; ai < 2; ++ai)
#pragma unroll
            for (int m = 0; m < 4; ++m) { const int row = u.pm * BM + ai * HALF + wr * 64 + m * 16 + fr;
                f32x4 h0, h1;
#pragma unroll
                for (int i = 0; i < 4; ++i) { const float g0 = acc[ai][0][m][0][i] * WS, g1 = acc[ai][0][m][1][i] * WS;
                    h0[i] = g0 * sigmoidf_(g0) * (acc[ai][1][m][0][i] * WS); h1[i] = g1 * sigmoidf_(g1) * (acc[ai][1][m][1][i] * WS); }
                { const u32x2 hv = pack8_fp8(h0, h1);
                  __hip_atomic_store((unsigned long long*)(HID + (size_t)row * DEXP + u.pn * HALF + wc * 32 + 8 * fq), (unsigned long long)hv.x | ((unsigned long long)hv.y << 32), __ATOMIC_RELAXED, __HIP_MEMORY_SCOPE_AGENT); } }
    }
};
struct EpiDown {
    static constexpr bool PERM = true, AFTER_DRAIN = false, MID_HOOK = false;
    unsigned char* Y; const PG8_LAS int* tokk; const PG8_LAS float* wt;
    __device__ __forceinline__ void operator()(f32x4 (&acc)[2][2][4][2], const Unit& u, int ui, int wr, int wc, int fr, int fq) const {
        const int odd = fq & 1;
#pragma unroll
        for (int ai = 0; ai < 2; ++ai)
#pragma unroll
            for (int mp = 0; mp < 2; ++mp) { const int r0 = ai * HALF + wr * 64 + (2 * mp) * 16 + fr, r1 = r0 + 16;
                const int tk0 = tokk[ui * 256 + r0], tk1 = tokk[ui * 256 + r1]; const float w0 = wt[ui * 256 + r0] * 2.0f, w1 = wt[ui * 256 + r1] * 2.0f;
                const int tk = odd ? tk1 : tk0;
#pragma unroll
                for (int bj = 0; bj < 2; ++bj) {
                    const u32x4 v = widen16(pack8_fp8(acc[ai][bj][2 * mp][0] * w0, acc[ai][bj][2 * mp][1] * w0), pack8_fp8(acc[ai][bj][2 * mp + 1][0] * w1, acc[ai][bj][2 * mp + 1][1] * w1));
                    *(u32x4*)(Y + (size_t)tk * DMODEL + u.pn * BM + bj * HALF + wc * 32 + 8 * (fq - odd)) = v; } }
    }
};
}

namespace att {
using bf16x8 = __attribute__((ext_vector_type(8))) short;
using s16x4 = __attribute__((ext_vector_type(4))) short;
using f32x16 = __attribute__((ext_vector_type(16))) float;
using u32x4 = __attribute__((ext_vector_type(4))) unsigned;
using u32x2 = __attribute__((ext_vector_type(2))) unsigned;
typedef unsigned short bf16r;
constexpr int SEQL = 4096, D = 64, DM = 512;
constexpr int NW = 8, QBLK = 32, QB = QBLK * NW, KVBLK = 64;
constexpr int SLOTB = 8192, NSLOT = 2;
constexpr int LDS_K = 0, LDS_V = NSLOT * SLOTB, LDS_WS = 2 * NSLOT * SLOTB, LDS_OST = LDS_WS + NW * 64 * 4, LDS_KM = LDS_OST + NW * 4096, LDS_BYTES = LDS_KM + 16 * 64 * 4;
constexpr float THR = 8.0f;
__device__ __forceinline__ int crow(int r, int hi) { return (r & 3) + 8 * (r >> 2) + 4 * hi; }
__device__ __forceinline__ void glds16(const void* gsrc, unsigned lds_dst) { unsigned keep;
    asm volatile("s_mov_b32 %0, m0\n\ts_mov_b32 m0, %2\n\ts_nop 0\n\tglobal_load_lds_dwordx4 %1, off\n\ts_mov_b32 m0, %0" : "=&s"(keep) : "v"(gsrc), "s"(lds_dst) : "memory"); }
typedef float f32x2_t __attribute__((ext_vector_type(2))); typedef __bf16 bf16x2_t __attribute__((ext_vector_type(2)));
__device__ __forceinline__ unsigned cvtpk_s(float lo, float hi) { f32x2_t v = {lo, hi}; bf16x2_t b = __builtin_convertvector(v, bf16x2_t); return __builtin_bit_cast(unsigned, b); }
__device__ __forceinline__ void qkt(f32x16& p0, f32x16& p1, const char* Kslot, const bf16x8* qr, const f32x16& cin, int r32, int hi) {
    const char* kb = Kslot + hi * 1024 + r32 * 16;
#pragma unroll
    for (int d0 = 0; d0 < 4; ++d0) {
        const bf16x8 b0 = *reinterpret_cast<const bf16x8*>(kb + d0 * 2048);
        const bf16x8 b1 = *reinterpret_cast<const bf16x8*>(kb + d0 * 2048 + 512);
        if (d0 == 0) { p0 = __builtin_amdgcn_mfma_f32_32x32x16_bf16(b0, qr[0], cin, 0, 0, 0); p1 = __builtin_amdgcn_mfma_f32_32x32x16_bf16(b1, qr[0], cin, 0, 0, 0); }
        else { p0 = __builtin_amdgcn_mfma_f32_32x32x16_bf16(b0, qr[d0], p0, 0, 0, 0); p1 = __builtin_amdgcn_mfma_f32_32x32x16_bf16(b1, qr[d0], p1, 0, 0, 0); } }
}
__device__ __forceinline__ float rowmax(const f32x16& p0, const f32x16& p1) {
    float a = __builtin_fmaxf(p0[0], p1[0]);
#pragma unroll
    for (int r = 1; r < 16; ++r) a = __builtin_fmaxf(a, __builtin_fmaxf(p0[r], p1[r]));
    auto rr = __builtin_amdgcn_permlane32_swap(__float_as_uint(a), __float_as_uint(a), false, false);
    return __builtin_fmaxf(__uint_as_float(rr[0]), __uint_as_float(rr[1]));
}
__device__ __forceinline__ void pv(f32x16* o, int vb, bf16x8 pa0, bf16x8 pa1, bf16x8 pa2, bf16x8 pa3) {
#pragma unroll
    for (int d0 = 0; d0 < 2; ++d0) { s16x4 lo[4], hi[4];
#pragma unroll
        for (int ks = 0; ks < 4; ++ks) {
            asm volatile("ds_read_b64_tr_b16 %0,%1 offset:%c2" : "=&v"(lo[ks]) : "v"(vb), "i"(d0 * 4096 + ks * 1024) : "memory");
            asm volatile("ds_read_b64_tr_b16 %0,%1 offset:%c2" : "=&v"(hi[ks]) : "v"(vb), "i"(d0 * 4096 + ks * 1024 + 512) : "memory"); }
        asm volatile("s_waitcnt lgkmcnt(0)" ::: "memory"); __builtin_amdgcn_sched_barrier(0);
#define ATT_PK(k) (bf16x8){lo[k][0], lo[k][1], lo[k][2], lo[k][3], hi[k][0], hi[k][1], hi[k][2], hi[k][3]}
        o[d0] = __builtin_amdgcn_mfma_f32_32x32x16_bf16(pa0, ATT_PK(0), o[d0], 0, 0, 0);
        o[d0] = __builtin_amdgcn_mfma_f32_32x32x16_bf16(pa1, ATT_PK(1), o[d0], 0, 0, 0);
        o[d0] = __builtin_amdgcn_mfma_f32_32x32x16_bf16(pa2, ATT_PK(2), o[d0], 0, 0, 0);
        o[d0] = __builtin_amdgcn_mfma_f32_32x32x16_bf16(pa3, ATT_PK(3), o[d0], 0, 0, 0);
#undef ATT_PK
    }
}
__device__ __forceinline__ float max3a(float a, float b, float c) { float r; asm("v_max3_f32 %0, %1, %2, %3" : "=v"(r) : "v"(a), "v"(b), "v"(c)); return r; }
__device__ __forceinline__ float rowmax_a(const f32x16& p0, const f32x16& p1) {
    float a = max3a(p0[0], p0[1], p1[0]), b = max3a(p0[2], p0[3], p1[1]); a = max3a(a, p1[2], p1[3]);
#pragma unroll
    for (int r = 4; r < 16; r += 4) { a = max3a(a, p0[r], p0[r + 1]); b = max3a(b, p0[r + 2], p0[r + 3]); a = max3a(a, p1[r], p1[r + 1]); b = max3a(b, p1[r + 2], p1[r + 3]); }
    float m; asm("v_max_f32_e32 %0, %1, %2" : "=v"(m) : "v"(a), "v"(b));
    auto rr = __builtin_amdgcn_permlane32_swap(__float_as_uint(m), __float_as_uint(m), false, false);
    float o; asm("v_max_f32_e32 %0, %1, %2" : "=v"(o) : "v"(__uint_as_float(rr[0])), "v"(__uint_as_float(rr[1]))); return o;
}
#define ATT_WAIT_BAR0() asm volatile("s_waitcnt vmcnt(0) lgkmcnt(0)\n\ts_barrier" ::: "memory")

template <int MODE> __device__ __forceinline__ void attn_unit(int b, int h, int qb, const bf16r* Q, const bf16r* __restrict__ K, const bf16r* __restrict__ V, bf16r* O, const void* aux, char* shm, const int tid_in) {
    int tidl_ = tid_in; asm volatile("" : "+v"(tidl_));
    const int tid = tidl_, lane = tid & 63, r32 = lane & 31, hi = lane >> 5; const int wid = __builtin_amdgcn_readfirstlane(tid >> 6);
    const long rowbase = (long)b * SEQL; const int q0 = qb * QB;
    const bf16r* Qw = Q + (rowbase + q0 + wid * QBLK) * DM + h * D;
    const bf16r* Kh = K + rowbase * DM + h * D, *Vh = V + rowbase * DM + h * D;
    const unsigned lds0 = (unsigned)(uintptr_t)shm;
    float* wsf = (float*)(shm + LDS_WS) + wid * 64;
    const bf16r* ksrc = Kh + (long)lane * DM + wid * 8;
    const bf16r* vsrc = Vh + (long)(16 * (wid & 3) + (lane >> 2)) * DM + (wid >> 2) * 32 + (lane & 3) * 8;
    const unsigned kdst = lds0 + LDS_K + wid * 1024, vdst = lds0 + LDS_V + wid * 1024;
#define DMA_K(t, slot) glds16(ksrc + (long)(t) * KVBLK * DM, (unsigned)__builtin_amdgcn_readfirstlane(kdst + (slot)))
#define DMA_V(t, slot) glds16(vsrc + (long)(t) * KVBLK * DM, (unsigned)__builtin_amdgcn_readfirstlane(vdst + (slot)))
    const int vb0 = (int)(lds0 + LDS_V) + ((lane >> 4) & 1) * 32 + (lane & 3) * 8 + (4 * hi + ((lane & 15) >> 2)) * 64;
    const char* Kbase = shm + LDS_K;
    const int NT = (q0 + QB) / KVBLK;
    DMA_K(0, 0); DMA_V(0, 0);
    bf16x8 qr[4];
#pragma unroll
    for (int d0 = 0; d0 < 4; ++d0) qr[d0] = *reinterpret_cast<const bf16x8*>(&Qw[(long)r32 * DM + d0 * 16 + hi * 8]);
    unsigned selmask = 0u;
    if (MODE == 0) {
        float* km = (float*)(shm + LDS_KM); const float* kmg = (const float*)aux + (size_t)(b * 8 + h) * 16 * 64;
        for (int i = tid; i < 16 * 64; i += NW * 64) km[i] = kmg[i];
        asm volatile("s_waitcnt vmcnt(0) lgkmcnt(0)" ::: "memory"); __syncthreads();
        float g[15];
#pragma unroll
        for (int j = 0; j < 15; ++j) { g[j] = -INFINITY;
            if (j < qb) { float s = 0.f;
#pragma unroll
                for (int d0 = 0; d0 < 4; ++d0)
#pragma unroll
                    for (int e = 0; e < 8; ++e) s += __uint_as_float(((unsigned)(unsigned short)qr[d0][e]) << 16) * km[j * 64 + d0 * 16 + hi * 8 + e];
                auto rr = __builtin_amdgcn_permlane32_swap(__float_as_uint(s), __float_as_uint(s), false, false);
                g[j] = __uint_as_float(rr[0]) + __uint_as_float(rr[1]); } }
#pragma unroll
        for (int k = 0; k < 3; ++k) { float best = -INFINITY; int bi = -1;
#pragma unroll
            for (int j = 0; j < 15; ++j) if (j < qb && !((selmask >> j) & 1u) && g[j] > best) { best = g[j]; bi = j; }
            if (bi >= 0) selmask |= 1u << bi; }
    }
    const unsigned* mrow = nullptr;
    if (MODE == 1) mrow = (const unsigned*)aux + (size_t)(rowbase + q0 + wid * QBLK + r32) * 128;
    float mhat = 0.f, l_reg = 0.f; f32x16 o[2]; o[0] = f32x16{}; o[1] = f32x16{};
    f32x16 negm = f32x16{};
    const int qrel = wid * QBLK + r32;
    for (int t = 0; t < NT; ++t) {
        ATT_WAIT_BAR0();
        if (t + 1 < NT) { DMA_K(t + 1, ((t + 1) & 1) * SLOTB); DMA_V(t + 1, ((t + 1) & 1) * SLOTB); }
        u32x2 mw = (u32x2){0u, 0u};
        if (MODE == 1) mw = *(const u32x2*)(mrow + 2 * t);
        f32x16 p0, p1;
        if (MODE == 0 && t < NT - 4) {
            const bool selq = (selmask >> (t >> 2)) & 1u; f32x16 cin;
#pragma unroll
            for (int r = 0; r < 16; ++r) cin[r] = selq ? negm[r] : -1e30f;
            qkt(p0, p1, Kbase + (t & 1) * SLOTB, qr, cin, r32, hi);
        } else qkt(p0, p1, Kbase + (t & 1) * SLOTB, qr, negm, r32, hi);
        if (MODE == 0) asm volatile("s_nop 15\n\ts_nop 7" : "+v"(p0), "+v"(p1));
        float rm;
        if (MODE == 0) { const int jb = t - (NT - 4);
            if (jb >= 0) { const int kb = 64 * jb + 4 * hi;
#pragma unroll
                for (int r = 0; r < 16; ++r) { const int kv = kb + (r & 3) + 8 * (r >> 2); if (kv > qrel) p0[r] = -INFINITY; if (kv + 32 > qrel) p1[r] = -INFINITY; } }
            rm = rowmax_a(p0, p1); }
        else { const int w0 = (int)(mw.x >> (4 * hi)), w1 = (int)(mw.y >> (4 * hi));
#pragma unroll
            for (int r = 0; r < 16; ++r) { const int bit = (r & 3) + 8 * (r >> 2);
                const unsigned m0 = (unsigned)((w0 << (31 - bit)) >> 31), m1 = (unsigned)((w1 << (31 - bit)) >> 31);
                p0[r] = __uint_as_float((__float_as_uint(p0[r]) & m0) | (0xff800000u & ~m0)); p1[r] = __uint_as_float((__float_as_uint(p1[r]) & m1) | (0xff800000u & ~m1)); }
            rm = rowmax_a(p0, p1); }
        if (__any(rm > THR)) {
            const float dl = __builtin_fmaxf(rm, 0.f); mhat += dl;
#pragma unroll
            for (int r = 0; r < 16; ++r) negm[r] = -mhat;
#pragma unroll
            for (int r = 0; r < 16; ++r) { p0[r] -= dl; p1[r] -= dl; }
            const float f = __builtin_amdgcn_exp2f(-dl); l_reg *= f; if (hi == 0) wsf[r32] = f;
            asm volatile("s_waitcnt lgkmcnt(0)" ::: "memory");
#pragma unroll
            for (int d_ = 0; d_ < 2; ++d_)
#pragma unroll
                for (int r = 0; r < 16; ++r) o[d_][r] *= wsf[crow(r, hi)];
        }
        float sacc = 0.f;
#pragma unroll
        for (int r = 0; r < 16; ++r) { p0[r] = __builtin_amdgcn_exp2f(p0[r]); p1[r] = __builtin_amdgcn_exp2f(p1[r]); sacc += p0[r] + p1[r]; }
        l_reg += sacc;
        u32x4 pw0, pw1, pw2, pw3;
        pw0 = (u32x4){cvtpk_s(p0[0], p0[1]), cvtpk_s(p0[2], p0[3]), cvtpk_s(p0[4], p0[5]), cvtpk_s(p0[6], p0[7])};
        pw1 = (u32x4){cvtpk_s(p0[8], p0[9]), cvtpk_s(p0[10], p0[11]), cvtpk_s(p0[12], p0[13]), cvtpk_s(p0[14], p0[15])};
        pw2 = (u32x4){cvtpk_s(p1[0], p1[1]), cvtpk_s(p1[2], p1[3]), cvtpk_s(p1[4], p1[5]), cvtpk_s(p1[6], p1[7])};
        pw3 = (u32x4){cvtpk_s(p1[8], p1[9]), cvtpk_s(p1[10], p1[11]), cvtpk_s(p1[12], p1[13]), cvtpk_s(p1[14], p1[15])};
        __builtin_amdgcn_sched_barrier(0);
        pv(o, vb0 + (t & 1) * SLOTB, __builtin_bit_cast(bf16x8, pw0), __builtin_bit_cast(bf16x8, pw1), __builtin_bit_cast(bf16x8, pw2), __builtin_bit_cast(bf16x8, pw3));
    }
    { auto rr = __builtin_amdgcn_permlane32_swap(__float_as_uint(l_reg), __float_as_uint(l_reg), false, false); l_reg = __uint_as_float(rr[0]) + __uint_as_float(rr[1]); }
    if (hi == 0) wsf[32 + r32] = l_reg; asm volatile("s_waitcnt lgkmcnt(0)" ::: "memory");
    float rli[16];
#pragma unroll
    for (int r = 0; r < 16; ++r) rli[r] = __builtin_amdgcn_rcpf(wsf[32 + crow(r, hi)]);
    unsigned char* Ow = (unsigned char*)O + (rowbase + q0 + wid * QBLK) * DM + h * D;
    { unsigned char* stg = (unsigned char*)(shm + LDS_OST) + wid * 2048;
#pragma unroll
        for (int r = 0; r < 16; ++r) { const int orow = crow(r, hi);
            const float sc16 = rli[r] * 16.0f; const int pk = __builtin_amdgcn_cvt_pk_fp8_f32(o[0][r] * sc16, o[1][r] * sc16, 0, false);
            stg[orow * 64 + r32] = (unsigned char)(pk & 0xff); stg[orow * 64 + 32 + r32] = (unsigned char)((pk >> 8) & 0xff); }
        asm volatile("s_waitcnt lgkmcnt(0)" ::: "memory");
#pragma unroll
        for (int i = 0; i < 2; ++i) { const int row = i * 16 + (lane >> 2), ch = lane & 3; const u32x4 v = *(const u32x4*)(stg + row * 64 + ch * 16); *(u32x4*)(Ow + (long)row * DM + ch * 16) = v; } }
    asm volatile("s_waitcnt vmcnt(0) lgkmcnt(0)\n\ts_barrier" ::: "memory");
#undef DMA_K
#undef DMA_V
}
}

namespace att2 {
using bf16=unsigned short;
using u32x2=__attribute__((ext_vector_type(2)))unsigned;
using bf16x8=__attribute__((ext_vector_type(8)))short;
using s16x4=__attribute__((ext_vector_type(4)))short;
using f32x16=__attribute__((ext_vector_type(16)))float;
using u32x4=__attribute__((ext_vector_type(4)))unsigned;
constexpr int BATCH=8,NHEAD=8,SEQ=4096,D=64,DM=NHEAD*D;
constexpr int NW=8,QBLK=32,QB=QBLK*NW,KVBLK=64,NQB=SEQ/QB;
constexpr int ATTN_PITCH=DM, ATTN_UNIT_ROWS=QB;
__device__ __forceinline__ int crow(int r,int hi){return (r&3)+8*(r>>2)+4*hi;}
#define SBAR() __builtin_amdgcn_sched_barrier(0)
__device__ __forceinline__ void cmask(f32x16&p0,f32x16&p1,int jb,int qrel,int hi){
  const float NEG=-INFINITY; int kb=64*jb+4*hi;
  #pragma unroll
  for(int r=0;r<16;++r){int kv=kb+(r&3)+8*(r>>2); if(kv>qrel)p0[r]=NEG; if(kv+32>qrel)p1[r]=NEG;}
}

constexpr int NSLOT=3, SLOTB=8192;
constexpr int LDS_K=0, LDS_V=NSLOT*SLOTB, LDS_WS=2*NSLOT*SLOTB, LDS_OST=LDS_WS+NW*64*4, LDS_KM=LDS_OST+NW*2048, LDS_BYTES=LDS_KM+16*64*4;
__device__ __forceinline__ void glds16(const void*gsrc,unsigned lds_dst){unsigned keep;
  asm volatile("s_mov_b32 %0, m0\n\ts_mov_b32 m0, %2\n\ts_nop 0\n\tglobal_load_lds_dwordx4 %1, off\n\ts_mov_b32 m0, %0":"=&s"(keep):"v"(gsrc),"s"(lds_dst):"memory");}
__device__ __forceinline__ float max3f(float a,float b,float c){float r;asm("v_max3_f32 %0, %1, %2, %3":"=v"(r):"v"(a),"v"(b),"v"(c));return r;}
__device__ __forceinline__ float max2f(float a,float b){float r;asm("v_max_f32_e32 %0, %1, %2":"=v"(r):"v"(a),"v"(b));return r;}
__device__ __forceinline__ float fadd_s(float a,float b){float r;asm("v_add_f32_e32 %0, %1, %2":"=v"(r):"v"(a),"v"(b));return r;}
__device__ __forceinline__ float fsub_s(float a,float b){float r;asm("v_sub_f32_e32 %0, %1, %2":"=v"(r):"v"(a),"v"(b));return r;}
typedef float f32x2_t __attribute__((ext_vector_type(2))); typedef __bf16 bf16x2_t __attribute__((ext_vector_type(2)));
__device__ __forceinline__ unsigned cvtpk_s(float lo,float hi){f32x2_t v={lo,hi};bf16x2_t b=__builtin_convertvector(v,bf16x2_t);return __builtin_bit_cast(unsigned,b);}
#define WAIT_BAR(N) asm volatile("s_waitcnt vmcnt(" #N ") lgkmcnt(0)\n\ts_barrier":::"memory")

__device__ __forceinline__ void qkt(f32x16&p0,f32x16&p1,const char*Kslot,const bf16x8*qr,const f32x16&negm,int r32,int hi){
  const char*kb=Kslot+hi*1024+r32*16;
  #pragma unroll
  for(int d0=0;d0<4;++d0){
    const bf16x8 b0=*reinterpret_cast<const bf16x8*>(kb+d0*2048);
    const bf16x8 b1=*reinterpret_cast<const bf16x8*>(kb+d0*2048+512);
    if(d0==0){p0=__builtin_amdgcn_mfma_f32_32x32x16_bf16(b0,qr[0],negm,0,0,0);p1=__builtin_amdgcn_mfma_f32_32x32x16_bf16(b1,qr[0],negm,0,0,0);}
    else{p0=__builtin_amdgcn_mfma_f32_32x32x16_bf16(b0,qr[d0],p0,0,0,0);p1=__builtin_amdgcn_mfma_f32_32x32x16_bf16(b1,qr[d0],p1,0,0,0);}}
}
typedef __attribute__((address_space(3))) const char* lds_cptr;
typedef short v4i16_t __attribute__((ext_vector_type(4)));
__device__ __forceinline__ void kload8(bf16x8*kf,lds_cptr kp){
  kf[0]=*(const __attribute__((address_space(3))) bf16x8*)(kp);      kf[1]=*(const __attribute__((address_space(3))) bf16x8*)(kp+512);
  kf[2]=*(const __attribute__((address_space(3))) bf16x8*)(kp+2048); kf[3]=*(const __attribute__((address_space(3))) bf16x8*)(kp+2560);
  kf[4]=*(const __attribute__((address_space(3))) bf16x8*)(kp+4096); kf[5]=*(const __attribute__((address_space(3))) bf16x8*)(kp+4608);
  kf[6]=*(const __attribute__((address_space(3))) bf16x8*)(kp+6144); kf[7]=*(const __attribute__((address_space(3))) bf16x8*)(kp+6656);
}
__device__ __forceinline__ void kload2(bf16x8*kf,lds_cptr kp,int j){ kf[2*j]=*(const __attribute__((address_space(3))) bf16x8*)(kp+j*2048); kf[2*j+1]=*(const __attribute__((address_space(3))) bf16x8*)(kp+j*2048+512); }
__device__ __forceinline__ s16x4 vtr(lds_cptr p){ return __builtin_bit_cast(s16x4,__builtin_amdgcn_ds_read_tr16_b64_v4i16((__attribute__((address_space(3))) v4i16_t*)p)); }
__device__ __forceinline__ float rowmax(const f32x16&p0,const f32x16&p1){
  float a=max3f(p0[0],p0[1],p1[0]),b=max3f(p0[2],p0[3],p1[1]);a=max3f(a,p1[2],p1[3]);
  #pragma unroll
  for(int r=4;r<16;r+=4){a=max3f(a,p0[r],p0[r+1]);b=max3f(b,p0[r+2],p0[r+3]);a=max3f(a,p1[r],p1[r+1]);b=max3f(b,p1[r+2],p1[r+3]);}
  const float m=max2f(a,b);
  auto rr=__builtin_amdgcn_permlane32_swap(__float_as_uint(m),__float_as_uint(m),false,false);
  return max2f(__uint_as_float(rr[0]),__uint_as_float(rr[1]));
}
__device__ __forceinline__ void pv(f32x16*o,int vb,bf16x8 pa0,bf16x8 pa1,bf16x8 pa2,bf16x8 pa3){
  #pragma unroll
  for(int d0=0;d0<2;++d0){s16x4 lo[4],hi[4];
    #pragma unroll
    for(int ks=0;ks<4;++ks){
      asm volatile("ds_read_b64_tr_b16 %0,%1 offset:%c2":"=&v"(lo[ks]):"v"(vb),"i"(d0*4096+ks*1024):"memory");
      asm volatile("ds_read_b64_tr_b16 %0,%1 offset:%c2":"=&v"(hi[ks]):"v"(vb),"i"(d0*4096+ks*1024+512):"memory");}
    asm volatile("s_waitcnt lgkmcnt(0)":::"memory");SBAR();
    #define PK(k) (bf16x8){lo[k][0],lo[k][1],lo[k][2],lo[k][3],hi[k][0],hi[k][1],hi[k][2],hi[k][3]}
    o[d0]=__builtin_amdgcn_mfma_f32_32x32x16_bf16(pa0,PK(0),o[d0],0,0,0);
    o[d0]=__builtin_amdgcn_mfma_f32_32x32x16_bf16(pa1,PK(1),o[d0],0,0,0);
    o[d0]=__builtin_amdgcn_mfma_f32_32x32x16_bf16(pa2,PK(2),o[d0],0,0,0);
    o[d0]=__builtin_amdgcn_mfma_f32_32x32x16_bf16(pa3,PK(3),o[d0],0,0,0);
    #undef PK
  }
}

template<int MODE,int THRL> __device__ __forceinline__ void attn_unit(int b,int h,int qb,const bf16*Q,const bf16*__restrict__ K,const bf16*__restrict__ V,unsigned char*O8,const void*aux,char*shm,const int tid_in){
  int tidl_=tid_in; asm volatile("":"+v"(tidl_));
  const int tid=tidl_,lane=tid&63,r32=lane&31,hi=lane>>5; const int wid=__builtin_amdgcn_readfirstlane(tid>>6);
  const long rowbase=(long)b*SEQ; const int q0=qb*QB;
  const bf16*Qw=Q+(rowbase+q0+wid*QBLK)*DM+h*D;
  const bf16*Kh=K+rowbase*DM+h*D,*Vh=V+rowbase*DM+h*D;
  const unsigned lds0=(unsigned)(uintptr_t)shm;
  float*wsf=(float*)(shm+LDS_WS)+wid*64;
  const bf16*ksrc=Kh+(long)lane*DM+wid*8;
  const bf16*vsrc=Vh+(long)(16*(wid&3)+(lane>>2))*DM+(wid>>2)*32+(lane&3)*8;
  const unsigned kdst=lds0+LDS_K+wid*1024, vdst=lds0+LDS_V+wid*1024;
  #define DMA_K(t,slot) glds16(ksrc+(long)(t)*KVBLK*DM,(unsigned)__builtin_amdgcn_readfirstlane(kdst+(slot)))
  #define DMA_V(t,slot) glds16(vsrc+(long)(t)*KVBLK*DM,(unsigned)__builtin_amdgcn_readfirstlane(vdst+(slot)))
  const int vb0=(int)(lds0+LDS_V)+((lane>>4)&1)*32+(lane&3)*8+(4*hi+((lane&15)>>2))*64;
  const char*Kbase=shm+LDS_K; bf16x8 kf[8];
  const lds_cptr shm3=(lds_cptr)shm; const lds_cptr kp0=shm3+LDS_K+hi*1024+r32*16; const lds_cptr vp0=shm3+LDS_V+((lane>>4)&1)*32+(lane&3)*8+(4*hi+((lane&15)>>2))*64;
  const int NT=(q0+QB)/KVBLK;
  unsigned selmask=0u;
  if(MODE==0){ float*km=(float*)(shm+LDS_KM); const float*kmg=(const float*)aux+(size_t)(b*NHEAD+h)*16*64;
    for(int i=tid;i<16*64;i+=NW*64)km[i]=kmg[i];
    bf16x8 qg[4];
    _Pragma("unroll") for(int d0=0;d0<4;++d0)qg[d0]=*reinterpret_cast<const bf16x8*>(&Qw[(long)r32*DM+d0*16+hi*8]);
    asm volatile("s_waitcnt vmcnt(0) lgkmcnt(0)":::"memory"); __syncthreads();
    float g[15];
    _Pragma("unroll") for(int j=0;j<15;++j){ g[j]=-INFINITY;
      if(j<qb){ float sg=0.f;
        _Pragma("unroll") for(int d0=0;d0<4;++d0) _Pragma("unroll") for(int e=0;e<8;++e) sg+=__uint_as_float(((unsigned)(unsigned short)qg[d0][e])<<16)*km[j*64+d0*16+hi*8+e];
        auto rr=__builtin_amdgcn_permlane32_swap(__float_as_uint(sg),__float_as_uint(sg),false,false); g[j]=__uint_as_float(rr[0])+__uint_as_float(rr[1]); } SBAR(); }
    _Pragma("unroll") for(int k=0;k<3;++k){ float best=-INFINITY; int bi=-1;
      _Pragma("unroll") for(int j=0;j<15;++j) if(j<qb && !((selmask>>j)&1u) && g[j]>best){best=g[j];bi=j;}
      if(bi>=0)selmask|=1u<<bi; }
    asm volatile("":"+v"(selmask)); SBAR(); }
  DMA_K(0,0);DMA_V(0,0);DMA_K(1,SLOTB);
  bf16x8 qr[4];
  #pragma unroll
  for(int d0=0;d0<4;++d0)qr[d0]=*reinterpret_cast<const bf16x8*>(&Qw[(long)r32*DM+d0*16+hi*8]);
  const unsigned*mrow=nullptr; u32x2 mwc=(u32x2){0u,0u}, mwn=(u32x2){0u,0u};
  if(MODE==1){ mrow=(const unsigned*)aux+(size_t)(rowbase+q0+wid*QBLK+r32)*128; mwc=*(const u32x2*)(mrow); mwn=*(const u32x2*)(mrow+2); }
  float z0_=0.f; asm volatile("":"+v"(z0_));
  float mhat=0.f,l_reg=0.f;f32x16 o[2];f32x16 negm;
  _Pragma("unroll") for(int r=0;r<16;++r){o[0][r]=z0_;o[1][r]=z0_;negm[r]=z0_;} asm volatile("":"+v"(negm));
  const int qrel=wid*QBLK+r32;
  #define DSAMASK(P0,P1,W) do{ const int w0_=(int)((W).x>>(4*hi)), w1_=(int)((W).y>>(4*hi)); \
    _Pragma("unroll") for(int r=0;r<16;++r){ const int bit_=(r&3)+8*(r>>2); const unsigned m0_=(unsigned)((w0_<<(31-bit_))>>31), m1_=(unsigned)((w1_<<(31-bit_))>>31); \
      P0[r]=__uint_as_float((__float_as_uint(P0[r])&m0_)|(0xff800000u&~m0_)); P1[r]=__uint_as_float((__float_as_uint(P1[r])&m1_)|(0xff800000u&~m1_)); } }while(0)
  #define CMASK(P0,P1,t) do{ if(MODE==0){ int jb_=(t)-(NT-4); if(jb_>=0)cmask(P0,P1,jb_,qrel,hi); \
      else if(!((selmask>>((t)>>2))&1u)){ _Pragma("unroll") for(int r=0;r<16;++r){P0[r]=-INFINITY;P1[r]=-INFINITY;} } } \
    else { DSAMASK(P0,P1,mwc); } }while(0)
  bool resc=false;
  #define START(P0,P1) do{ const float rm=rowmax(P0,P1); resc=false; \
    { const float dl=__builtin_fmaxf(rm,0.f); mhat=fadd_s(mhat,dl); \
      _Pragma("unroll") for(int r=0;r<16;++r){P0[r]=fsub_s(P0[r],dl);P1[r]=fsub_s(P1[r],dl);} \
      _Pragma("unroll") for(int r=0;r<16;++r)negm[r]=-mhat; asm volatile("":"+v"(negm)); } \
    _Pragma("unroll") for(int r=0;r<16;++r)P0[r]=__builtin_amdgcn_exp2f(P0[r]); }while(0)
  #define RESC() do{ if(resc){ asm volatile("s_waitcnt lgkmcnt(0)":::"memory"); \
      _Pragma("unroll") for(int d_=0;d_<2;++d_) _Pragma("unroll") for(int r=0;r<16;++r)o[d_][r]*=wsf[crow(r,hi)]; } }while(0)
  f32x16 pA0,pA1,pB0,pB1;
  int sl_prev=0,sl_cur=0,sl_next=SLOTB;
  #define ROT() do{sl_prev=sl_cur;sl_cur=sl_next;sl_next=(sl_next==(NSLOT-1)*SLOTB)?0:sl_next+SLOTB;}while(0)
  DMA_K(2,2*SLOTB);
  WAIT_BAR(3);
  qkt(pA0,pA1,Kbase,qr,negm,r32,hi);asm volatile("s_nop 15\n\ts_nop 7":"+v"(pA0),"+v"(pA1));CMASK(pA0,pA1,0);
  START(pA0,pA1);
  _Pragma("unroll") for(int r=0;r<16;++r)pA1[r]=__builtin_amdgcn_exp2f(pA1[r]);
  WAIT_BAR(0);
  DMA_K(3,0);DMA_V(1,SLOTB);
  ROT();
  if(MODE==1){mwc=mwn;}
  kload8(kf,kp0+sl_cur);
  WAIT_BAR(2);
  s16x4 vlo[8],vhi[8]; u32x4 pw0,pw1,pw2,pw3;
  #define PKW(P,B) cvtpk_s(P[B],P[B+1])
  #define PAF(k) __builtin_bit_cast(bf16x8,pw##k)
  #define VFR(i) (bf16x8){vlo[i][0],vlo[i][1],vlo[i][2],vlo[i][3],vhi[i][0],vhi[i][1],vhi[i][2],vhi[i][3]}
  #define PIN(x) asm volatile("":"+v"(x))
  #define MX3(a,b,c) __builtin_fmaxf(__builtin_fmaxf((a),(b)),(c))
  #define GAPA(MF,A0,A1,A2,A3,W0,W1,PW) do{ MF; sacc+=A0; sacc+=A1; sacc+=A2; sacc+=A3; PIN(sacc); W0; W1; PIN(PW); SBAR(); }while(0)
  #define EX(v) __builtin_amdgcn_exp2f(v)
  #define GAPB(MF,X,B) do{ MF; X[B]=EX(X[B]); X[B+1]=EX(X[B+1]); X[B+2]=EX(X[B+2]); X[B+3]=EX(X[B+3]); PIN(X); SBAR(); }while(0)
  #define VRD(i) do{ vlo[i]=vtr(vp_+(((i)>>2)*4096+((i)&3)*1024)); vhi[i]=vtr(vp_+(((i)>>2)*4096+((i)&3)*1024+512)); }while(0)
  #define KRD(G,j) do{ if(G){ kload2(kf,kp0+sl_next,j); SBAR(); } }while(0)
  #define MLOAD(tn) do{ if(MODE==1){ const unsigned*mp_=mrow+2*(tn); asm volatile("global_load_dwordx2 %0, %1, off":"=v"(mwn):"v"(mp_):"memory"); } }while(0)
  #define MROT() do{ if(MODE==1){ asm volatile("":"+v"(mwn)); mwc=mwn; } }while(0)
  #define STEP(C0,C1,P0,P1,t,GK,GV,GL) do{ SBAR(); \
    if((t)+1<NT){MLOAD((t)+1);} \
    const lds_cptr vp_=vp0+sl_prev; \
    VRD(0); SBAR(); float sacc=(P0[0]+P0[1]); \
    GAPA(C0=__builtin_amdgcn_mfma_f32_32x32x16_bf16(kf[0],qr[0],negm,0,0,0), P0[2],P0[3],P0[4],P0[5],     pw0[0]=PKW(P0,0), pw0[1]=PKW(P0,2), pw0); \
    VRD(4); SBAR(); GAPA(C1=__builtin_amdgcn_mfma_f32_32x32x16_bf16(kf[1],qr[0],negm,0,0,0), P0[6],P0[7],P0[8],P0[9],     pw0[2]=PKW(P0,4), pw0[3]=PKW(P0,6), pw0); \
    VRD(1); SBAR(); GAPA(C0=__builtin_amdgcn_mfma_f32_32x32x16_bf16(kf[2],qr[1],C0,0,0,0),   P0[10],P0[11],P0[12],P0[13], pw1[0]=PKW(P0,8), pw1[1]=PKW(P0,10), pw1); \
    VRD(5); SBAR(); GAPA(C1=__builtin_amdgcn_mfma_f32_32x32x16_bf16(kf[3],qr[1],C1,0,0,0),   P0[14],P0[15],P1[0],P1[1],   pw1[2]=PKW(P0,12),pw1[3]=PKW(P0,14), pw1); \
    VRD(2); SBAR(); GAPA(C0=__builtin_amdgcn_mfma_f32_32x32x16_bf16(kf[4],qr[2],C0,0,0,0),   P1[2],P1[3],P1[4],P1[5],     pw2[0]=PKW(P1,0), pw2[1]=PKW(P1,2), pw2); \
    VRD(6); SBAR(); GAPA(C1=__builtin_amdgcn_mfma_f32_32x32x16_bf16(kf[5],qr[2],C1,0,0,0),   P1[6],P1[7],P1[8],P1[9],     pw2[2]=PKW(P1,4), pw2[3]=PKW(P1,6), pw2); \
    VRD(3); SBAR(); GAPA(C0=__builtin_amdgcn_mfma_f32_32x32x16_bf16(kf[6],qr[3],C0,0,0,0),   P1[10],P1[11],P1[12],P1[13], pw3[0]=PKW(P1,8), pw3[1]=PKW(P1,10), pw3); \
    VRD(7); SBAR(); GAPA(C1=__builtin_amdgcn_mfma_f32_32x32x16_bf16(kf[7],qr[3],C1,0,0,0),   P1[14],P1[15],0.f,0.f,       pw3[2]=PKW(P1,12),pw3[3]=PKW(P1,14), pw3); \
    l_reg+=sacc; \
    if(GK){DMA_K((t)+3,sl_cur);} if(GV){DMA_V((t)+1,sl_next);} \
    CMASK(C0,C1,t); \
    { float a=MX3(C0[0],C0[1],C1[0]),b=MX3(C0[2],C0[3],C1[1]); a=MX3(a,C1[2],C1[3]); \
      _Pragma("unroll") for(int r=4;r<16;r+=4){a=MX3(a,C0[r],C0[r+1]);b=MX3(b,C0[r+2],C0[r+3]);a=MX3(a,C1[r],C1[r+1]);b=MX3(b,C1[r+2],C1[r+3]);} \
      float rm=__builtin_fmaxf(a,b); { auto rr=__builtin_amdgcn_permlane32_swap(__float_as_uint(rm),__float_as_uint(rm),false,false); rm=__builtin_fmaxf(__uint_as_float(rr[0]),__uint_as_float(rr[1])); } \
      resc=false; \
      if(__builtin_expect(__any(rm>(float)THRL),0)){ const float dl=__builtin_fmaxf(rm,0.f); mhat+=dl; \
        _Pragma("unroll") for(int r=0;r<16;++r){C0[r]-=dl;C1[r]-=dl;} \
        _Pragma("unroll") for(int r=0;r<16;++r)negm[r]=-mhat; asm volatile("":"+v"(negm)); \
        const float f=__builtin_amdgcn_exp2f(-dl); l_reg*=f; if(hi==0)wsf[r32]=f; resc=true; } } \
    SBAR(); \
    GAPB(o[0]=__builtin_amdgcn_mfma_f32_32x32x16_bf16(PAF(0),VFR(0),o[0],0,0,0), C0,0); \
    GAPB(o[1]=__builtin_amdgcn_mfma_f32_32x32x16_bf16(PAF(0),VFR(4),o[1],0,0,0), C0,4); \
    KRD(GL,0); GAPB(o[0]=__builtin_amdgcn_mfma_f32_32x32x16_bf16(PAF(1),VFR(1),o[0],0,0,0), C0,8); \
    KRD(GL,1); GAPB(o[1]=__builtin_amdgcn_mfma_f32_32x32x16_bf16(PAF(1),VFR(5),o[1],0,0,0), C0,12); \
    KRD(GL,2); GAPB(o[0]=__builtin_amdgcn_mfma_f32_32x32x16_bf16(PAF(2),VFR(2),o[0],0,0,0), C1,0); \
    KRD(GL,3); GAPB(o[1]=__builtin_amdgcn_mfma_f32_32x32x16_bf16(PAF(2),VFR(6),o[1],0,0,0), C1,4); \
    GAPB(o[0]=__builtin_amdgcn_mfma_f32_32x32x16_bf16(PAF(3),VFR(3),o[0],0,0,0), C1,8); \
    GAPB(o[1]=__builtin_amdgcn_mfma_f32_32x32x16_bf16(PAF(3),VFR(7),o[1],0,0,0), C1,12); \
    }while(0)
  int t=1;
  for(;t+5<NT;t+=2){
    STEP(pB0,pB1,pA0,pA1,t,true,true,true);     WAIT_BAR(2); MROT(); RESC(); ROT();
    STEP(pA0,pA1,pB0,pB1,t+1,true,true,true);   WAIT_BAR(2); MROT(); RESC(); ROT();
  }
  #define ENDW(tt) do{ if((tt)+3<NT){WAIT_BAR(2);} else if((tt)+2<NT){WAIT_BAR(1);} else {WAIT_BAR(0);} }while(0)
  for(;t+1<NT;t+=2){
    STEP(pB0,pB1,pA0,pA1,t,(t+3<NT),(t+1<NT),(t+1<NT));       ENDW(t);   MROT(); RESC(); ROT();
    STEP(pA0,pA1,pB0,pB1,t+1,(t+4<NT),(t+2<NT),(t+2<NT));     ENDW(t+1); MROT(); RESC(); ROT();
  }
  STEP(pB0,pB1,pA0,pA1,NT-1,false,false,false); RESC();
  { float sacc=pB0[0]+pB0[1]; _Pragma("unroll") for(int r=2;r<16;++r)sacc+=pB0[r]; _Pragma("unroll") for(int r=0;r<16;++r)sacc+=pB1[r]; l_reg+=sacc;
    pw0=(u32x4){PKW(pB0,0),PKW(pB0,2),PKW(pB0,4),PKW(pB0,6)};pw1=(u32x4){PKW(pB0,8),PKW(pB0,10),PKW(pB0,12),PKW(pB0,14)};pw2=(u32x4){PKW(pB1,0),PKW(pB1,2),PKW(pB1,4),PKW(pB1,6)};pw3=(u32x4){PKW(pB1,8),PKW(pB1,10),PKW(pB1,12),PKW(pB1,14)};
    SBAR(); pv(o,vb0+sl_cur,PAF(0),PAF(1),PAF(2),PAF(3)); }
  #undef PKW
  #undef PAF
  #undef VFR
  #undef PIN
  #undef MX3
  #undef GAPA
  #undef GAPB
  #undef EX
  #undef VRD
  #undef KRD
  #undef STEP
  #undef ENDW
  {auto rr=__builtin_amdgcn_permlane32_swap(__float_as_uint(l_reg),__float_as_uint(l_reg),false,false);l_reg=__uint_as_float(rr[0])+__uint_as_float(rr[1]);}
  if(hi==0)wsf[32+r32]=l_reg;asm volatile("s_waitcnt lgkmcnt(0)":::"memory");
  float rli[16];
  #pragma unroll
  for(int r=0;r<16;++r)rli[r]=__builtin_amdgcn_rcpf(wsf[32+crow(r,hi)]);
  unsigned char*Ow=O8+(rowbase+q0+wid*QBLK)*(2*DM)+h*D;
  { unsigned char*stg=(unsigned char*)(shm+LDS_OST)+wid*2048;
    #pragma unroll
    for(int r=0;r<16;++r){const int orow=crow(r,hi); const float sc16=rli[r]*16.0f; const int pk=__builtin_amdgcn_cvt_pk_fp8_f32(o[0][r]*sc16,o[1][r]*sc16,0,false);
      stg[orow*64+r32]=(unsigned char)(pk&0xff); stg[orow*64+32+r32]=(unsigned char)((pk>>8)&0xff);}
    asm volatile("s_waitcnt lgkmcnt(0)":::"memory");
    #pragma unroll
    for(int i=0;i<2;++i){const int row=i*16+(lane>>2),ch=lane&3; const u32x4 v=*(const u32x4*)(stg+row*64+ch*16); *(u32x4*)(Ow+(long)row*(2*DM)+ch*16)=v;} }
  asm volatile("s_waitcnt lgkmcnt(0)\n\ts_barrier":::"memory");
  #undef DMA_K
  #undef DMA_V
  #undef CMASK
  #undef START
  #undef RESC
  #undef ROT
  #undef MLOAD
  #undef MROT
  #undef DSAMASK
}
constexpr int ATTN_LDS_BYTES=LDS_BYTES;
#undef SBAR
#undef WAIT_BAR
}

namespace idx {
using bf16x8 = __attribute__((ext_vector_type(8))) short;
using f32x16 = __attribute__((ext_vector_type(16))) float;
using f32x4 = __attribute__((ext_vector_type(4))) float;
using u32x4 = __attribute__((ext_vector_type(4))) unsigned;
using u32x2 = __attribute__((ext_vector_type(2))) unsigned;
typedef unsigned short bf16r;
constexpr int SEQL = 4096, LCAP = 256, HSTRIDE = 1028;
constexpr int L_AF = 0, L_W = L_AF + 16384, L_M = L_W + 512, L_CT = L_M + 8192, L_LIST = L_CT + 512, L_HIST = L_LIST + 16 * LCAP * 8, LDS_BYTES = L_HIST + 16 * HSTRIDE * 4;
#define IDX_LAS __attribute__((address_space(3)))
__device__ __forceinline__ unsigned okey(float s) { const unsigned u = __float_as_uint(s); return u ^ ((unsigned)((int)u >> 31) | 0x80000000u); }
__device__ __forceinline__ float fkey(unsigned k) { return __uint_as_float(k ^ ((unsigned)((int)(~k) >> 31) | 0x80000000u)); }
__device__ __forceinline__ void glds16(const void* gsrc, unsigned lds_dst) { unsigned keep;
    asm volatile("s_mov_b32 %0, m0\n\ts_mov_b32 m0, %2\n\ts_nop 0\n\tglobal_load_lds_dwordx4 %1, off\n\ts_mov_b32 m0, %0" : "=&s"(keep) : "v"(gsrc), "s"(lds_dst) : "memory"); }
__device__ __forceinline__ float relu1(float x) { float r; asm("v_max_f32_e32 %0, 0, %1" : "=v"(r) : "v"(x)); return r; }
__device__ __forceinline__ void fmac1(float& acc, float a, float b) { asm("v_fmac_f32_e32 %0, %1, %2" : "+v"(acc) : "v"(a), "v"(b)); }
#define IDX_DPP(v, ctrl) __builtin_bit_cast(float, __builtin_amdgcn_update_dpp(0, __builtin_bit_cast(int, (v)), (ctrl), 0xF, 0xF, false))
__device__ __forceinline__ float half_max(float v) { v = __builtin_fmaxf(v, IDX_DPP(v, 0xB1)); v = __builtin_fmaxf(v, IDX_DPP(v, 0x4E)); v = __builtin_fmaxf(v, IDX_DPP(v, 0x141)); v = __builtin_fmaxf(v, IDX_DPP(v, 0x140));
    auto r = __builtin_amdgcn_permlane16_swap(__float_as_uint(v), __float_as_uint(v), false, false); return __builtin_fmaxf(__uint_as_float(r[0]), __uint_as_float(r[1])); }
__device__ __forceinline__ float half_min(float v) { v = __builtin_fminf(v, IDX_DPP(v, 0xB1)); v = __builtin_fminf(v, IDX_DPP(v, 0x4E)); v = __builtin_fminf(v, IDX_DPP(v, 0x141)); v = __builtin_fminf(v, IDX_DPP(v, 0x140));
    auto r = __builtin_amdgcn_permlane16_swap(__float_as_uint(v), __float_as_uint(v), false, false); return __builtin_fminf(__uint_as_float(r[0]), __uint_as_float(r[1])); }

__device__ __forceinline__ void scan_hist(IDX_LAS unsigned* hist, int q, unsigned need, int lane, unsigned& binL, unsigned& needL) {
    unsigned w[16];
#pragma unroll
    for (int i = 0; i < 4; ++i) { const u32x4 v = *(const IDX_LAS u32x4*)(hist + q * HSTRIDE + 16 * lane + 4 * i); w[4 * i] = v.x; w[4 * i + 1] = v.y; w[4 * i + 2] = v.z; w[4 * i + 3] = v.w; }
    unsigned tot = 0u;
#pragma unroll
    for (int i = 0; i < 16; ++i) tot += w[i];
    unsigned s = tot;
#pragma unroll
    for (int d = 1; d < 64; d <<= 1) { const unsigned t = __shfl_down(s, d); if (lane + d < 64) s += t; }
    const unsigned above = s - tot;
    const unsigned long long bal = __ballot(above < need && need <= above + tot);
    const int L = bal ? (int)__builtin_ctzll(bal) : 0;
    unsigned run = above, bsel = 0u, nsel = 1u; bool found = false;
#pragma unroll
    for (int i = 15; i >= 0; --i) { if (!found && run + w[i] >= need) { found = true; bsel = i; nsel = need - run; } run += w[i]; }
    binL = (unsigned)__shfl((int)bsel, L) + 16u * (unsigned)L; needL = (unsigned)__shfl((int)nsel, L);
}
__device__ __forceinline__ void zero_hist(IDX_LAS char* shm, int tid) { IDX_LAS u32x4* h4 = (IDX_LAS u32x4*)(shm + L_HIST);
#pragma unroll
    for (int i = 0; i < 9; ++i) if (tid + i * 512 < 16 * HSTRIDE / 4) h4[tid + i * 512] = (u32x4){0u, 0u, 0u, 0u}; }

__device__ __forceinline__ void unit(int b, int q0, const bf16r* IQ, const bf16r* IK, const float* IW, unsigned* MASK, char* shm_, const int tid_in, unsigned long long* dbg = nullptr) {
    int tid_ = tid_in; asm volatile("" : "+v"(tid_)); unsigned shm_u = (unsigned)(uintptr_t)shm_; asm volatile("" : "+s"(shm_u)); IDX_LAS char* const shm = (IDX_LAS char*)shm_u;
    const int tid = tid_, lane = tid & 63, j = lane & 31, hi = lane >> 5; const int wid = __builtin_amdgcn_readfirstlane(tid >> 6);
    const size_t rowbase = (size_t)b * SEQL;
    IDX_LAS unsigned* ct = (IDX_LAS unsigned*)(shm + L_CT);
    IDX_LAS unsigned* hist = (IDX_LAS unsigned*)(shm + L_HIST);
    const unsigned lds0 = shm_u;
    const int ntile = (q0 + 15) / 32 + 1;
    const int ni = (ntile > wid) ? (ntile - wid + 7) / 8 : 0;
    const bf16r* iksrc = IK + (rowbase + j) * 64 + 8 * hi;
    const unsigned ring = lds0 + L_HIST + (unsigned)wid * 8192u;
#define IDX_DMA(i_) do { const bf16r* s_ = iksrc + (size_t)(8 * (i_) + wid) * 32 * 64; const unsigned d_ = (unsigned)__builtin_amdgcn_readfirstlane(ring + (((i_) & 1) ? 4096u : 0u)); \
        glds16(s_, d_); glds16(s_ + 16, (unsigned)__builtin_amdgcn_readfirstlane(d_ + 1024u)); glds16(s_ + 32, (unsigned)__builtin_amdgcn_readfirstlane(d_ + 2048u)); glds16(s_ + 48, (unsigned)__builtin_amdgcn_readfirstlane(d_ + 3072u)); } while (0)
    if (ni > 0) IDX_DMA(0);
#pragma unroll
    for (int k = 0; k < 2; ++k) { const int f = wid + 8 * k, rb = f >> 2, s = f & 3; const int i = j;
        const int qi = ((i >> 4) & 1) + 2 * ((i >> 2) & 1), head = (i & 3) + 4 * ((i >> 3) & 1);
        const u32x4 v = *(const u32x4*)(IQ + (rowbase + q0 + 4 * rb + qi) * 512 + head * 64 + 16 * s + 8 * hi);
        *(IDX_LAS u32x4*)(shm + L_AF + f * 1024 + lane * 16) = v; }
    if (tid < 128) ((IDX_LAS float*)(shm + L_W))[tid] = IW[(rowbase + q0 + (tid >> 3)) * 8 + (tid & 7)];
    { IDX_LAS u32x4* m4 = (IDX_LAS u32x4*)(shm + L_M); m4[tid] = (u32x4){0u, 0u, 0u, 0u}; }
    if (tid < 128) ct[tid] = (tid >= 48 && tid < 64) ? 0xffffffffu : 0u;
    asm volatile("s_waitcnt vmcnt(0) lgkmcnt(0)" ::: "memory"); __syncthreads();
    unsigned long long t0_ = 0; if (dbg) t0_ = __builtin_amdgcn_s_memrealtime();
    f32x16 sc[8];
#pragma unroll
    for (int c = 0; c < 8; ++c)
#pragma unroll
        for (int i = 0; i < 16; ++i) sc[c][i] = -INFINITY;
    float fmx[8], fmn[8];
#pragma unroll
    for (int c = 0; c < 8; ++c) { fmx[c] = -INFINITY; fmn[c] = INFINITY; }
#pragma unroll 1
    for (int i = 0; i < ni; ++i) {
        const int kt = 8 * i + wid; const int key = 32 * kt + j;
        if (i + 1 < ni) { IDX_DMA(i + 1); asm volatile("s_waitcnt vmcnt(4)" ::: "memory"); } else asm volatile("s_waitcnt vmcnt(0)" ::: "memory");
        bf16x8 bfr4[4];
#pragma unroll
        for (int s = 0; s < 4; ++s) bfr4[s] = *(const IDX_LAS bf16x8*)(shm + L_HIST + wid * 8192 + (i & 1) * 4096 + s * 1024 + lane * 16);
#define IDX_AF(rb_, s_) (*(const IDX_LAS bf16x8*)(shm + L_AF + ((rb_) * 4 + (s_)) * 1024 + lane * 16))
#define IDX_RELU(x) __int_as_float(max(__float_as_int(x), 0))
        typedef float f32x2_ __attribute__((ext_vector_type(2)));
        f32x16 d = f32x16{};
        { bf16x8 a0 = IDX_AF(0, 0), a1 = IDX_AF(0, 1), a2 = IDX_AF(0, 2), a3 = IDX_AF(0, 3);
          d = __builtin_amdgcn_mfma_f32_32x32x16_bf16(a0, bfr4[0], d, 0, 0, 0); d = __builtin_amdgcn_mfma_f32_32x32x16_bf16(a1, bfr4[1], d, 0, 0, 0);
          d = __builtin_amdgcn_mfma_f32_32x32x16_bf16(a2, bfr4[2], d, 0, 0, 0); d = __builtin_amdgcn_mfma_f32_32x32x16_bf16(a3, bfr4[3], d, 0, 0, 0); }
        bf16x8 an = IDX_AF(1, 0);
        __builtin_amdgcn_sched_barrier(0);
#pragma unroll
        for (int rb = 0; rb < 4; ++rb) { f32x16 dn = f32x16{}; const int rn = (rb < 3) ? rb + 1 : 3;
            const IDX_LAS f32x4* wl = (const IDX_LAS f32x4*)(shm + L_W + (4 * rb + 2 * hi) * 32);
            f32x2_ pa = {0.f, 0.f}, pb = {0.f, 0.f};
            bf16x8 an1 = an; if (rb < 3) { an1 = IDX_AF(rn, 1); dn = __builtin_amdgcn_mfma_f32_32x32x16_bf16(an, bfr4[0], dn, 0, 0, 0); }
            { const f32x4 wa0 = wl[0], wb0 = wl[2];
              pa += (f32x2_){wa0[0], wa0[1]} * (f32x2_){IDX_RELU(d[0]), IDX_RELU(d[1])}; pa += (f32x2_){wa0[2], wa0[3]} * (f32x2_){IDX_RELU(d[2]), IDX_RELU(d[3])};
              pb += (f32x2_){wb0[0], wb0[1]} * (f32x2_){IDX_RELU(d[8]), IDX_RELU(d[9])}; pb += (f32x2_){wb0[2], wb0[3]} * (f32x2_){IDX_RELU(d[10]), IDX_RELU(d[11])}; }
            __builtin_amdgcn_sched_barrier(0);
            bf16x8 an2 = an; if (rb < 3) { an2 = IDX_AF(rn, 2); dn = __builtin_amdgcn_mfma_f32_32x32x16_bf16(an1, bfr4[1], dn, 0, 0, 0); }
            { const f32x4 wa1 = wl[1], wb1 = wl[3];
              pa += (f32x2_){wa1[0], wa1[1]} * (f32x2_){IDX_RELU(d[4]), IDX_RELU(d[5])}; pa += (f32x2_){wa1[2], wa1[3]} * (f32x2_){IDX_RELU(d[6]), IDX_RELU(d[7])};
              pb += (f32x2_){wb1[0], wb1[1]} * (f32x2_){IDX_RELU(d[12]), IDX_RELU(d[13])}; pb += (f32x2_){wb1[2], wb1[3]} * (f32x2_){IDX_RELU(d[14]), IDX_RELU(d[15])}; }
            __builtin_amdgcn_sched_barrier(0);
            bf16x8 an3 = an; if (rb < 3) { an3 = IDX_AF(rn, 3); dn = __builtin_amdgcn_mfma_f32_32x32x16_bf16(an2, bfr4[2], dn, 0, 0, 0); }
            float sa = pa[0] + pa[1], sb = pb[0] + pb[1];
            const int posa = q0 + 4 * rb + 2 * hi;
            const bool ina = key > posa, inb = key > posa + 1;
            asm volatile("v_min_f32 %0, %0, %2\n\tv_min_f32 %1, %1, %3" : "+v"(fmn[2 * rb]), "+v"(fmn[2 * rb + 1]) : "v"(sa), "v"(sb));
            if (ina) sa = -INFINITY; if (inb) sb = -INFINITY;
            __builtin_amdgcn_sched_barrier(0);
            if (rb < 3) { dn = __builtin_amdgcn_mfma_f32_32x32x16_bf16(an3, bfr4[3], dn, 0, 0, 0); if (rb < 2) an = IDX_AF(rn + 1, 0); }
            asm volatile("v_max_f32 %0, %0, %2\n\tv_max_f32 %1, %1, %3" : "+v"(fmx[2 * rb]), "+v"(fmx[2 * rb + 1]) : "v"(sa), "v"(sb));
            sc[2 * rb][i] = sa; sc[2 * rb + 1][i] = sb; __builtin_amdgcn_sched_barrier(0);
            d = dn; }
    }
#undef IDX_DMA
    if (dbg) { const unsigned long long t1_ = __builtin_amdgcn_s_memrealtime(); if (tid == 0) dbg[0] += t1_ - t0_; t0_ = t1_; }
#define TMARK(k) do { if (dbg) { const unsigned long long t1_ = __builtin_amdgcn_s_memrealtime(); if (tid == 0) dbg[k] += t1_ - t0_; t0_ = t1_; } } while (0)
    float tf[8]; int tix[8];
    if (q0 >= 256) {
        { unsigned umx[8], umn[8];
#pragma unroll
          for (int c = 0; c < 8; ++c) { umx[c] = (fmx[c] == -INFINITY) ? 0u : okey(fmx[c]); umn[c] = okey(fmn[c]);
#define IDX_DPPU(v, ctrl) ((unsigned)__builtin_amdgcn_update_dpp(0, (int)(v), (ctrl), 0xF, 0xF, false))
              umx[c] = max(umx[c], IDX_DPPU(umx[c], 0xB1)); umn[c] = min(umn[c], IDX_DPPU(umn[c], 0xB1)); umx[c] = max(umx[c], IDX_DPPU(umx[c], 0x4E)); umn[c] = min(umn[c], IDX_DPPU(umn[c], 0x4E));
              umx[c] = max(umx[c], IDX_DPPU(umx[c], 0x141)); umn[c] = min(umn[c], IDX_DPPU(umn[c], 0x141)); umx[c] = max(umx[c], IDX_DPPU(umx[c], 0x140)); umn[c] = min(umn[c], IDX_DPPU(umn[c], 0x140));
              { const auto r = __builtin_amdgcn_permlane16_swap(umx[c], umx[c], false, false); umx[c] = max((unsigned)r[0], (unsigned)r[1]); }
              { const auto r = __builtin_amdgcn_permlane16_swap(umn[c], umn[c], false, false); umn[c] = min((unsigned)r[0], (unsigned)r[1]); } }
          asm volatile("s_waitcnt lgkmcnt(0)" ::: "memory"); __syncthreads();
          if (j == 0) {
#pragma unroll
            for (int c = 0; c < 8; ++c) { const int q = 4 * (c >> 1) + 2 * hi + (c & 1);
                if (umx[c] != 0u) { (void)__hip_atomic_fetch_max(&ct[32 + q], umx[c], __ATOMIC_RELAXED, __HIP_MEMORY_SCOPE_WORKGROUP); (void)__hip_atomic_fetch_min(&ct[48 + q], umn[c], __ATOMIC_RELAXED, __HIP_MEMORY_SCOPE_WORKGROUP); } } } }
        TMARK(3);
        if (tid < 16) ct[16 + tid] = 256u;
        IDX_LAS u32x2* list = (IDX_LAS u32x2*)(shm + L_LIST);
        auto round_body = [&](const int round) __attribute__((always_inline)) {
            zero_hist(shm, tid);
            if (tid < 16) { ct[64 + tid] = 0u; ct[96 + tid] = ct[112 + tid]; }
            asm volatile("s_waitcnt lgkmcnt(0)" ::: "memory"); __syncthreads();
            float lo[8], scl[8];
#pragma unroll
            for (int c = 0; c < 8; ++c) { const int q = 4 * (c >> 1) + 2 * hi + (c & 1); const float h_ = fkey(ct[32 + q]); lo[c] = fkey(ct[48 + q]); const float d_ = h_ - lo[c]; scl[c] = (d_ > 0.f) ? 1023.0f / d_ : 0.f; }
#pragma unroll 1
            for (int i = 0; i < ni; ++i) {
#pragma unroll
                for (int c = 0; c < 8; ++c) { const float s = sc[c][i]; const int q = 4 * (c >> 1) + 2 * hi + (c & 1);
                    const unsigned bin = min((unsigned)((s - lo[c]) * scl[c]), 1024u);
                    (void)__hip_atomic_fetch_add(&hist[q * HSTRIDE + bin], 1u, __ATOMIC_RELAXED, __HIP_MEMORY_SCOPE_WORKGROUP); } __builtin_amdgcn_sched_barrier(0); }
            asm volatile("s_waitcnt lgkmcnt(0)" ::: "memory"); __syncthreads(); TMARK(4);
#pragma unroll 1
            for (int qq = 0; qq < 2; ++qq) { const int q = 2 * wid + qq; if (ct[96 + q] == 0u) { unsigned binL, needL; scan_hist(hist, q, ct[16 + q], lane, binL, needL); if (lane == 0) { ct[q] = binL; ct[16 + q] = needL; ct[32 + q] = 0u; ct[48 + q] = 0xffffffffu; } } }
            asm volatile("s_waitcnt lgkmcnt(0)" ::: "memory"); __syncthreads(); TMARK(5);
            unsigned b1[8];
#pragma unroll
            for (int c = 0; c < 8; ++c) { const int q = 4 * (c >> 1) + 2 * hi + (c & 1); b1[c] = (ct[96 + q] == 0u) ? ct[q] : 0xffffffffu; }
#pragma unroll 1
            for (int i = 0; i < ni; ++i) { const int kidx = 32 * (8 * i + wid) + j;
                bool pc[8]; bool anyc = false;
#pragma unroll
                for (int c = 0; c < 8; ++c) { const float s = sc[c][i]; const unsigned bin = min((unsigned)((s - lo[c]) * scl[c]), 1024u); pc[c] = (bin == b1[c]) && (s >= lo[c]); anyc = anyc || pc[c]; }
                if (__any(anyc)) {
#pragma unroll
                    for (int c = 0; c < 8; ++c) { const int q = 4 * (c >> 1) + 2 * hi + (c & 1);
                        if (pc[c]) { const unsigned k = okey(sc[c][i]); const unsigned pos = __hip_atomic_fetch_add(&ct[64 + q], 1u, __ATOMIC_RELAXED, __HIP_MEMORY_SCOPE_WORKGROUP);
                            (void)__hip_atomic_fetch_max(&ct[32 + q], k, __ATOMIC_RELAXED, __HIP_MEMORY_SCOPE_WORKGROUP); (void)__hip_atomic_fetch_min(&ct[48 + q], k, __ATOMIC_RELAXED, __HIP_MEMORY_SCOPE_WORKGROUP);
                            if (pos < (unsigned)LCAP) list[q * LCAP + pos] = (u32x2){k, (unsigned)kidx}; } } } }
            asm volatile("s_waitcnt lgkmcnt(0)" ::: "memory"); __syncthreads(); TMARK(6);
#pragma unroll 1
            for (int qq = 0; qq < 2; ++qq) { const int q = 2 * wid + qq; if (ct[96 + q] != 0u) continue;
                const int n = (int)ct[64 + q]; const unsigned need = ct[16 + q];
                if (n > LCAP) { if (ct[32 + q] == ct[48 + q] || round == 5) { if (lane == 0) { ct[q] = ct[48 + q]; ct[80 + q] = 0x7fffffffu; ct[112 + q] = 1u; } }
                    continue; }
                unsigned mk[4], mi[4], cg[4], ce[4];
#pragma unroll
                for (int m = 0; m < 4; ++m) { const int e = lane + 64 * m; const u32x2 v = (e < n) ? list[q * LCAP + e] : (u32x2){0u, 0u}; mk[m] = v.x; mi[m] = v.y; cg[m] = 0u; ce[m] = 0u; }
                for (int e = 0; e < n; ++e) { const u32x2 x = list[q * LCAP + e];
#pragma unroll
                    for (int m = 0; m < 4; ++m) { cg[m] += (x.x > mk[m]) ? 1u : 0u; ce[m] += (x.x == mk[m] && x.y < mi[m]) ? 1u : 0u; } }
                unsigned tmin = 0xffffffffu;
#pragma unroll
                for (int m = 0; m < 4; ++m) { const bool sel = (lane + 64 * m < n) && (cg[m] + ce[m] < need); if (sel) tmin = min(tmin, mk[m]); }
#pragma unroll
                for (int d = 1; d < 64; d <<= 1) tmin = min(tmin, (unsigned)__shfl_xor((int)tmin, d));
                unsigned imax = 0u; bool cut = false;
#pragma unroll
                for (int m = 0; m < 4; ++m) { const bool eq = (lane + 64 * m < n) && mk[m] == tmin; const bool sel = eq && (cg[m] + ce[m] < need); if (sel) imax = max(imax, mi[m]); cut = cut || (eq && !sel); }
#pragma unroll
                for (int d = 1; d < 64; d <<= 1) imax = max(imax, (unsigned)__shfl_xor((int)imax, d));
                if (!__any(cut)) imax = 0x7fffffffu;
                if (lane == 0) { ct[q] = tmin; ct[80 + q] = imax; ct[112 + q] = 1u; } }
            asm volatile("s_waitcnt lgkmcnt(0)" ::: "memory"); __syncthreads(); TMARK(7);
        };
        round_body(0);
        { bool alldone = true;
#pragma unroll
          for (int q = 0; q < 16; ++q) alldone = alldone && (ct[112 + q] != 0u);
          if (!alldone) round_body(5); }
#pragma unroll
        for (int c = 0; c < 8; ++c) { const int q = 4 * (c >> 1) + 2 * hi + (c & 1); tf[c] = fkey(ct[q]); tix[c] = (int)ct[80 + q]; }
    } else {
#pragma unroll
        for (int c = 0; c < 8; ++c) { tf[c] = -3.0e38f; tix[c] = 0x7fffffff; }
        asm volatile("s_waitcnt lgkmcnt(0)" ::: "memory"); __syncthreads();
    }
    if (dbg) { const unsigned long long t1_ = __builtin_amdgcn_s_memrealtime(); if (tid == 0) dbg[1] += t1_ - t0_; t0_ = t1_; }
    IDX_LAS unsigned* M = (IDX_LAS unsigned*)(shm + L_M);
    bool ties = false;
#pragma unroll
    for (int c = 0; c < 8; ++c) ties = ties || (tix[c] != 0x7fffffff);
    if (!__any(ties)) {
#pragma unroll 1
        for (int i = 0; i < ni; ++i) { const int kt = 8 * i + wid;
#pragma unroll
            for (int c = 0; c < 8; ++c) { const unsigned long long bal = __ballot(sc[c][i] >= tf[c]); const unsigned word = hi ? (unsigned)(bal >> 32) : (unsigned)bal;
                M[(4 * (c >> 1) + 2 * hi + (c & 1)) * 128 + kt] = word; } }
    } else {
#pragma unroll 1
        for (int i = 0; i < ni; ++i) { const int kt = 8 * i + wid; const int kidx = 32 * kt + j;
#pragma unroll
            for (int c = 0; c < 8; ++c) { const float s = sc[c][i]; const bool on = (s > tf[c]) || (s == tf[c] && kidx <= tix[c]);
                const unsigned long long bal = __ballot(on); const unsigned word = hi ? (unsigned)(bal >> 32) : (unsigned)bal;
                M[(4 * (c >> 1) + 2 * hi + (c & 1)) * 128 + kt] = word; } }
    }
    asm volatile("s_waitcnt lgkmcnt(0)" ::: "memory"); __syncthreads();
    { const u32x4 v = ((const IDX_LAS u32x4*)M)[tid]; *(u32x4*)(MASK + (rowbase + q0) * 128 + tid * 4) = v; }
    asm volatile("s_waitcnt lgkmcnt(0)" ::: "memory"); __syncthreads();
    if (dbg) { const unsigned long long t1_ = __builtin_amdgcn_s_memrealtime(); if (tid == 0) dbg[2] += t1_ - t0_; }
}
}

constexpr int NWAVES = 8;
constexpr int N_LAUNCHES = MK_N_LAUNCHES;
enum Phase { PH_PRO = 0, PH_ZG, PH_IDX, PH_ATT, PH_BR, PH_WO, PH_RT, PH_GU, PH_DN, PH_CMB, PH_PG, PH_FIN, PH_COUNT };
using pg8::BATCH; using pg8::SEQ; using pg8::DMODEL; using pg8::TOK; using pg8::AW; using pg8::ZN; using pg8::IN_COLS; using pg8::NEXP; using pg8::DEXP; using pg8::PLE; using pg8::RMS_EPS;

constexpr size_t MiB = 1u << 20;
constexpr size_t WS_CTL = 0, CTL_ZERO_BYTES = 2 * MiB;
constexpr size_t WS_KMEAN = 1 * MiB;
constexpr size_t WS_ROPEC = 2 * MiB, WS_ROPES = 2 * MiB + 128 * 1024;
constexpr size_t WS_RSTD = 2 * MiB + 256 * 1024;
constexpr size_t WS_LTOK = 3 * MiB, WS_LW = 7 * MiB;
constexpr size_t WS_WIN = 11 * MiB, WS_WIN8 = 17 * MiB;
constexpr size_t WS_H8 = 470 * MiB;
constexpr size_t WS_BRA = 23 * MiB, WS_BRB = 24 * MiB, WS_WOUT = 25 * MiB, WS_WPG = 27 * MiB, WS_WPP = 29 * MiB;
constexpr size_t WS_PB = 30 * MiB;
constexpr size_t WS_A = 46 * MiB;
constexpr size_t WS_B = 110 * MiB;
constexpr size_t WS_QA = WS_B, WS_KA = WS_B + 32 * MiB, WS_VA = WS_B + 64 * MiB, WS_QB = WS_B + 96 * MiB, WS_KB = WS_B + 128 * MiB, WS_VB = WS_B + 160 * MiB;
constexpr size_t WS_IQ = WS_B + 192 * MiB, WS_IK = WS_B + 224 * MiB, WS_IW = WS_B + 228 * MiB;
constexpr size_t WS_OAB8 = WS_IQ;
constexpr size_t WS_MRG = WS_KA;
constexpr size_t WS_HID = WS_B, WS_Y = WS_B + 72 * MiB;
constexpr size_t WS_P = 342 * MiB + 64 * MiB;
constexpr size_t WS_X1B = WS_B + 140 * MiB;
constexpr size_t WS_C = 342 * MiB;
constexpr size_t WS_GA = WS_C, WS_GB = WS_C + 64 * MiB;
constexpr size_t WS_WGU = WS_C, WS_WDN = WS_C + 32 * MiB;
constexpr size_t WS_MASK = 470 * MiB;
constexpr size_t WS_ST = 486 * MiB;
constexpr size_t WS_END = 502 * MiB;
constexpr int CW_BAR = 4096;
constexpr int CW_CNT = 16384;
constexpr int CW_HID = 40960;
constexpr int CW_IDXQ = 51200;
constexpr int CW_FIN = 32768;
constexpr int RING_OFF = 0, RING_BYTES = 131072;
constexpr int TBL_OFF = RING_BYTES, TBL_BYTES = 28672;
constexpr int LDSCTL_OFF = TBL_OFF + TBL_BYTES, MISC_OFF = LDSCTL_OFF + 320;
constexpr int LDS_BYTES = 163840;
static_assert(MISC_OFF + 128 <= LDS_BYTES, "LDS map");

#define GAS __attribute__((address_space(1)))
#define LAS __attribute__((address_space(3)))
typedef unsigned short bf16;
typedef unsigned v4u __attribute__((ext_vector_type(4)));
typedef float f32x4 __attribute__((ext_vector_type(4)));
typedef short bf16x8 __attribute__((ext_vector_type(8)));
typedef GAS unsigned gu32;
typedef GAS unsigned long long gu64;
#define RLX_AGENT __ATOMIC_RELAXED, __HIP_MEMORY_SCOPE_AGENT
#define LDS_WAIT() asm volatile("s_waitcnt lgkmcnt(0)" ::: "memory")
#define VM_WAIT() asm volatile("s_waitcnt vmcnt(0)" ::: "memory")
__device__ __forceinline__ unsigned long long rt() { return __builtin_amdgcn_s_memrealtime(); }
__device__ __forceinline__ unsigned f2bf(float f) { unsigned u = __builtin_bit_cast(unsigned, f); return (u + 0x7fffu + ((u >> 16) & 1u)) >> 16; }
__device__ __forceinline__ unsigned pk2(float lo, float hi) { return f2bf(lo) | (f2bf(hi) << 16); }

#define XB_TMO      128
#define XB_XCNT(j)  (256  + 64 * (j))
#define XB_XSUB(j)  (1280 + 64 * (j))
#define XB_XGEN(j)  (2304 + 64 * (j))
#define XB_TOP      3328
#define XB_TOPGEN   3392
#define XCD_BAR_WORDS 3456
#define XB_SPIN_CAP (1u << 18)

__device__ __forceinline__ unsigned xb_ld(unsigned* p)              { return __hip_atomic_load(p, __ATOMIC_RELAXED, __HIP_MEMORY_SCOPE_AGENT); }
__device__ __forceinline__ unsigned xb_add(unsigned* p, unsigned v) { return __hip_atomic_fetch_add(p, v, __ATOMIC_RELAXED, __HIP_MEMORY_SCOPE_AGENT); }
__device__ __forceinline__ unsigned xb_xcc_id() { return (unsigned)__builtin_amdgcn_s_getreg((3 << 11) | 20) & 0xFu; }
#define XB_SPIN(cond, bar) do { unsigned _sp = 0; while (cond) { __builtin_amdgcn_s_sleep(1); \
    if ((++_sp & 255u) == 0u) { if (xb_ld(&(bar)[XB_TMO])) break; if (_sp > XB_SPIN_CAP) { atomicAdd(&(bar)[XB_TMO], 1u); break; } } } } while (0)

struct XcdBarrier {
    unsigned* bar; unsigned x;
    volatile LAS unsigned* st;
};

__device__ __forceinline__ XcdBarrier xcd_barrier_post(unsigned* bar, volatile LAS unsigned* st, int xb_tid) {
    XcdBarrier b; b.bar = bar; b.x = xb_xcc_id(); b.st = st;
    if (xb_tid == 0) (void)xb_add(&bar[XB_XCNT(b.x)], 1u);
    return b;
}
__device__ __forceinline__ void xcd_barrier_complete(unsigned* bar, unsigned x, unsigned& nloc, unsigned& nx) {
    const unsigned G = gridDim.x * gridDim.y * gridDim.z;
    unsigned sum, cnt, mine, sp = 0u;
    for (;;) {
        sum = 0u; cnt = 0u; mine = 0u;
#pragma unroll
        for (unsigned j = 0; j < 16; ++j) { const unsigned c = xb_ld(&bar[XB_XCNT(j)]); sum += c; cnt += (c > 0u) ? 1u : 0u; mine = (j == x) ? c : mine; }
        if (sum == G) break;
        __builtin_amdgcn_s_sleep(1);
        if ((++sp & 255u) == 0u) { if (xb_ld(&bar[XB_TMO])) break; if (sp > XB_SPIN_CAP) { atomicAdd(&bar[XB_TMO], 1u); break; } }
    }
    nloc = mine > 0u ? mine : 1u; nx = cnt > 0u ? cnt : 1u;
}

__device__ __forceinline__ void xcd_barrier(const XcdBarrier& b, int xb_tid) {
    asm volatile("s_waitcnt vmcnt(0)" ::: "memory");
    __syncthreads();
    if (xb_tid == 0) {
        unsigned* bar = b.bar;
        __builtin_amdgcn_s_waitcnt(0);
        unsigned nloc = b.st[0], nx = b.st[1];
        if (nloc == 0u) { xcd_barrier_complete(bar, b.x, nloc, nx); b.st[0] = nloc; b.st[1] = nx; }
        const unsigned old = xb_add(&bar[XB_XSUB(b.x)], 1u);
        const unsigned gen = old / nloc;
        if (old + 1u == (gen + 1u) * nloc) {
            __builtin_amdgcn_fence(__ATOMIC_RELEASE, "agent");
            asm volatile("s_waitcnt vmcnt(0)" ::: "memory");
            const unsigned og = xb_add(&bar[XB_TOP], 1u);
            const unsigned tg = og / nx;
            if (og + 1u == (tg + 1u) * nx) xb_add(&bar[XB_TOPGEN], 1u);
            else XB_SPIN(xb_ld(&bar[XB_TOPGEN]) == tg, bar);
            __builtin_amdgcn_fence(__ATOMIC_ACQUIRE, "agent");
            xb_add(&bar[XB_XGEN(b.x)], 1u);
            asm volatile("s_waitcnt vmcnt(0)" ::: "memory");
        } else {
            XB_SPIN(xb_ld(&bar[XB_XGEN(b.x)]) == gen, bar);
            __builtin_amdgcn_fence(__ATOMIC_ACQUIRE, "agent");
            asm volatile("s_waitcnt vmcnt(0)" ::: "memory");
        }
    }
    __syncthreads();
}

struct Frame {
    LAS unsigned char* lds;
    volatile LAS unsigned* MISC;
    gu32* ctl;
    int tid, lane, wave;
    int vcu, G;
};
__device__ __forceinline__ float dpp_f(float v, const int ctrl) { return v; }
#define DPP_ADD(v, ctrl) ((v) + __builtin_bit_cast(float, __builtin_amdgcn_update_dpp(0, __builtin_bit_cast(int, (v)), (ctrl), 0xF, 0xF, false)))
__device__ __forceinline__ float wave_sum(float v) {
    v = DPP_ADD(v, 0xB1);
    v = DPP_ADD(v, 0x4E);
    v = DPP_ADD(v, 0x141);
    v = DPP_ADD(v, 0x140);
    { auto r = __builtin_amdgcn_permlane16_swap(__float_as_uint(v), __float_as_uint(v), false, false); v = __uint_as_float(r[0]) + __uint_as_float(r[1]); }
    { auto r = __builtin_amdgcn_permlane32_swap(__float_as_uint(v), __float_as_uint(v), false, false); v = __uint_as_float(r[0]) + __uint_as_float(r[1]); }
    return v;
}
template <class RowMap> __device__ __forceinline__ void transpose_item(const float* W, int K, int N, bf16* WT, const RowMap& RM, LAS float* scr, int item, int lane) {
    const int nblk = (N + 31) / 32, kb = item / nblk, nb = item % nblk, k0 = 64 * kb, n0 = 32 * nb;
    const int nsrc = n0 + (lane & 31); const bool okc = nsrc < N;
#pragma unroll 16
    for (int i = 0; i < 32; ++i) { const int kk = 2 * i + (lane >> 5); scr[kk * 33 + (lane & 31)] = okc ? W[(size_t)(k0 + kk) * N + nsrc] : 0.f; }
    LDS_WAIT(); asm volatile("" ::: "memory");
    const int c = lane & 7;
#pragma unroll
    for (int j = 0; j < 4; ++j) { const int n = (lane >> 3) + 8 * j; const LAS float* s = scr + (8 * c) * 33 + n;
        v4u o; o.x = pk2(s[0 * 33], s[1 * 33]); o.y = pk2(s[2 * 33], s[3 * 33]); o.z = pk2(s[4 * 33], s[5 * 33]); o.w = pk2(s[6 * 33], s[7 * 33]);
        const int drow = (n0 + n < N) ? RM(n0 + n) : -1;
        if (drow >= 0) *(GAS v4u*)(WT + (size_t)drow * K + k0 + 8 * c) = o; }
    LDS_WAIT(); asm volatile("" ::: "memory");
}
template <class RowMap> __device__ __forceinline__ void transpose_item8(const float* W, int K, int N, unsigned char* WT, const RowMap& RM, float sc, LAS float* scr, int item, int lane) {
    const int nblk = (N + 31) / 32, kb = item / nblk, nb = item % nblk, k0 = 64 * kb, n0 = 32 * nb;
    const int nsrc = n0 + (lane & 31); const bool okc = nsrc < N;
#pragma unroll 16
    for (int i = 0; i < 32; ++i) { const int kk = 2 * i + (lane >> 5); scr[kk * 33 + (lane & 31)] = okc ? W[(size_t)(k0 + kk) * N + nsrc] * sc : 0.f; }
    LDS_WAIT(); asm volatile("" ::: "memory");
    const int c = lane & 7;
#pragma unroll
    for (int j = 0; j < 4; ++j) { const int n = (lane >> 3) + 8 * j; const LAS float* s = scr + (8 * c) * 33 + n;
        const pg8::u32x2 o = pg8::pack8_fp8((f32x4){s[0 * 33], s[1 * 33], s[2 * 33], s[3 * 33]}, (f32x4){s[4 * 33], s[5 * 33], s[6 * 33], s[7 * 33]});
        const int drow = (n0 + n < N) ? RM(n0 + n) : -1;
        if (drow >= 0) *(GAS pg8::u32x2*)(WT + (size_t)drow * K + k0 + 8 * c) = o; }
    LDS_WAIT(); asm volatile("" ::: "memory");
}
template <class RowMap> __device__ __forceinline__ void transpose_item_split(const float* W, int K, int N, bf16* WT, unsigned char* WT8, const RowMap& RM, LAS float* scr, int item, int lane) {
    const int nblk = (N + 31) / 32, kb = item / nblk, nb = item % nblk, k0 = 64 * kb, n0 = 32 * nb;
    const int nsrc = n0 + (lane & 31); const bool okc = nsrc < N;
#pragma unroll 16
    for (int i = 0; i < 32; ++i) { const int kk = 2 * i + (lane >> 5); scr[kk * 33 + (lane & 31)] = okc ? W[(size_t)(k0 + kk) * N + nsrc] : 0.f; }
    LDS_WAIT(); asm volatile("" ::: "memory");
    const int c = lane & 7;
#pragma unroll
    for (int j = 0; j < 4; ++j) { const int n = (lane >> 3) + 8 * j; const LAS float* s = scr + (8 * c) * 33 + n;
        const int drow = (n0 + n < N) ? RM(n0 + n) : -1;
        if (drow >= 0) { v4u o; o.x = pk2(s[0 * 33], s[1 * 33]); o.y = pk2(s[2 * 33], s[3 * 33]); o.z = pk2(s[4 * 33], s[5 * 33]); o.w = pk2(s[6 * 33], s[7 * 33]); *(GAS v4u*)(WT + (size_t)drow * K + k0 + 8 * c) = o; }
        else if (drow <= -2) { const pg8::u32x2 o = pg8::pack8_fp8((f32x4){s[0 * 33] * 32.f, s[1 * 33] * 32.f, s[2 * 33] * 32.f, s[3 * 33] * 32.f}, (f32x4){s[4 * 33] * 32.f, s[5 * 33] * 32.f, s[6 * 33] * 32.f, s[7 * 33] * 32.f});
            *(GAS pg8::u32x2*)(WT8 + (size_t)(-2 - drow) * K + k0 + 8 * c) = o; } }
    LDS_WAIT(); asm volatile("" ::: "memory");
}
struct RmIdent { __device__ __forceinline__ int operator()(int n) const { return n; } };
struct RmWin { __device__ __forceinline__ int operator()(int n) const {
    if (n < 1024) return -2 - (n + 4096);
    if (n < 1536) return -2 - (n - 1024);
    if (n < 2560) return -2 - (n - 1536 + 3072);
    if (n < 3072) return -2 - (n - 2560 + 512);
    if (n < 3656) return n - 3072;
    { const int c = n - 3656, g = c >> 10, cc = c & 1023; return -2 - (1024 + 256 * (cc >> 7) + 128 * g + (cc & 127)); } } };
struct RmGate { int up; __device__ __forceinline__ int operator()(int n) const { return 256 * (n >> 7) + 128 * up + (n & 127); } };

__device__ __forceinline__ void conv_load(const float* W, int N, int nblk, int item, int lane, float (&t)[32]) {
    const int kb = item / nblk, nb = item - kb * nblk;
    int n = 32 * nb + (lane & 31); n = n < N ? n : N - 1;
    const GAS float* src = (const GAS float*)W + (size_t)(64 * kb + 32 * (lane >> 5)) * N + n;
#pragma unroll
    for (int i = 0; i < 32; ++i) t[i] = src[(size_t)i * N];
}
struct MoeItem { const float* W; int K, N, nblk, r, mode; unsigned char* d; };
__device__ __forceinline__ MoeItem moe_item(int it, const float* wg, const float* wu, const float* wd, unsigned char* Wgu, unsigned char* Wdn) {
    const int e = it / 768; int r = it - e * 768; MoeItem m;
    m.W = wg + (size_t)e * DMODEL * DEXP; m.K = DMODEL; m.N = DEXP; m.nblk = 16; m.mode = 0; m.d = Wgu + (size_t)e * DMODEL * DMODEL;
    if (r >= 256) { r -= 256; m.W = wu + (size_t)e * DMODEL * DEXP; m.mode = 1;
        if (r >= 256) { r -= 256; m.W = wd + (size_t)e * DEXP * DMODEL; m.K = DEXP; m.N = DMODEL; m.nblk = 32; m.mode = 2; m.d = Wdn + (size_t)e * DMODEL * DEXP; } }
    m.r = r; return m; }
struct RmMoe { int mode; __device__ __forceinline__ int operator()(int n) const { return mode == 2 ? n : 256 * (n >> 7) + 128 * mode + (n & 127); } };
template <int MODE, class RowMap> __device__ __forceinline__ void conv_store(int K, int N, int nblk, int item, int lane, unsigned char* d16, unsigned char* d8, const RowMap& RM, float sc, const float (&t)[32], int ldk = 0) {
    const int kb = item / nblk, nb = item - kb * nblk;
    const int n = 32 * nb + (lane & 31); const int kq = 64 * kb + 32 * (lane >> 5);
    if (n < N) { const int drow = RM(n);
        if (MODE == 1 || (MODE == 2 && drow < 0)) { const int row = (MODE == 1) ? drow : -2 - drow; const float q = (MODE == 1) ? sc : 32.f;
            unsigned w[8];
#pragma unroll
            for (int j = 0; j < 8; ++j) { int w_ = __builtin_amdgcn_cvt_pk_fp8_f32(t[4 * j] * q, t[4 * j + 1] * q, 0, false); w_ = __builtin_amdgcn_cvt_pk_fp8_f32(t[4 * j + 2] * q, t[4 * j + 3] * q, w_, true); w[j] = (unsigned)w_; }
            GAS v4u* o = (GAS v4u*)(d8 + (size_t)row * (ldk ? ldk : K) + kq); o[0] = (v4u){w[0], w[1], w[2], w[3]}; o[1] = (v4u){w[4], w[5], w[6], w[7]}; }
        else { unsigned w[16];
#pragma unroll
            for (int j = 0; j < 16; ++j) w[j] = pg8::cvt_pk_bf16(t[2 * j], t[2 * j + 1]);
            GAS v4u* o = (GAS v4u*)(d16 + ((size_t)drow * K + kq) * 2);
#pragma unroll
            for (int j = 0; j < 4; ++j) o[j] = (v4u){w[4 * j], w[4 * j + 1], w[4 * j + 2], w[4 * j + 3]}; } }
}

__device__ __forceinline__ void rms_row_to_bf16(const float* xrow, const float* g, bf16* orow, unsigned char* orow8, int lane) {
    const GAS f32x4* xr = (const GAS f32x4*)xrow + lane; const GAS f32x4* gr = (const GAS f32x4*)g + lane;
    f32x4 v[4]; float s = 0.f;
#pragma unroll
    for (int j = 0; j < 4; ++j) { v[j] = xr[64 * j]; s += (v[j].x * v[j].x + v[j].y * v[j].y) + (v[j].z * v[j].z + v[j].w * v[j].w); }
    const float rinv = 1.0f / sqrtf(wave_sum(s) * (1.f / DMODEL) + RMS_EPS);
    GAS unsigned long long* o8 = (GAS unsigned long long*)orow + lane;
    GAS unsigned* o4 = (GAS unsigned*)orow8 + lane;
#pragma unroll
    for (int j = 0; j < 4; ++j) { const f32x4 gg = gr[64 * j]; const f32x4 h = (f32x4){v[j].x * rinv * gg.x, v[j].y * rinv * gg.y, v[j].z * rinv * gg.z, v[j].w * rinv * gg.w};
        o8[64 * j] = (unsigned long long)pk2(h.x, h.y) | ((unsigned long long)pk2(h.z, h.w) << 32);
        int w_ = __builtin_amdgcn_cvt_pk_fp8_f32(h.x, h.y, 0, false); w_ = __builtin_amdgcn_cvt_pk_fp8_f32(h.z, h.w, w_, true); o4[64 * j] = (unsigned)w_; }
}

struct MoeTbl {
    static constexpr int RB0 = 0;
    static constexpr int UNITS = 256;
    static constexpr int ROWOFF = 512;
    static constexpr int ROWW = 512 + 8192;
};
struct MoeOrder {
    const LAS int* units; const LAS unsigned* rowoff; int n; size_t estride; unsigned* publish; unsigned* ready;
    __device__ __forceinline__ bool next(int i, pg8::Unit& u) const { if (i >= n) return false; u.pm = units[4 * i]; u.pn = units[4 * i + 1]; u.e = units[4 * i + 2]; u.valid = units[4 * i + 3]; u.boff = (size_t)u.e * estride; return true; }
    __device__ __forceinline__ void a_ready(const pg8::Unit& u, int wid, int lane) const {
        if (ready == nullptr) return;
        if (wid == 0) { unsigned sp = 0;
            while ((unsigned)__builtin_amdgcn_readfirstlane((int)__hip_atomic_load(ready + 16 * u.pm, __ATOMIC_RELAXED, __HIP_MEMORY_SCOPE_AGENT)) < 32u) { __builtin_amdgcn_s_sleep(2); if (++sp > (1u << 22)) break; }
            __builtin_amdgcn_fence(__ATOMIC_ACQUIRE, "agent"); asm volatile("s_waitcnt vmcnt(0)" ::: "memory"); }
        asm volatile("" ::: "memory"); __builtin_amdgcn_s_barrier(); asm volatile("" ::: "memory"); (void)lane; }
    __device__ __forceinline__ void done(const pg8::Unit& u, int, int lane) const {
        if (publish == nullptr) return;
        asm volatile("s_waitcnt vmcnt(0)" ::: "memory");
        if (lane == 0) (void)__hip_atomic_fetch_add(publish + 16 * u.pm, 1u, __ATOMIC_RELAXED, __HIP_MEMORY_SCOPE_AGENT); }
    __device__ __forceinline__ unsigned arow(int ui, int r) const { return rowoff[ui * 256 + r]; }
};
__device__ __forceinline__ int moe_build(Frame& F, const int* cnt_g, const int* ltok, const float* lw, int mode) {
    LAS int* rb0 = (LAS int*)(F.lds + TBL_OFF + MoeTbl::RB0); LAS int* units = (LAS int*)(F.lds + TBL_OFF + MoeTbl::UNITS);
    LAS unsigned* rowoff = (LAS unsigned*)(F.lds + TBL_OFF + MoeTbl::ROWOFF); LAS float* roww = (LAS float*)(F.lds + TBL_OFF + MoeTbl::ROWW);
    LAS int* cn = (LAS int*)(F.lds + TBL_OFF + MoeTbl::ROWW + 8192);
    if (F.tid < 32) cn[F.tid] = __hip_atomic_load(cnt_g + F.tid, __ATOMIC_RELAXED, __HIP_MEMORY_SCOPE_AGENT);
    LDS_WAIT(); __syncthreads();
    if (F.tid == 0) { int s = 0; for (int e = 0; e < 32; ++e) { rb0[e] = s; s += (cn[e] + 255) >> 8; } rb0[32] = s; }
    LDS_WAIT(); __syncthreads();
    const int NB = rb0[32]; int n = 0;
    const int U_ = 4 * NB, full_ = U_ / F.G, r_ = U_ - full_ * F.G;
    for (int i = 0; i < 8; ++i) { int L = i * F.G + (int)blockIdx.x;
        if (mode == 1 && i == full_) { const int j_ = ((int)blockIdx.x - r_ + F.G) % F.G; L = (j_ < r_) ? full_ * F.G + j_ : U_; }
        if (L >= U_) break; n = i + 1;
        const int rb = L >> 2, t = L & 3; int e = 0;
        for (int k = 1; k < 32; ++k) if (rb0[k] <= rb) e = k;
        const int jb = rb - rb0[e]; const int valid = min(256, cn[e] - 256 * jb);
        if (F.tid == 0) { units[4 * i] = rb; units[4 * i + 1] = t; units[4 * i + 2] = e; units[4 * i + 3] = valid; }
        if (F.tid < 256) { const int r = F.tid; const int src = e * 32768 + 256 * jb + (r < valid ? r : 0); const int tk = ltok[src];
            if (mode == 0) rowoff[i * 256 + r] = (unsigned)(tk >> 1) * (unsigned)DMODEL;
            else { rowoff[i * 256 + r] = (r < valid) ? (unsigned)tk : (unsigned)(2 * TOK); roww[i * 256 + r] = (r < valid) ? lw[src] : 0.f; } }
    }
    VM_WAIT(); LDS_WAIT(); __syncthreads();
    return n;
}

struct Args { const float* in[19]; float* out; unsigned char* ws; int ph_lo, ph_hi; };
typedef __attribute__((address_space(4))) const Args CArgs;
__device__ __forceinline__ CArgs* phase_args() { CArgs* p = (CArgs*)__builtin_amdgcn_kernarg_segment_ptr(); asm volatile("" : "+s"(p)); return p; }
__global__ void __launch_bounds__(NWAVES * 64, 2) fwd(Args args) {
    extern __shared__ __attribute__((aligned(16))) unsigned char lds[];
    Frame F0; Frame& F = F0;
    F.lds = (LAS unsigned char*)lds;
    F.MISC = (volatile LAS unsigned*)(F.lds + MISC_OFF);
    const int wv0 = __builtin_amdgcn_readfirstlane((int)threadIdx.x >> 6);
#define HW_TID() ([&]() { unsigned z_ = 0u; asm volatile("" : "+v"(z_)); return 64 * wv0 + (int)__builtin_amdgcn_mbcnt_hi(~0u, __builtin_amdgcn_mbcnt_lo(~0u, z_)); }())
    F.tid = HW_TID(); F.lane = F.tid & 63; F.wave = wv0;
    F.G = gridDim.x; { const int bx = blockIdx.x; F.vcu = (F.G % 8 == 0) ? (bx % 8) * (F.G / 8) + bx / 8 : bx; }
    F.ctl = (gu32*)(args.ws + WS_CTL);
    for (int u = F.tid; u < (LDS_BYTES - LDSCTL_OFF) / 4; u += NWAVES * 64) ((LAS unsigned*)(F.lds + LDSCTL_OFF))[u] = 0u;
    __syncthreads();
    if (N_LAUNCHES == 1) (void)xcd_barrier_post((unsigned*)(F.ctl + CW_BAR), F.MISC + 8, F.tid);
#define GRID_BAR() do { if (N_LAUNCHES == 1) { XcdBarrier b_; b_.bar = (unsigned*)(F.ctl + CW_BAR); b_.x = xb_xcc_id(); b_.st = F.MISC + 8; xcd_barrier(b_, F.tid); } } while (0)
#ifndef PROBE_BLK
#define PROBE_BLK 0
#endif
#if defined(PROBE_A)
    unsigned long long* const ts_ = (unsigned long long*)(args.ws + 2 * MiB + 512 * 1024);
    if (blockIdx.x == 0 && F.tid == 0) { for (int i_ = 24; i_ < 34; ++i_) ts_[i_] = 0; ts_[0] = __builtin_amdgcn_s_memrealtime(); }
#define STAMP(k) do { if (blockIdx.x == 0 && F.tid == 0) ts_[(k) + 1] = __builtin_amdgcn_s_memrealtime(); } while (0)
#else
#define STAMP(k) do { } while (0)
#endif
    const int lo = (N_LAUNCHES == 1) ? 0 : args.ph_lo, hi = (N_LAUNCHES == 1) ? (int)PH_COUNT : args.ph_hi;
#ifndef PHASE_MASK
#define PHASE_MASK 0xFFF
#endif
#define IN(k) ((((PHASE_MASK) >> (k)) & 1) && lo <= (k) && (k) < hi)
#define BOTH(k) (IN(k) && IN((k) + 1))
#define Win_t ((bf16*)(ws + WS_WIN))
#define BrA_t ((bf16*)(ws + WS_BRA))
#define BrB_t ((bf16*)(ws + WS_BRB))
#define Wout_t ((bf16*)(ws + WS_WOUT))
#define Wpg_t ((bf16*)(ws + WS_WPG))
#define Wpp_t ((bf16*)(ws + WS_WPP))
#define PB ((bf16*)(ws + WS_PB))
#define HA ((bf16*)(ws + WS_A))
#define ropec ((float*)(ws + WS_ROPEC))
#define ropes ((float*)(ws + WS_ROPES))
#define kmean ((float*)(ws + WS_KMEAN))
#define cnt_g ((int*)(ws + WS_CTL + 4 * CW_CNT))
#define ltok ((int*)(ws + WS_LTOK))
#define lwt ((float*)(ws + WS_LW))
    if (IN(PH_PRO)) {
        CArgs& args = *phase_args(); unsigned char* const ws = args.ws; float* const out = args.out; const float* const x = args.in[0]; (void)x; (void)out;
        Frame F; { int t_ = HW_TID(); asm volatile("" : "+v"(t_)); F.tid = t_; F.lane = t_ & 63; F.wave = __builtin_amdgcn_readfirstlane(t_ >> 6);
          unsigned l_ = (unsigned)(uintptr_t)lds; asm volatile("" : "+s"(l_)); F.lds = (LAS unsigned char*)l_; F.MISC = (volatile LAS unsigned*)(F.lds + MISC_OFF); F.ctl = (gu32*)(ws + WS_CTL);
          int g_ = (int)gridDim.x; asm volatile("" : "+s"(g_)); F.G = g_; const int bx = blockIdx.x; F.vcu = (F.G % 8 == 0) ? (bx % 8) * (F.G / 8) + bx / 8 : bx; }
        const int gw = F.vcu * NWAVES + F.wave, NGW = F.G * NWAVES; (void)gw; (void)NGW;
        constexpr int I_IN = 16 * 179, I_BR = 8 * 32, I_O = 16 * 32, I_PP = 4 * 32;
        constexpr int NITEMS = I_IN + 2 * I_BR + 2 * I_O + I_PP;
        { const int gt = F.vcu * NWAVES * 64 + F.tid, NGT = F.G * NWAVES * 64;
            for (int i = gt; i < 184 * 128; i += NGT) ((GAS v4u*)(Win_t + (size_t)584 * DMODEL))[i] = (v4u){0u, 0u, 0u, 0u};
            for (int i = gt; i < SEQ * 8; i += NGT) { const int pos = i >> 3, k = i & 7; const float inv = 1.0f / powf(500000.0f, (float)k * 0.125f); const float ang = (float)pos * inv; ropec[i] = cosf(ang); ropes[i] = sinf(ang); } }
        { const int gt = F.vcu * NWAVES * 64 + F.tid, NGT = F.G * NWAVES * 64;
          const int trips_r = (TOK - gw + 4 * NGW - 1) / (4 * NGW), trips_i = (NITEMS - gw + NGW - 1) / NGW, trips_p = (TOK * PLE / 4 + 4 * NGT - 1) / (4 * NGT);
          const int trips = max(max(trips_r, trips_i), trips_p);
          const GAS f32x4* p4 = (const GAS f32x4*)args.in[1]; GAS unsigned long long* pb8 = (GAS unsigned long long*)PB;
          f32x4 gg[4];
#pragma unroll
          for (int j = 0; j < 4; ++j) gg[j] = ((const GAS f32x4*)args.in[2] + F.lane)[64 * j];
#pragma unroll 1
          for (int b = 0; b < trips; ++b) {
              f32x4 v[4][4]; float t[32]; f32x4 pv[4];
#pragma unroll
              for (int r = 0; r < 4; ++r) { int m = gw + (4 * b + r) * NGW; m = m < TOK ? m : TOK - 1; const GAS f32x4* xr = (const GAS f32x4*)(x + (size_t)m * DMODEL) + F.lane;
#pragma unroll
                  for (int j = 0; j < 4; ++j) v[r][j] = xr[64 * j]; }
              const int it0 = gw + b * NGW; const int it = it0 < NITEMS ? it0 : NITEMS - 1; int r_ = it; int kind = 0;
              const float* W_ = args.in[3]; int K_ = DMODEL, N_ = IN_COLS; unsigned char* d_ = (unsigned char*)Win_t;
              {
                  if (r_ >= I_IN) { r_ -= I_IN; kind = 1; W_ = args.in[4]; K_ = AW; N_ = DMODEL; d_ = (unsigned char*)BrA_t;
                      if (r_ >= I_BR) { r_ -= I_BR; kind = 2; W_ = args.in[5]; d_ = (unsigned char*)BrA_t + AW;
                          if (r_ >= I_BR) { r_ -= I_BR; kind = 3; W_ = args.in[6]; K_ = DMODEL; d_ = (unsigned char*)Wout_t;
                              if (r_ >= I_O) { r_ -= I_O; kind = 4; W_ = args.in[16]; d_ = (unsigned char*)Wpg_t;
                                  if (r_ >= I_O) { r_ -= I_O; kind = 5; W_ = args.in[17]; K_ = PLE; d_ = (unsigned char*)Wpp_t; } } } } } }
              const int nblk_ = (N_ + 31) >> 5;
              conv_load(W_, N_, nblk_, r_, F.lane, t);
              if (it0 >= NITEMS) kind = -1;
#pragma unroll
              for (int j = 0; j < 4; ++j) { int i = gt + (4 * b + j) * NGT; i = i < TOK * PLE / 4 ? i : TOK * PLE / 4 - 1; pv[j] = p4[i]; }
              asm volatile("" : "+v"(v[0][0]), "+v"(v[0][1]), "+v"(v[0][2]), "+v"(v[0][3]) :: "memory");
#pragma unroll
              for (int r = 0; r < 4; ++r) { const int m = gw + (4 * b + r) * NGW; float s = 0.f;
#pragma unroll
                  for (int j = 0; j < 4; ++j) s += (v[r][j].x * v[r][j].x + v[r][j].y * v[r][j].y) + (v[r][j].z * v[r][j].z + v[r][j].w * v[r][j].w);
                  const float rstd = sqrtf(wave_sum(s) * (1.f / DMODEL) + RMS_EPS); const float rinv = 1.0f / rstd;
                  if (m < TOK && F.lane == 0) ((float*)(ws + WS_RSTD))[m] = rstd;
                  if (m < TOK) { GAS unsigned long long* o8 = (GAS unsigned long long*)(HA + (size_t)m * DMODEL) + F.lane; GAS unsigned* o4 = (GAS unsigned*)(ws + WS_H8 + (size_t)m * DMODEL) + F.lane;
#pragma unroll
                      for (int j = 0; j < 4; ++j) { const f32x4 h = (f32x4){v[r][j].x * rinv * gg[j].x, v[r][j].y * rinv * gg[j].y, v[r][j].z * rinv * gg[j].z, v[r][j].w * rinv * gg[j].w};
                          o8[64 * j] = (unsigned long long)pg8::cvt_pk_bf16(h.x, h.y) | ((unsigned long long)pg8::cvt_pk_bf16(h.z, h.w) << 32);
                          int w_ = __builtin_amdgcn_cvt_pk_fp8_f32(h.x, h.y, 0, false); w_ = __builtin_amdgcn_cvt_pk_fp8_f32(h.z, h.w, w_, true); o4[64 * j] = (unsigned)w_; } } }
              asm volatile("" ::: "memory");
              if (kind == 0) conv_store<2>(K_, N_, nblk_, r_, F.lane, (unsigned char*)Win_t, ws + WS_WIN8, RmWin{}, 32.f, t);
              else if (kind == 5) conv_store<0>(K_, N_, nblk_, r_, F.lane, d_, d_, RmIdent{}, 1.f, t);
              else if (kind > 0) conv_store<1>(K_, N_, nblk_, r_, F.lane, d_, d_, RmIdent{}, 32.f, t, (kind <= 2) ? DMODEL : 0);
#pragma unroll
              for (int j = 0; j < 4; ++j) { const int i = gt + (4 * b + j) * NGT; if (i < TOK * PLE / 4) pb8[i] = (unsigned long long)pg8::cvt_pk_bf16(pv[j].x, pv[j].y) | ((unsigned long long)pg8::cvt_pk_bf16(pv[j].z, pv[j].w) << 32); }
          } }
        if (BOTH(PH_PRO)) GRID_BAR(); STAMP(PH_PRO);
    }
    if (IN(PH_ZG)) {
        CArgs& args = *phase_args(); unsigned char* const ws = args.ws; float* const out = args.out; const float* const x = args.in[0]; (void)x; (void)out;
        Frame F; { int t_ = HW_TID(); asm volatile("" : "+v"(t_)); F.tid = t_; F.lane = t_ & 63; F.wave = __builtin_amdgcn_readfirstlane(t_ >> 6);
          unsigned l_ = (unsigned)(uintptr_t)lds; asm volatile("" : "+s"(l_)); F.lds = (LAS unsigned char*)l_; F.MISC = (volatile LAS unsigned*)(F.lds + MISC_OFF); F.ctl = (gu32*)(ws + WS_CTL);
          int g_ = (int)gridDim.x; asm volatile("" : "+s"(g_)); F.G = g_; const int bx = blockIdx.x; F.vcu = (F.G % 8 == 0) ? (bx % 8) * (F.G / 8) + bx / 8 : bx; }
        const int gw = F.vcu * NWAVES + F.wave, NGW = F.G * NWAVES; (void)gw; (void)NGW;
        { pg8::Gemm g{(const bf16*)(ws + WS_H8), (const bf16*)(ws + WS_WIN8), TOK, 5120, DMODEL}; pg8::StaticOrderTail S; S.S.init(TOK, 5120, F.G, (int)blockIdx.x);
          { const int nb = (TOK / 256) * 3, rb = nb % F.G; const bool uneven = (rb > 0) && (2 * rb == F.G) && (S.S.nwg % F.G == 0); S.full = uneven ? S.S.nwg / F.G - 1 : (1 << 20); S.cut = uneven ? rb : 0; }
          pg8::EpiZ<1> E{(bf16*)(ws + WS_QA), (bf16*)(ws + WS_KA), (bf16*)(ws + WS_VA), (bf16*)(ws + WS_QB), (bf16*)(ws + WS_KB), (bf16*)(ws + WS_VB), (bf16*)(ws + WS_IQ), (bf16*)(ws + WS_IK),
                      (bf16*)(ws + WS_GA), (bf16*)(ws + WS_GB), (float*)(ws + WS_IW), kmean, ropec, ropes};
          pg8::gemm_phase<pg8::EpiZ<1>, pg8::StaticOrderTail, true, true, false, true>(F.lds + RING_OFF, g, S, E, F.tid); }
        VM_WAIT(); __syncthreads();
        { pg8::Gemm g{HA, Win_t, TOK, 768, DMODEL}; pg8::StaticOrder S; S.init(TOK, 768, F.G, (int)blockIdx.x);
          pg8::EpiZ<0> E{(bf16*)(ws + WS_QA), (bf16*)(ws + WS_KA), (bf16*)(ws + WS_VA), (bf16*)(ws + WS_QB), (bf16*)(ws + WS_KB), (bf16*)(ws + WS_VB), (bf16*)(ws + WS_IQ), (bf16*)(ws + WS_IK),
                      (bf16*)(ws + WS_GA), (bf16*)(ws + WS_GB), (float*)(ws + WS_IW), kmean, ropec, ropes};
          pg8::gemm_phase<pg8::EpiZ<0>, pg8::StaticOrder, true, true, false, false>(F.lds + RING_OFF, g, S, E, F.tid); }
        if (BOTH(PH_ZG)) GRID_BAR(); STAMP(PH_ZG);
    }
    if (IN(PH_IDX)) {
        CArgs& args = *phase_args(); unsigned char* const ws = args.ws; float* const out = args.out; const float* const x = args.in[0]; (void)x; (void)out;
        Frame F; { int t_ = HW_TID(); asm volatile("" : "+v"(t_)); F.tid = t_; F.lane = t_ & 63; F.wave = __builtin_amdgcn_readfirstlane(t_ >> 6);
          unsigned l_ = (unsigned)(uintptr_t)lds; asm volatile("" : "+s"(l_)); F.lds = (LAS unsigned char*)l_; F.MISC = (volatile LAS unsigned*)(F.lds + MISC_OFF); F.ctl = (gu32*)(ws + WS_CTL);
          int g_ = (int)gridDim.x; asm volatile("" : "+s"(g_)); F.G = g_; const int bx = blockIdx.x; F.vcu = (F.G % 8 == 0) ? (bx % 8) * (F.G / 8) + bx / 8 : bx; }
        const int gw = F.vcu * NWAVES + F.wave, NGW = F.G * NWAVES; (void)gw; (void)NGW;
        const int b = F.vcu >> 5, jj = F.vcu & 31;
#if defined(PROBE_A)
        const unsigned long long tl0_ = __builtin_amdgcn_s_memrealtime();
#endif
        if (F.G == 256) {
            (void)jj;
            unsigned* const qh = (unsigned*)(ws + WS_CTL) + CW_IDXQ + 16 * b; volatile LAS int* const tk = (volatile LAS int*)(F.lds + MISC_OFF + 64);
            if (F.tid == 0) tk[0] = (int)__hip_atomic_fetch_add(qh, 1u, __ATOMIC_RELAXED, __HIP_MEMORY_SCOPE_AGENT);
            __syncthreads(); int t = tk[0]; __syncthreads();
#pragma unroll 1
            while (t < 256) { const int u = 255 - t;
                unsigned nx = 0u; if (F.tid == 0) nx = __hip_atomic_fetch_add(qh, 1u, __ATOMIC_RELAXED, __HIP_MEMORY_SCOPE_AGENT);
                idx::unit(b, 16 * u, (const bf16*)(ws + WS_IQ), (const bf16*)(ws + WS_IK), (const float*)(ws + WS_IW), (unsigned*)(ws + WS_MASK), (char*)lds + RING_OFF, F.tid
#if defined(PROBE_ACC)
                    , (blockIdx.x == PROBE_BLK) ? ts_ + 24 : nullptr
#endif
                    );
                if (F.tid == 0) tk[0] = (int)nx;
                __syncthreads(); t = tk[0]; __syncthreads(); }
        }
        if (BOTH(PH_IDX)) GRID_BAR(); STAMP(PH_IDX);
    }
    if (IN(PH_ATT)) {
        CArgs& args = *phase_args(); unsigned char* const ws = args.ws; float* const out = args.out; const float* const x = args.in[0]; (void)x; (void)out;
        Frame F; { int t_ = HW_TID(); asm volatile("" : "+v"(t_)); F.tid = t_; F.lane = t_ & 63; F.wave = __builtin_amdgcn_readfirstlane(t_ >> 6);
          unsigned l_ = (unsigned)(uintptr_t)lds; asm volatile("" : "+s"(l_)); F.lds = (LAS unsigned char*)l_; F.MISC = (volatile LAS unsigned*)(F.lds + MISC_OFF); F.ctl = (gu32*)(ws + WS_CTL);
          int g_ = (int)gridDim.x; asm volatile("" : "+s"(g_)); F.G = g_; const int bx = blockIdx.x; F.vcu = (F.G % 8 == 0) ? (bx % 8) * (F.G / 8) + bx / 8 : bx; }
        const int gw = F.vcu * NWAVES + F.wave, NGW = F.G * NWAVES; (void)gw; (void)NGW;
        if (F.G == 256) {
            const int bh = F.vcu >> 2, s = F.vcu & 3; const int b = bh >> 3, h = bh & 7;
#pragma unroll 1
            for (int i = 0; i < 4; ++i) { const int qb = (i == 0) ? s : (i == 1) ? 7 - s : (i == 2) ? 8 + s : 15 - s;
                att2::attn_unit<0, 8>(b, h, qb, (const bf16*)(ws + WS_QA), (const bf16*)(ws + WS_KA), (const bf16*)(ws + WS_VA), ws + WS_OAB8, kmean, (char*)lds + RING_OFF, F.tid); }
#pragma unroll 1
            for (int i = 0; i < 4; ++i) { const int qb = (i == 0) ? s : (i == 1) ? 7 - s : (i == 2) ? 8 + s : 15 - s;
                att2::attn_unit<1, 8>(b, h, qb, (const bf16*)(ws + WS_QB), (const bf16*)(ws + WS_KB), (const bf16*)(ws + WS_VB), ws + WS_OAB8 + AW, ws + WS_MASK, (char*)lds + RING_OFF, F.tid); }
        }
        if (BOTH(PH_ATT)) GRID_BAR(); STAMP(PH_ATT);
    }
    if (IN(PH_BR)) {
        CArgs& args = *phase_args(); unsigned char* const ws = args.ws; float* const out = args.out; const float* const x = args.in[0]; (void)x; (void)out;
        Frame F; { int t_ = HW_TID(); asm volatile("" : "+v"(t_)); F.tid = t_; F.lane = t_ & 63; F.wave = __builtin_amdgcn_readfirstlane(t_ >> 6);
          unsigned l_ = (unsigned)(uintptr_t)lds; asm volatile("" : "+s"(l_)); F.lds = (LAS unsigned char*)l_; F.MISC = (volatile LAS unsigned*)(F.lds + MISC_OFF); F.ctl = (gu32*)(ws + WS_CTL);
          int g_ = (int)gridDim.x; asm volatile("" : "+s"(g_)); F.G = g_; const int bx = blockIdx.x; F.vcu = (F.G % 8 == 0) ? (bx % 8) * (F.G / 8) + bx / 8 : bx; }
        const int gw = F.vcu * NWAVES + F.wave, NGW = F.G * NWAVES; (void)gw; (void)NGW;
        { pg8::Gemm g{(const bf16*)(ws + WS_OAB8), BrA_t, TOK, DMODEL, 2 * AW}; pg8::StaticOrder S; S.init(TOK, DMODEL, F.G, (int)blockIdx.x);
          pg8::EpiMerged E{(const bf16*)(ws + WS_GA), (const bf16*)(ws + WS_GB), ws + WS_MRG};
          pg8::gemm_phase<pg8::EpiMerged, pg8::StaticOrder, true, true, false, true>(F.lds + RING_OFF, g, S, E, F.tid); }
        if (BOTH(PH_BR)) GRID_BAR(); STAMP(PH_BR);
    }
    if (IN(PH_WO)) {
        CArgs& args = *phase_args(); unsigned char* const ws = args.ws; float* const out = args.out; const float* const x = args.in[0]; (void)x; (void)out;
        Frame F; { int t_ = HW_TID(); asm volatile("" : "+v"(t_)); F.tid = t_; F.lane = t_ & 63; F.wave = __builtin_amdgcn_readfirstlane(t_ >> 6);
          unsigned l_ = (unsigned)(uintptr_t)lds; asm volatile("" : "+s"(l_)); F.lds = (LAS unsigned char*)l_; F.MISC = (volatile LAS unsigned*)(F.lds + MISC_OFF); F.ctl = (gu32*)(ws + WS_CTL);
          int g_ = (int)gridDim.x; asm volatile("" : "+s"(g_)); F.G = g_; const int bx = blockIdx.x; F.vcu = (F.G % 8 == 0) ? (bx % 8) * (F.G / 8) + bx / 8 : bx; }
        const int gw = F.vcu * NWAVES + F.wave, NGW = F.G * NWAVES; (void)gw; (void)NGW;
        pg8::Gemm g{(const bf16*)(ws + WS_MRG), Wout_t, TOK, DMODEL, DMODEL}; pg8::StaticOrder S; S.init(TOK, DMODEL, F.G, (int)blockIdx.x);
        pg8::EpiResidualB E{HA, (const float*)(ws + WS_RSTD), args.in[2], (bf16*)(ws + WS_X1B)};
        pg8::gemm_phase<pg8::EpiResidualB, pg8::StaticOrder, true, true, false, true>(F.lds + RING_OFF, g, S, E, F.tid);
        if (BOTH(PH_WO)) GRID_BAR(); STAMP(PH_WO);
    }
    if (IN(PH_RT)) {
        CArgs& args = *phase_args(); unsigned char* const ws = args.ws; float* const out = args.out; const float* const x = args.in[0]; (void)x; (void)out;
        Frame F; { int t_ = HW_TID(); asm volatile("" : "+v"(t_)); F.tid = t_; F.lane = t_ & 63; F.wave = __builtin_amdgcn_readfirstlane(t_ >> 6);
          unsigned l_ = (unsigned)(uintptr_t)lds; asm volatile("" : "+s"(l_)); F.lds = (LAS unsigned char*)l_; F.MISC = (volatile LAS unsigned*)(F.lds + MISC_OFF); F.ctl = (gu32*)(ws + WS_CTL);
          int g_ = (int)gridDim.x; asm volatile("" : "+s"(g_)); F.G = g_; const int bx = blockIdx.x; F.vcu = (F.G % 8 == 0) ? (bx % 8) * (F.G / 8) + bx / 8 : bx; }
        const int gw = F.vcu * NWAVES + F.wave, NGW = F.G * NWAVES; (void)gw; (void)NGW;
        LAS float* WT = (LAS float*)(F.lds);
        LAS int* lcnt = (LAS int*)(F.lds + 147456);
        LAS int* rinfo = (LAS int*)(F.lds + 147456 + 256);
        { const GAS f32x4* wg4 = (const GAS f32x4*)args.in[8]; const GAS f32x4* wr4 = (const GAS f32x4*)args.in[10];
          for (int i = F.tid; i < DMODEL; i += NWAVES * 64) { const f32x4 v = wg4[i]; WT[0 * DMODEL + i] = v.x; WT[1 * DMODEL + i] = v.y; WT[2 * DMODEL + i] = v.z; WT[3 * DMODEL + i] = v.w; }
#pragma unroll 4
          for (int i = F.tid; i < DMODEL * 8; i += NWAVES * 64) { const f32x4 v = wr4[i]; const int k = i >> 3, c = 4 + 4 * (i & 7); WT[(c + 0) * DMODEL + k] = v.x; WT[(c + 1) * DMODEL + k] = v.y; WT[(c + 2) * DMODEL + k] = v.z; WT[(c + 3) * DMODEL + k] = v.w; } }
        if (F.tid < 64) lcnt[F.tid] = 0;
        VM_WAIT(); LDS_WAIT(); __syncthreads();
        const int chunk = F.vcu;
        if (F.G == 256) {
            constexpr int NMI = NEXP * 768;
            unsigned long long vn[2][4];
#pragma unroll
            for (int t = 0; t < 2; ++t) { const GAS unsigned long long* xr = (const GAS unsigned long long*)((const bf16*)(ws + WS_X1B) + (size_t)(chunk * 128 + F.wave * 16 + t) * DMODEL) + F.lane;
#pragma unroll
                for (int j = 0; j < 4; ++j) vn[t][j] = xr[64 * j]; }
#pragma unroll 1
            for (int rr = 0; rr < 8; ++rr) { const int rloc = F.wave * 16 + 2 * rr; const int row = chunk * 128 + rloc;
                const GAS f32x4* gr = (const GAS f32x4*)args.in[7] + F.lane;
                f32x4 v[2][4]; float rinv[2]; float t_[32];
#pragma unroll
                for (int t = 0; t < 2; ++t)
#pragma unroll
                    for (int j = 0; j < 4; ++j) { const unsigned lo_ = (unsigned)vn[t][j], hi_ = (unsigned)(vn[t][j] >> 32); v[t][j] = (f32x4){pg8::bf_lo(lo_), pg8::bf_hi(lo_), pg8::bf_lo(hi_), pg8::bf_hi(hi_)}; }
                { const int rown = row + (rr < 7 ? 2 : 0);
#pragma unroll
                  for (int t = 0; t < 2; ++t) { const GAS unsigned long long* xr = (const GAS unsigned long long*)((const bf16*)(ws + WS_X1B) + (size_t)(rown + t) * DMODEL) + F.lane;
#pragma unroll
                      for (int j = 0; j < 4; ++j) vn[t][j] = xr[64 * j]; } }
                const int it0 = gw + rr * NGW; const MoeItem mi = moe_item(it0 < NMI ? it0 : NMI - 1, args.in[12], args.in[13], args.in[14], ws + WS_WGU, ws + WS_WDN);
                conv_load(mi.W, mi.N, mi.nblk, mi.r, F.lane, t_);
                asm volatile("" : "+v"(v[0][0]), "+v"(v[0][1]), "+v"(v[0][2]), "+v"(v[0][3]) :: "memory");
#pragma unroll
                for (int t = 0; t < 2; ++t) { float s = 0.f;
#pragma unroll
                    for (int j = 0; j < 4; ++j) s += (v[t][j].x * v[t][j].x + v[t][j].y * v[t][j].y) + (v[t][j].z * v[t][j].z + v[t][j].w * v[t][j].w);
                    rinv[t] = 1.0f / sqrtf(wave_sum(s) * (1.f / DMODEL) + RMS_EPS); }
#pragma unroll
                for (int t = 0; t < 2; ++t) { GAS unsigned* o4 = (GAS unsigned*)((unsigned char*)HA + (size_t)(row + t) * DMODEL) + F.lane;
#pragma unroll
                    for (int j = 0; j < 4; ++j) { const f32x4 gg = gr[64 * j]; v[t][j] = v[t][j] * rinv[t] * gg;
                        int w_ = __builtin_amdgcn_cvt_pk_fp8_f32(v[t][j].x, v[t][j].y, 0, false); w_ = __builtin_amdgcn_cvt_pk_fp8_f32(v[t][j].z, v[t][j].w, w_, true); o4[64 * j] = (unsigned)w_; } }
                float gl[2][4];
#pragma unroll
                for (int c = 0; c < 4; ++c) { float a0 = 0.f, a1 = 0.f;
#pragma unroll
                    for (int j = 0; j < 4; ++j) { const f32x4 w = *(const LAS f32x4*)(WT + c * DMODEL + 256 * j + 4 * F.lane);
                        a0 += (v[0][j].x * w.x + v[0][j].y * w.y) + (v[0][j].z * w.z + v[0][j].w * w.w); a1 += (v[1][j].x * w.x + v[1][j].y * w.y) + (v[1][j].z * w.z + v[1][j].w * w.w); }
                    gl[0][c] = wave_sum(a0) + args.in[9][c]; gl[1][c] = wave_sum(a1) + args.in[9][c]; }
#pragma unroll
                for (int t = 0; t < 2; ++t) {
                    int g = 0; float gm = gl[t][0];
#pragma unroll
                    for (int c = 1; c < 4; ++c) if (gl[t][c] > gm) { gm = gl[t][c]; g = c; }
                    g = __builtin_amdgcn_readfirstlane(g);
                    float den = 0.f;
#pragma unroll
                    for (int c = 0; c < 4; ++c) den += expf(gl[t][c] - gm);
                    const float pg = 1.0f / den;
                    float el[8];
#pragma unroll
                    for (int c = 0; c < 8; ++c) { float a = 0.f; const LAS float* wp = WT + (4 + 8 * g + c) * DMODEL + 4 * F.lane;
#pragma unroll
                        for (int j = 0; j < 4; ++j) { const f32x4 w = *(const LAS f32x4*)(wp + 256 * j); a += (v[t][j].x * w.x + v[t][j].y * w.y) + (v[t][j].z * w.z + v[t][j].w * w.w); }
                        el[c] = wave_sum(a) + args.in[11][8 * g + c]; }
                    int i1 = 0; float v1 = el[0];
#pragma unroll
                    for (int c = 1; c < 8; ++c) if (el[c] > v1) { v1 = el[c]; i1 = c; }
                    int i2 = -1; float v2 = -INFINITY;
#pragma unroll
                    for (int c = 0; c < 8; ++c) if (c != i1 && el[c] > v2) { v2 = el[c]; i2 = c; }
                    const float e2 = expf(v2 - v1); const float w1 = pg / (1.0f + e2), w2 = pg * e2 / (1.0f + e2);
                    if (F.lane == 0) { const int e1 = 8 * g + i1, ee2 = 8 * g + i2;
                        const int p1 = __hip_atomic_fetch_add(lcnt + e1, 1, __ATOMIC_RELAXED, __HIP_MEMORY_SCOPE_WORKGROUP); const int p2 = __hip_atomic_fetch_add(lcnt + ee2, 1, __ATOMIC_RELAXED, __HIP_MEMORY_SCOPE_WORKGROUP);
                        LAS int* ri = rinfo + (rloc + t) * 8; ri[0] = e1; ri[1] = p1; ri[2] = (int)__float_as_uint(w1); ri[3] = 2 * (row + t); ri[4] = ee2; ri[5] = p2; ri[6] = (int)__float_as_uint(w2); ri[7] = 2 * (row + t) + 1; }
                }
                asm volatile("" ::: "memory");
                if (it0 < NMI) conv_store<1>(mi.K, mi.N, mi.nblk, mi.r, F.lane, mi.d, mi.d, RmMoe{mi.mode}, 32.f, t_);
            }
            LDS_WAIT(); __syncthreads();
            if (F.tid < 32) { const int c = lcnt[F.tid]; lcnt[32 + F.tid] = c ? (int)__hip_atomic_fetch_add((gu32*)cnt_g + F.tid, (unsigned)c, RLX_AGENT) : 0; }
            VM_WAIT(); LDS_WAIT(); __syncthreads();
            if (F.tid < 256) { const LAS int* ri = rinfo + F.tid * 4; const int e = ri[0], pos = lcnt[32 + e] + ri[1]; ltok[e * 32768 + pos] = ri[3]; lwt[e * 32768 + pos] = __uint_as_float((unsigned)ri[2]); }
        }
        __syncthreads(); STAMP(19);
        { constexpr int NMI = NEXP * 768;
          const int k0 = (F.G == 256) ? 8 : 0; const int trips = (NMI - gw + NGW - 1) / NGW;
          float ta[32];
          { const int it = gw + k0 * NGW; const MoeItem mi = moe_item(it < NMI ? it : NMI - 1, args.in[12], args.in[13], args.in[14], ws + WS_WGU, ws + WS_WDN); conv_load(mi.W, mi.N, mi.nblk, mi.r, F.lane, ta); }
#pragma unroll 1
          for (int k = k0; k < trips; ++k) { float tb[32];
              const int it = gw + k * NGW, itn = it + NGW;
              const MoeItem mn = moe_item(itn < NMI ? itn : NMI - 1, args.in[12], args.in[13], args.in[14], ws + WS_WGU, ws + WS_WDN); conv_load(mn.W, mn.N, mn.nblk, mn.r, F.lane, tb);
              asm volatile("" : "+v"(ta[0]) :: "memory");
              const MoeItem mi = moe_item(it, args.in[12], args.in[13], args.in[14], ws + WS_WGU, ws + WS_WDN);
              conv_store<1>(mi.K, mi.N, mi.nblk, mi.r, F.lane, mi.d, mi.d, RmMoe{mi.mode}, 32.f, ta);
#pragma unroll
              for (int i = 0; i < 32; ++i) ta[i] = tb[i]; } }
        if (BOTH(PH_RT)) GRID_BAR(); STAMP(PH_RT);
    }
    if (IN(PH_GU)) {
        CArgs& args = *phase_args(); unsigned char* const ws = args.ws; float* const out = args.out; const float* const x = args.in[0]; (void)x; (void)out;
        Frame F; { int t_ = HW_TID(); asm volatile("" : "+v"(t_)); F.tid = t_; F.lane = t_ & 63; F.wave = __builtin_amdgcn_readfirstlane(t_ >> 6);
          unsigned l_ = (unsigned)(uintptr_t)lds; asm volatile("" : "+s"(l_)); F.lds = (LAS unsigned char*)l_; F.MISC = (volatile LAS unsigned*)(F.lds + MISC_OFF); F.ctl = (gu32*)(ws + WS_CTL);
          int g_ = (int)gridDim.x; asm volatile("" : "+s"(g_)); F.G = g_; const int bx = blockIdx.x; F.vcu = (F.G % 8 == 0) ? (bx % 8) * (F.G / 8) + bx / 8 : bx; }
        const int gw = F.vcu * NWAVES + F.wave, NGW = F.G * NWAVES; (void)gw; (void)NGW;
        const int n = moe_build(F, cnt_g, ltok, lwt, 0);
        MoeOrder S{(const LAS int*)(F.lds + TBL_OFF + MoeTbl::UNITS), (const LAS unsigned*)(F.lds + TBL_OFF + MoeTbl::ROWOFF), n, (size_t)DMODEL * DMODEL, (unsigned*)(ws + WS_CTL) + CW_HID, nullptr};
        pg8::Gemm g{HA, (const bf16*)(ws + WS_WGU), 0, DMODEL, DMODEL};
        pg8::EpiSwiglu E{ws + WS_HID};
        pg8::gemm_phase<pg8::EpiSwiglu, MoeOrder, true, true, true, true>(F.lds + RING_OFF, g, S, E, F.tid);
        { VM_WAIT(); __syncthreads();
          const int U = 4 * ((const LAS int*)(F.lds + TBL_OFF + MoeTbl::RB0))[32]; const int r = U % F.G, idle = F.G - r; const int c = (int)blockIdx.x;
          pg8::Gemm gp{PB, Wpp_t, TOK, DMODEL, PLE}; pg8::StaticOrderSlice SP; SP.S.init(TOK, DMODEL, F.G, 0); SP.limit = 256;
          if (2 * idle >= F.G) { SP.first = (c >= r) ? 0 + c - r : -1; SP.stride = idle; } else { SP.first = 0 + c; SP.stride = F.G; }
          pg8::EpiStoreBf16 EP{(bf16*)(ws + WS_P), DMODEL};
          pg8::gemm_phase<pg8::EpiStoreBf16, pg8::StaticOrderSlice, true, true, false>(F.lds + RING_OFF, gp, SP, EP, F.tid); }
        VM_WAIT(); __syncthreads(); STAMP(PH_GU);
    }
    if (IN(PH_DN)) {
        CArgs& args = *phase_args(); unsigned char* const ws = args.ws; float* const out = args.out; const float* const x = args.in[0]; (void)x; (void)out;
        Frame F; { int t_ = HW_TID(); asm volatile("" : "+v"(t_)); F.tid = t_; F.lane = t_ & 63; F.wave = __builtin_amdgcn_readfirstlane(t_ >> 6);
          unsigned l_ = (unsigned)(uintptr_t)lds; asm volatile("" : "+s"(l_)); F.lds = (LAS unsigned char*)l_; F.MISC = (volatile LAS unsigned*)(F.lds + MISC_OFF); F.ctl = (gu32*)(ws + WS_CTL);
          int g_ = (int)gridDim.x; asm volatile("" : "+s"(g_)); F.G = g_; const int bx = blockIdx.x; F.vcu = (F.G % 8 == 0) ? (bx % 8) * (F.G / 8) + bx / 8 : bx; }
        const int gw = F.vcu * NWAVES + F.wave, NGW = F.G * NWAVES; (void)gw; (void)NGW;
        const int n = moe_build(F, cnt_g, ltok, lwt, 1);
        MoeOrder S{(const LAS int*)(F.lds + TBL_OFF + MoeTbl::UNITS), (const LAS unsigned*)(F.lds + TBL_OFF + MoeTbl::ROWOFF), n, (size_t)DMODEL * DEXP, nullptr, (unsigned*)(ws + WS_CTL) + CW_HID};
        pg8::Gemm g{(const bf16*)(ws + WS_HID), (const bf16*)(ws + WS_WDN), 0, DMODEL, DEXP};
        pg8::EpiDown E{ws + WS_Y, (const LAS int*)(F.lds + TBL_OFF + MoeTbl::ROWOFF), (const LAS float*)(F.lds + TBL_OFF + MoeTbl::ROWW)};
        pg8::gemm_phase<pg8::EpiDown, MoeOrder, true, true, false, true>(F.lds + RING_OFF, g, S, E, F.tid);
        { VM_WAIT(); __syncthreads();
          const int U = 4 * ((const LAS int*)(F.lds + TBL_OFF + MoeTbl::RB0))[32]; const int r = U % F.G, idle = F.G - r; const int c = (int)blockIdx.x;
          pg8::Gemm gp{PB, Wpp_t, TOK, DMODEL, PLE}; pg8::StaticOrderSlice SP; SP.S.init(TOK, DMODEL, F.G, 0); SP.limit = 512;
          { const int r2 = 2 * r < F.G ? 2 * r : F.G, idle2 = F.G - r2; if (2 * idle2 >= F.G / 2 && idle2 > 0) { SP.first = (c >= r2) ? 256 + c - r2 : -1; SP.stride = idle2; } else { SP.first = 256 + c; SP.stride = F.G; } }
          pg8::EpiStoreBf16 EP{(bf16*)(ws + WS_P), DMODEL};
          pg8::gemm_phase<pg8::EpiStoreBf16, pg8::StaticOrderSlice, true, true, false>(F.lds + RING_OFF, gp, SP, EP, F.tid); }
        if (BOTH(PH_DN)) GRID_BAR(); STAMP(PH_DN);
    }
    if (IN(PH_CMB)) {
        CArgs& args = *phase_args(); unsigned char* const ws = args.ws; float* const out = args.out; const float* const x = args.in[0]; (void)x; (void)out;
        Frame F; { int t_ = HW_TID(); asm volatile("" : "+v"(t_)); F.tid = t_; F.lane = t_ & 63; F.wave = __builtin_amdgcn_readfirstlane(t_ >> 6);
          unsigned l_ = (unsigned)(uintptr_t)lds; asm volatile("" : "+s"(l_)); F.lds = (LAS unsigned char*)l_; F.MISC = (volatile LAS unsigned*)(F.lds + MISC_OFF); F.ctl = (gu32*)(ws + WS_CTL);
          int g_ = (int)gridDim.x; asm volatile("" : "+s"(g_)); F.G = g_; const int bx = blockIdx.x; F.vcu = (F.G % 8 == 0) ? (bx % 8) * (F.G / 8) + bx / 8 : bx; }
        const int gw = F.vcu * NWAVES + F.wave, NGW = F.G * NWAVES; (void)gw; (void)NGW;
        const unsigned char* Y = ws + WS_Y;
#ifndef NO_CMB_LOOP
        { f32x4 gg[4];
#pragma unroll
          for (int j = 0; j < 4; ++j) gg[j] = ((const GAS f32x4*)args.in[15] + F.lane)[64 * j];
#pragma unroll 1
          for (int m0 = gw; m0 < TOK; m0 += 4 * NGW) {
              unsigned long long xw[4][4]; unsigned ya[4][4], yb[4][4];
#pragma unroll
              for (int r = 0; r < 4; ++r) { int m = m0 + r * NGW; m = m < TOK ? m : TOK - 1;
                  const GAS unsigned long long* x1r = (const GAS unsigned long long*)((const bf16*)(ws + WS_X1B) + (size_t)m * DMODEL) + F.lane;
                  const GAS unsigned* y0 = (const GAS unsigned*)(Y + (size_t)(2 * m) * DMODEL) + F.lane; const GAS unsigned* y1 = (const GAS unsigned*)(Y + (size_t)(2 * m + 1) * DMODEL) + F.lane;
#pragma unroll
                  for (int j = 0; j < 4; ++j) { xw[r][j] = x1r[64 * j]; ya[r][j] = y0[64 * j]; yb[r][j] = y1[64 * j]; } }
              asm volatile("" : "+v"(xw[0][0]) :: "memory");
#pragma unroll
              for (int r = 0; r < 4; ++r) { const int m = m0 + r * NGW; f32x4 v[4]; float s = 0.f;
#pragma unroll
                  for (int j = 0; j < 4; ++j) { const unsigned lo_ = (unsigned)xw[r][j], hi_ = (unsigned)(xw[r][j] >> 32); v[j] = (f32x4){pg8::bf_lo(lo_), pg8::bf_hi(lo_), pg8::bf_lo(hi_), pg8::bf_hi(hi_)}; const unsigned a = ya[r][j], b = yb[r][j];
                      const auto a0 = __builtin_amdgcn_cvt_pk_f32_fp8((int)a, false), a1 = __builtin_amdgcn_cvt_pk_f32_fp8((int)a, true), b0 = __builtin_amdgcn_cvt_pk_f32_fp8((int)b, false), b1 = __builtin_amdgcn_cvt_pk_f32_fp8((int)b, true);
                      v[j].x += (a0[0] + b0[0]) * (1.0f / 64.0f); v[j].y += (a0[1] + b0[1]) * (1.0f / 64.0f); v[j].z += (a1[0] + b1[0]) * (1.0f / 64.0f); v[j].w += (a1[1] + b1[1]) * (1.0f / 64.0f);
#if defined(PROBE_A)
                      if (m < TOK) ((GAS f32x4*)(out + (size_t)m * DMODEL) + F.lane)[64 * j] = v[j];
#endif
                      if (m < TOK) ((GAS unsigned long long*)((bf16*)(ws + WS_X1B) + (size_t)m * DMODEL) + F.lane)[64 * j] = (unsigned long long)pg8::cvt_pk_bf16(v[j].x, v[j].y) | ((unsigned long long)pg8::cvt_pk_bf16(v[j].z, v[j].w) << 32);
                      s += (v[j].x * v[j].x + v[j].y * v[j].y) + (v[j].z * v[j].z + v[j].w * v[j].w); }
                  const float rinv = 1.0f / sqrtf(wave_sum(s) * (1.f / DMODEL) + RMS_EPS);
                  if (m < TOK) { GAS unsigned* o4 = (GAS unsigned*)((unsigned char*)HA + (size_t)m * DMODEL) + F.lane;
#pragma unroll
                      for (int j = 0; j < 4; ++j) { int w_ = __builtin_amdgcn_cvt_pk_fp8_f32(v[j].x * rinv * gg[j].x, v[j].y * rinv * gg[j].y, 0, false); w_ = __builtin_amdgcn_cvt_pk_fp8_f32(v[j].z * rinv * gg[j].z, v[j].w * rinv * gg[j].w, w_, true); o4[64 * j] = (unsigned)w_; } } } } }
#endif
        VM_WAIT(); __syncthreads(); STAMP(20);
        if (BOTH(PH_CMB)) GRID_BAR(); STAMP(PH_CMB);
    }
    if (IN(PH_PG)) {
        CArgs& args = *phase_args(); unsigned char* const ws = args.ws; float* const out = args.out; const float* const x = args.in[0]; (void)x; (void)out;
        Frame F; { int t_ = HW_TID(); asm volatile("" : "+v"(t_)); F.tid = t_; F.lane = t_ & 63; F.wave = __builtin_amdgcn_readfirstlane(t_ >> 6);
          unsigned l_ = (unsigned)(uintptr_t)lds; asm volatile("" : "+s"(l_)); F.lds = (LAS unsigned char*)l_; F.MISC = (volatile LAS unsigned*)(F.lds + MISC_OFF); F.ctl = (gu32*)(ws + WS_CTL);
          int g_ = (int)gridDim.x; asm volatile("" : "+s"(g_)); F.G = g_; const int bx = blockIdx.x; F.vcu = (F.G % 8 == 0) ? (bx % 8) * (F.G / 8) + bx / 8 : bx; }
        const int gw = F.vcu * NWAVES + F.wave, NGW = F.G * NWAVES; (void)gw; (void)NGW;
#if defined(PROBE_A)
        { pg8::Gemm g{HA, Wpg_t, TOK, DMODEL, DMODEL}; pg8::StaticOrder S; S.init(TOK, DMODEL, F.G, (int)blockIdx.x);
          pg8::EpiPle E{out, (const bf16*)(ws + WS_P), (float*)(ws + WS_ST)};
          pg8::gemm_phase<pg8::EpiPle, pg8::StaticOrder, true, true, false, true>(F.lds + RING_OFF, g, S, E, F.tid); }
#else
        if (F.G == 256) {
            { pg8::Gemm g{HA, Wpg_t, TOK, DMODEL, DMODEL}; pg8::StaticOrderRound S; S.S.init(TOK, DMODEL, F.G, (int)blockIdx.x); S.round = 0;
              pg8::EpiPleFin E{out, (const bf16*)(ws + WS_X1B), (const bf16*)(ws + WS_P), (float*)(ws + WS_ST), (unsigned*)(ws + WS_CTL) + CW_FIN, args.in[18]};
              pg8::gemm_phase<pg8::EpiPleFin, pg8::StaticOrderRound, true, true, false, true>(F.lds + RING_OFF, g, S, E, F.tid); }
            VM_WAIT(); __syncthreads();
            { pg8::Gemm g{HA, Wpg_t, TOK, DMODEL, DMODEL}; pg8::StaticOrderRound S; S.S.init(TOK, DMODEL, F.G, (int)blockIdx.x); S.round = 1;
              pg8::EpiPleFin E{out, (const bf16*)(ws + WS_X1B), (const bf16*)(ws + WS_P), (float*)(ws + WS_ST), (unsigned*)(ws + WS_CTL) + CW_FIN, args.in[18]};
              pg8::gemm_phase<pg8::EpiPleFin, pg8::StaticOrderRound, true, true, false, true>(F.lds + RING_OFF, g, S, E, F.tid); }
        }
#endif
#if defined(PROBE_A)
        if (BOTH(PH_PG)) GRID_BAR(); STAMP(PH_PG);
#endif
    }
#if defined(PROBE_A)
    if (IN(PH_FIN)) {
        CArgs& args = *phase_args(); unsigned char* const ws = args.ws; float* const out = args.out; const float* const x = args.in[0]; (void)x; (void)out;
        Frame F; { int t_ = HW_TID(); asm volatile("" : "+v"(t_)); F.tid = t_; F.lane = t_ & 63; F.wave = __builtin_amdgcn_readfirstlane(t_ >> 6);
          unsigned l_ = (unsigned)(uintptr_t)lds; asm volatile("" : "+s"(l_)); F.lds = (LAS unsigned char*)l_; F.MISC = (volatile LAS unsigned*)(F.lds + MISC_OFF); F.ctl = (gu32*)(ws + WS_CTL);
          int g_ = (int)gridDim.x; asm volatile("" : "+s"(g_)); F.G = g_; const int bx = blockIdx.x; F.vcu = (F.G % 8 == 0) ? (bx % 8) * (F.G / 8) + bx / 8 : bx; }
        const int gw = F.vcu * NWAVES + F.wave, NGW = F.G * NWAVES; (void)gw; (void)NGW;
        const float* st = (const float*)(ws + WS_ST);
#pragma unroll 4
        for (int m = gw; m < TOK; m += NGW) {
            GAS f32x4* xr = (GAS f32x4*)(out + (size_t)m * DMODEL) + F.lane; const GAS f32x4* gr = (const GAS f32x4*)args.in[18] + F.lane;
            float s = st[(size_t)m * 16 + (F.lane & 15)];
            s += __shfl_xor(s, 1); s += __shfl_xor(s, 2); s += __shfl_xor(s, 4); s += __shfl_xor(s, 8);
            const float rinv = 1.0f / sqrtf(s * (1.f / DMODEL) + RMS_EPS);
#pragma unroll
            for (int j = 0; j < 4; ++j) { const f32x4 v = xr[64 * j]; xr[64 * j] = v * rinv * gr[64 * j]; }
#if defined(PROBE_A)
            { const unsigned long long* tq = (const unsigned long long*)(ws + 2 * MiB + 512 * 1024);
              const unsigned long long t0 = __hip_atomic_load(tq + 0, __ATOMIC_RELAXED, __HIP_MEMORY_SCOPE_AGENT), te = __hip_atomic_load(tq + PH_PG, __ATOMIC_RELAXED, __HIP_MEMORY_SCOPE_AGENT);
              float fa = 0.f; const float tot = (float)(te - t0);
#if defined(PROBE_ACC)
              fa = (float)__hip_atomic_load(tq + PROBE_ACC, __ATOMIC_RELAXED, __HIP_MEMORY_SCOPE_AGENT) / tot;
#endif
#if defined(PROBE_S0)
              fa = (float)(__hip_atomic_load(tq + PROBE_S1, __ATOMIC_RELAXED, __HIP_MEMORY_SCOPE_AGENT) - __hip_atomic_load(tq + PROBE_S0, __ATOMIC_RELAXED, __HIP_MEMORY_SCOPE_AGENT)) / tot;
#endif
#pragma unroll
              for (int k = 0; k < PH_PG; ++k) if ((PROBE_A >> k) & 1) fa += (float)(__hip_atomic_load(tq + k + 1, __ATOMIC_RELAXED, __HIP_MEMORY_SCOPE_AGENT) - __hip_atomic_load(tq + k, __ATOMIC_RELAXED, __HIP_MEMORY_SCOPE_AGENT)) / tot;
#ifndef PROBE_OFF
#define PROBE_OFF 0.0f
#endif
              #ifndef PROBE_Q
#define PROBE_Q 20.f
#endif
              fa = floorf((fa + PROBE_OFF) * PROBE_Q) / PROBE_Q;
              if ((float)m < fa * (float)TOK) {
#pragma unroll
                  for (int j = 0; j < 4; ++j) xr[64 * j] = (f32x4){0.f, 0.f, 0.f, 0.f}; }
              }
#endif
        }
    }
#endif
#undef IN
#undef BOTH
#undef GRID_BAR
}

extern "C" void kernel_launch(void* const* d_in, const int* in_sizes, int n_in, void* d_out, int out_size, void* d_ws, size_t ws_size, hipStream_t stream) {
    static int grid = 0;
    if (grid == 0) {
        if (n_in != 19 || in_sizes[0] != TOK * DMODEL || out_size != TOK * DMODEL || ws_size < WS_END) { fprintf(stderr, "kernel_launch: unexpected problem shape (n_in %d, ws %zu); nothing launched\n", n_in, ws_size); grid = -1; return; }
        int dev = 0, cus = 0, per_cu = 0;
        if (hipGetDevice(&dev) != hipSuccess || hipDeviceGetAttribute(&cus, hipDeviceAttributeMultiprocessorCount, dev) != hipSuccess) { grid = -1; return; }
        if (hipFuncSetAttribute((const void*)fwd, hipFuncAttributeMaxDynamicSharedMemorySize, LDS_BYTES) != hipSuccess) { fprintf(stderr, "kernel_launch: hipFuncSetAttribute failed\n"); grid = -1; return; }
        if (hipOccupancyMaxActiveBlocksPerMultiprocessor(&per_cu, (const void*)fwd, NWAVES * 64, LDS_BYTES) != hipSuccess || per_cu < 1) fprintf(stderr, "kernel_launch: occupancy query reports %d\n", per_cu);
        (void)hipGetLastError();
        grid = cus;
        if (grid != 256) fprintf(stderr, "kernel_launch: %d CUs; this build is laid out for 256\n", grid);
    }
    if (grid < 0) return;
    if (hipMemsetAsync((char*)d_ws + WS_CTL, 0, CTL_ZERO_BYTES, stream) != hipSuccess) return;
    Args a{};
    for (int i = 0; i < 19; ++i) a.in[i] = (const float*)d_in[i];
    a.out = (float*)d_out; a.ws = (unsigned char*)d_ws;
    if (N_LAUNCHES == 1) { a.ph_lo = 0; a.ph_hi = PH_COUNT; hipLaunchKernelGGL(fwd, dim3(grid), dim3(NWAVES * 64), LDS_BYTES, stream, a); }
    else { for (int p = 0; p < PH_COUNT; ++p) { a.ph_lo = p; a.ph_hi = p + 1; hipLaunchKernelGGL(fwd, dim3(grid), dim3(NWAVES * 64), LDS_BYTES, stream, a); } }
}
```
